# Optimizing an MI355X kernel written in HIP

```python
import jax, jax.numpy as jnp
from jax import lax
import numpy as np

D_MODEL = 1024
BATCH = 8
SEQ = 4096
DEPTH = 4

HGRN_KDIM = 128
HGRN_VDIM = 128
HGRN_HEADS = D_MODEL // HGRN_KDIM
HGRN_WIDTH = HGRN_HEADS * HGRN_KDIM
GLA_CHUNK = 64
SG_CHUNK = 128
SG_GROUP_CH = 128
SG_GROUPS = D_MODEL // SG_GROUP_CH
SG_WIDTH = SG_GROUPS * SG_GROUP_CH
IN_SPLITS = (HGRN_WIDTH, HGRN_WIDTH, HGRN_WIDTH, HGRN_WIDTH, HGRN_WIDTH,
             SG_WIDTH, SG_WIDTH, SG_WIDTH, D_MODEL, D_MODEL)
IN_WIDTH = 5 * HGRN_WIDTH + 3 * SG_WIDTH + 2 * D_MODEL
RMS_EPS = 1e-6
LN_EPS = 1e-5
LB_FLOOR = 1e-20

kernel_name = "hgrn2_spatial_gating_hybrid_encoder"


def _rmsnorm(x, w, eps=RMS_EPS):
    xf = x.astype(jnp.float32)
    y = xf * lax.rsqrt(jnp.mean(xf * xf, axis=-1, keepdims=True) + eps)
    return (y * w.astype(jnp.float32)).astype(x.dtype)


def _layernorm(x, w, b, eps=LN_EPS):
    xf = x.astype(jnp.float32)
    mu = jnp.mean(xf, axis=-1, keepdims=True)
    var = jnp.mean(jnp.square(xf - mu), axis=-1, keepdims=True)
    y = (xf - mu) * lax.rsqrt(var + eps)
    return (y * w.astype(jnp.float32) + b.astype(jnp.float32)).astype(x.dtype)


def _gla_chunked(q, k, v, log_f):
    b, h, s, dk = q.shape
    dv = v.shape[-1]
    n = s // GLA_CHUNK

    def to_chunks(t):
        return jnp.moveaxis(t.reshape(b, h, n, GLA_CHUNK, t.shape[-1]), 2, 0)

    qc, kc, vc = to_chunks(q), to_chunks(k), to_chunks(v)
    gc = jnp.cumsum(to_chunks(log_f), axis=-2)
    mask = jnp.tril(jnp.ones((GLA_CHUNK, GLA_CHUNK), dtype=bool))[:, :, None]

    def step(state, xs):
        qb, kb, vb, gb = xs
        diff = gb[..., :, None, :] - gb[..., None, :, :]
        decay = jnp.where(mask, jnp.exp(jnp.where(mask, diff, 0.0)), 0.0)
        attn = jnp.einsum('bhtd,bhsd,bhtsd->bhts', qb, kb, decay)
        o = jnp.einsum('bhts,bhsv->bhtv', attn, vb)
        o = o + jnp.einsum('bhtd,bhdv->bhtv', qb * jnp.exp(gb), state)
        g_last = gb[..., -1:, :]
        k_dec = kb * jnp.exp(g_last - gb)
        state = state * jnp.exp(g_last[..., 0, :])[..., None] + jnp.einsum('bhsd,bhsv->bhdv', k_dec, vb)
        return state, o

    state0 = jnp.zeros((b, h, dk, dv), jnp.float32)
    _, outs = lax.scan(step, state0, (qc, kc, vc, gc))
    return jnp.moveaxis(outs, 0, 2).reshape(b, h, s, dv)


def _hgrn2_forget(f_raw, lb):
    z = f_raw.astype(jnp.float32)
    k = (1.0 - lb) * jax.nn.sigmoid(-z)
    log_f = jnp.logaddexp(jnp.log(jnp.maximum(lb, LB_FLOOR)),
                          jnp.log1p(-lb) + jax.nn.log_sigmoid(z))
    return k, log_f


def _hgrn2_branch(q_raw, ffwd_raw, fbwd_raw, i_raw, g_raw, lb_fwd, lb_bwd, gnorm_w):
    b, s, _ = q_raw.shape

    def heads(t):
        return t.reshape(b, s, HGRN_HEADS, -1).transpose(0, 2, 1, 3).astype(jnp.float32)

    def flip(t):
        return jnp.flip(t, axis=2)

    q = heads(jax.nn.silu(q_raw)) * (HGRN_KDIM ** -0.5)
    v = heads(i_raw)
    k_f, g_f = _hgrn2_forget(ffwd_raw, lb_fwd)
    k_b, g_b = _hgrn2_forget(fbwd_raw, lb_bwd)
    o_fwd = _gla_chunked(q, heads(k_f), v, heads(g_f))
    o_bwd = flip(_gla_chunked(flip(q), flip(heads(k_b)), flip(v), flip(heads(g_b))))
    o = (o_fwd + o_bwd).transpose(0, 2, 1, 3)
    o = _rmsnorm(o, gnorm_w).reshape(b, s, HGRN_HEADS * HGRN_VDIM)
    return (o * jax.nn.silu(g_raw.astype(jnp.float32))).astype(q_raw.dtype)


def _spatial_gating_branch(u_raw, v_raw, g_raw, ln_w, ln_b, w_s, b_s):
    b, s, _ = u_raw.shape
    u = jax.nn.gelu(u_raw)
    v = _layernorm(jax.nn.gelu(v_raw), ln_w, ln_b)
    vc = v.reshape(b, s // SG_CHUNK, SG_CHUNK, SG_GROUPS, SG_GROUP_CH)
    mixed = jnp.einsum('gts,bnsgc->bntgc', w_s, vc) + b_s.T[None, None, :, :, None]
    return u * mixed.reshape(b, s, SG_WIDTH) * jax.nn.silu(g_raw)


def setup_inputs(seed: int = 0) -> dict:
    key = jax.random.key(seed)
    ks = jax.random.split(key, 16)
    f32 = jnp.float32
    x = jax.random.normal(ks[0], (BATCH, SEQ, D_MODEL), f32)
    norm_w = 1.0 + 0.05 * jax.random.normal(ks[1], (DEPTH, D_MODEL), f32)
    w_in = jax.random.normal(ks[2], (DEPTH, D_MODEL, IN_WIDTH), f32) * D_MODEL ** -0.5
    lower_bounds = 0.1 * jax.random.normal(ks[3], (DEPTH, 2, HGRN_WIDTH), f32)
    gnorm_w = 1.0 + 0.05 * jax.random.normal(ks[4], (DEPTH, HGRN_VDIM), f32)
    ln_w = 1.0 + 0.05 * jax.random.normal(ks[5], (DEPTH, SG_WIDTH), f32)
    ln_b = 0.02 * jax.random.normal(ks[6], (DEPTH, SG_WIDTH), f32)
    w_s = jax.random.normal(ks[7], (DEPTH, SG_GROUPS, SG_CHUNK, SG_CHUNK), f32) * SG_CHUNK ** -0.5
    b_s = 1.0 + 0.1 * jax.random.normal(ks[8], (DEPTH, SG_GROUPS, SG_CHUNK), f32)
    w_proj_a = jax.random.normal(ks[9], (DEPTH, HGRN_WIDTH, D_MODEL), f32) * HGRN_WIDTH ** -0.5
    w_proj_b = jax.random.normal(ks[10], (DEPTH, SG_WIDTH, D_MODEL), f32) * SG_WIDTH ** -0.5
    w_out = jax.random.normal(ks[11], (DEPTH, D_MODEL, D_MODEL), f32) * D_MODEL ** -0.5
    final_norm_w = 1.0 + 0.05 * jax.random.normal(ks[12], (D_MODEL,), f32)
    return {"x": x, "norm_w": norm_w, "w_in": w_in, "lower_bounds": lower_bounds,
            "gnorm_w": gnorm_w, "ln_w": ln_w, "ln_b": ln_b, "w_s": w_s, "b_s": b_s,
            "w_proj_a": w_proj_a, "w_proj_b": w_proj_b, "w_out": w_out,
            "final_norm_w": final_norm_w}


def reference(x, norm_w, w_in, lower_bounds, gnorm_w, ln_w, ln_b, w_s, b_s,
              w_proj_a, w_proj_b, w_out, final_norm_w):
    lb = jax.nn.softmax(lower_bounds.astype(jnp.float32), axis=0)
    lb = jnp.cumsum(lb, axis=0) - lb[0]
    split_points = []
    acc = 0
    for size in IN_SPLITS[:-1]:
        acc += size
        split_points.append(acc)
    for layer in range(DEPTH):
        h = _rmsnorm(x, norm_w[layer])
        proj = jnp.einsum('bsd,de->bse', h, w_in[layer])
        (q_raw, ffwd_raw, fbwd_raw, i_raw, ga_raw,
         u_raw, v_raw, gb_raw, ma_raw, mb_raw) = jnp.split(proj, split_points, axis=-1)
        y_a = _hgrn2_branch(q_raw, ffwd_raw, fbwd_raw, i_raw, ga_raw,
                            lb[layer, 0], lb[layer, 1], gnorm_w[layer])
        y_b = _spatial_gating_branch(u_raw, v_raw, gb_raw, ln_w[layer], ln_b[layer],
                                     w_s[layer], b_s[layer])
        merged = (jax.nn.sigmoid(ma_raw) * jnp.einsum('bsw,wd->bsd', y_a, w_proj_a[layer])
                  + jax.nn.sigmoid(mb_raw) * jnp.einsum('bsw,wd->bsd', y_b, w_proj_b[layer]))
        x = x + jnp.einsum('bsd,de->bse', merged, w_out[layer])
    return _rmsnorm(x, final_norm_w)
```

```cpp
#include <hip/hip_runtime.h>
#include <hip/hip_cooperative_groups.h>
#include <cstdio>
namespace cg = cooperative_groups;

#define LAS __attribute__((address_space(3)))
#define DI __device__ __forceinline__
typedef unsigned short bf16_t;
typedef short bf16x8 __attribute__((ext_vector_type(8)));
typedef float f32x4 __attribute__((ext_vector_type(4)));
typedef float f32x2 __attribute__((ext_vector_type(2)));
typedef float f32x16 __attribute__((ext_vector_type(16)));
typedef unsigned u32x4 __attribute__((ext_vector_type(4)));
typedef unsigned u32x2 __attribute__((ext_vector_type(2)));
typedef __bf16 bf16v2 __attribute__((ext_vector_type(2)));

constexpr int D = 1024, SEQ = 4096, MH = 16384, M_ALL = 32768, DEPTH = 4, NIN = 10240;
constexpr int LDS_BYTES = 147456;
constexpr float LOG2E = 1.4426950408889634f;
constexpr size_t ARR = (size_t)MH * D;

constexpr size_t WS_WIN = 1ull << 20;
constexpr size_t WS_WA = WS_WIN + (size_t)DEPTH * NIN * D * 2;
constexpr size_t WS_WB = WS_WA + (size_t)DEPTH * D * D * 2;
constexpr size_t WS_WO = WS_WB + (size_t)DEPTH * D * D * 2;
constexpr size_t WS_H = WS_WO + (size_t)DEPTH * D * D * 2;
constexpr size_t WS_OUT9 = WS_H + (size_t)M_ALL * D * 2;
constexpr size_t WS_OF = WS_OUT9 + 9 * ARR * 2;
constexpr size_t WS_OB = WS_OF + ARR * 2;
constexpr size_t WS_END = WS_OB + ARR * 2;

DI unsigned pk2(float lo, float hi) { f32x2 v = {lo, hi}; bf16v2 r = __builtin_convertvector(v, bf16v2); return __builtin_bit_cast(unsigned, r); }
DI float bflo(unsigned w) { return __uint_as_float(w << 16); }
DI float bfhi(unsigned w) { return __uint_as_float(w & 0xffff0000u); }
DI float fexp2(float x) { return __builtin_amdgcn_exp2f(x); }
DI float frcp(float x) { return __builtin_amdgcn_rcpf(x); }
DI float sigmoidf_(float x) { return frcp(1.0f + fexp2(-x * LOG2E)); }
DI float siluf_(float x) { return x * sigmoidf_(x); }
DI float geluf_(float x) { const float t = x + 0.044715f * x * x * x; return x * frcp(1.0f + fexp2(-2.3022082f * t)); }
DI float wave_sum(float v) {
#pragma unroll
    for (int o = 1; o < 64; o <<= 1) v += __shfl_xor(v, o);
    return v;
}
#define LDS_WAIT() asm volatile("s_waitcnt lgkmcnt(0)" ::: "memory")
DI int opaque_tid() { int t = threadIdx.x; asm volatile("" : "+v"(t)); return t; }

namespace pg8 {
constexpr int BM = 256, BK = 64, HALF = 128, HTB = HALF * BK * 2, STAGE_BYTES = 8 * HTB, NXCD = 8, WGM = 8;
DI int lds_byte(int r, int c) { const int st = (r >> 4) * 2 + (c >> 5), rr = r & 15, cc = c & 31, ob = rr * 64 + cc * 2; return st * 1024 + (ob ^ (((ob >> 9) & 1) << 5)); }
DI void stage_rc(int b, int& R, int& C) { const int st = b / 1024, sb = b % 1024, swz = sb ^ (((sb >> 9) & 1) << 5); R = (st >> 1) * 16 + swz / 64; C = (st & 1) * 32 + (swz % 64) / 2; }
DI int perm32(int rho) { const int n = rho >> 4, i = rho & 15; return 8 * (i >> 2) + 4 * n + (i & 3); }

struct Unit { int pm, pn, sel; };
struct Gemm { const bf16_t* A0; const bf16_t* A1; const bf16_t* B0; const bf16_t* B1; int K; };
struct Order {
    int nM, nN, nwg, G, c, dual;
    DI void init(int M, int N, int G_, int c_, int dual_) { nM = M / BM; nN = N / BM; nwg = nM * nN; G = G_; c = c_; dual = dual_; }
    DI bool next(int i, Unit& u) const {
        const int ti = dual ? (i >> 1) : i; u.sel = dual ? (i & 1) : 0;
        const long L = (long)ti * G + c; if (L >= nwg) return false;
        int wgid = (int)L; { const int q = nwg / NXCD, r = nwg % NXCD, xcd = wgid % NXCD, off = wgid / NXCD; wgid = (xcd < r ? xcd * (q + 1) : r * (q + 1) + (xcd - r) * q) + off; }
        const int nig = WGM * nN, gid = wgid / nig, fm = gid * WGM, gsz = (nM - fm) < WGM ? (nM - fm) : WGM;
        u.pm = fm + ((wgid % nig) % gsz); u.pn = (wgid % nig) / gsz; return true;
    }
};

template <class Epi>
DI void gemm_phase(LAS unsigned char* lds, const Gemm g, const Order& S, const Epi& E) {
    const int tid = opaque_tid(), wid = __builtin_amdgcn_readfirstlane(tid >> 6), lane = tid & 63, wr = wid >> 2, wc = wid & 3, fr = lane & 15, fq = lane >> 4;
    const int K = g.K, nt = K / BK;
    unsigned voffA[2], voffB[2];
#pragma unroll
    for (int i = 0; i < 2; ++i) { int R, C; stage_rc(tid * 16 + i * 8192, R, C); const int Rb = Epi::PERM ? ((R & ~31) + perm32(R & 31)) : R;
        voffA[i] = (unsigned)(R * K + C) * 2u; voffB[i] = (unsigned)(Rb * K + C) * 2u; }
    const size_t kstep = (size_t)(BK * 2);
    const size_t hstep = (size_t)HALF * K * 2;
    const size_t tstep = 2 * hstep;
    const unsigned ldsw = (unsigned)wid * 1024u;
    const int aoff = lds_byte(wr * 64 + fr, fq * 8), boff = lds_byte(wc * 32 + fr, fq * 8);
#define PG8_SA(b, h) (((b) * 2 + (h)) * HTB)
#define PG8_SB(b, h) ((4 + (b) * 2 + (h)) * HTB)
#define PG8_STAGE(bufoff, gbase, voff) do { _Pragma("unroll") for (int _i = 0; _i < 2; ++_i) \
        __builtin_amdgcn_global_load_lds((const unsigned*)((const char*)(gbase) + (voff)[_i]), (LAS unsigned*)(lds + (bufoff) + ldsw + _i * 8192), 16, 0, 0); } while (0)
#define PG8_LDA(dst, b, h) do { _Pragma("unroll") for (int m = 0; m < 4; ++m) _Pragma("unroll") for (int k = 0; k < 2; ++k) dst[m][k] = *(const LAS bf16x8*)(lds + PG8_SA(b, h) + aoff + m * 2048 + k * 1024); } while (0)
#define PG8_LDB(dst, b, h) do { _Pragma("unroll") for (int n = 0; n < 2; ++n) _Pragma("unroll") for (int k = 0; k < 2; ++k) dst[n][k] = *(const LAS bf16x8*)(lds + PG8_SB(b, h) + boff + n * 2048 + k * 1024); } while (0)
#define PG8_MMA(ai, bj, At, Bt) do { __builtin_amdgcn_s_setprio(1); _Pragma("unroll") for (int m = 0; m < 4; ++m) _Pragma("unroll") for (int n = 0; n < 2; ++n) _Pragma("unroll") for (int k = 0; k < 2; ++k) \
        acc[ai][bj][m][n] = __builtin_amdgcn_mfma_f32_16x16x32_bf16(Bt[n][k], At[m][k], acc[ai][bj][m][n], 0, 0, 0); __builtin_amdgcn_s_setprio(0); } while (0)
#define PG8_WAIT_V(n) asm volatile("s_waitcnt vmcnt(" #n ")" ::: "memory")
#define PG8_WAIT_L(n) asm volatile("s_waitcnt lgkmcnt(" #n ")" ::: "memory")
#define PG8_BAR __builtin_amdgcn_s_barrier()
#define PG8_SCHED __builtin_amdgcn_sched_barrier(0)
    Unit cur, nxt; int ui = 0;
    if (!S.next(0, cur)) return;
    f32x4 acc[2][2][4][2];
#pragma unroll
    for (int a = 0; a < 2; ++a)
#pragma unroll
        for (int b = 0; b < 2; ++b)
#pragma unroll
            for (int m = 0; m < 4; ++m)
#pragma unroll
                for (int n = 0; n < 2; ++n) acc[a][b][m][n] = (f32x4){0.f, 0.f, 0.f, 0.f};
    bf16x8 At[4][2], B0[2][2], B1[2][2];
    const char* cA = (const char*)(cur.sel ? g.A1 : g.A0) + (size_t)cur.pm * tstep; const char* cB = (const char*)(cur.sel ? g.B1 : g.B0) + (size_t)cur.pn * tstep;
    PG8_STAGE(PG8_SB(0, 0), cB, voffB); PG8_STAGE(PG8_SB(0, 1), cB + hstep, voffB); PG8_STAGE(PG8_SA(0, 0), cA, voffA); PG8_STAGE(PG8_SA(0, 1), cA + hstep, voffA);
    if (wr == 1) PG8_BAR;
    PG8_WAIT_V(2); PG8_BAR;
    PG8_STAGE(PG8_SB(1, 0), cB + kstep, voffB); PG8_STAGE(PG8_SA(1, 0), cA + kstep, voffA); PG8_STAGE(PG8_SB(1, 1), cB + hstep + kstep, voffB);
    PG8_WAIT_V(6); PG8_BAR;
    for (;;) {
        const bool has_next = S.next(ui + 1, nxt);
        const char* nA = has_next ? (const char*)(nxt.sel ? g.A1 : g.A0) + (size_t)nxt.pm * tstep : cA; const char* nB = has_next ? (const char*)(nxt.sel ? g.B1 : g.B0) + (size_t)nxt.pn * tstep : cB;
        for (int t = 0; t < nt; t += 2) {
            const bool last = (t == nt - 2);
            const char* a1 = cA + (size_t)(t + 1) * kstep;
            const char* a2 = last ? nA : cA + (size_t)(t + 2) * kstep; const char* b2 = last ? nB : cB + (size_t)(t + 2) * kstep;
            const char* a3 = a2 + kstep; const char* b3 = b2 + kstep;
            PG8_LDB(B0, 0, 0); PG8_LDB(B1, 0, 1); PG8_SCHED; PG8_LDA(At, 0, 0); PG8_STAGE(PG8_SA(1, 1), a1 + hstep, voffA);
            PG8_WAIT_V(8); PG8_WAIT_L(0); PG8_BAR; PG8_MMA(0, 0, At, B0); PG8_MMA(0, 1, At, B1); PG8_BAR; PG8_SCHED;
            PG8_LDA(At, 0, 1); PG8_STAGE(PG8_SB(0, 0), b2, voffB); PG8_STAGE(PG8_SB(0, 1), b2 + hstep, voffB); PG8_STAGE(PG8_SA(0, 0), a2, voffA);
            PG8_WAIT_V(8); PG8_WAIT_L(0); PG8_BAR; PG8_MMA(1, 0, At, B0); PG8_MMA(1, 1, At, B1); PG8_BAR; PG8_SCHED;
            PG8_LDB(B0, 1, 0); PG8_LDB(B1, 1, 1); PG8_SCHED; PG8_LDA(At, 1, 0); PG8_STAGE(PG8_SA(0, 1), a2 + hstep, voffA);
            PG8_WAIT_V(8); PG8_WAIT_L(0); PG8_BAR; PG8_MMA(0, 0, At, B0); PG8_MMA(0, 1, At, B1); PG8_BAR; PG8_SCHED;
            PG8_LDA(At, 1, 1); PG8_STAGE(PG8_SB(1, 0), b3, voffB); PG8_STAGE(PG8_SB(1, 1), b3 + hstep, voffB); PG8_STAGE(PG8_SA(1, 0), a3, voffA);
            PG8_WAIT_V(8); PG8_WAIT_L(0); PG8_BAR; PG8_MMA(1, 0, At, B0); PG8_MMA(1, 1, At, B1); PG8_BAR; PG8_SCHED;
        }
        if (wr == 0) PG8_BAR;
        E(acc, cur, wr, wc, fr, fq);
        if (!has_next) break;
#pragma unroll
        for (int a = 0; a < 2; ++a)
#pragma unroll
            for (int b = 0; b < 2; ++b)
#pragma unroll
                for (int m = 0; m < 4; ++m)
#pragma unroll
                    for (int n = 0; n < 2; ++n) acc[a][b][m][n] = (f32x4){0.f, 0.f, 0.f, 0.f};
        cur = nxt; cA = nA; cB = nB; ++ui;
        if (wr == 1) PG8_BAR;
    }
    PG8_WAIT_V(0);
    PG8_BAR;
#undef PG8_SA
#undef PG8_SB
#undef PG8_STAGE
#undef PG8_LDA
#undef PG8_LDB
#undef PG8_MMA
#undef PG8_WAIT_V
#undef PG8_WAIT_L
#undef PG8_BAR
#undef PG8_SCHED
}
}

template <int ACT> DI float act_fn(float x) {
    if (ACT == 0) return x;
    if (ACT == 1) return siluf_(x) * 0.08838834764831845f;
    if (ACT == 2) return siluf_(x);
    if (ACT == 3) return geluf_(x);
    return sigmoidf_(x);
}
template <int ACT> DI void store_act(const f32x4 (&acc)[2][2][4][2], bf16_t* base, int row0, int col0) {
#pragma unroll
    for (int ai = 0; ai < 2; ++ai)
#pragma unroll
        for (int m = 0; m < 4; ++m) { bf16_t* rowp = base + (size_t)(row0 + ai * 128 + m * 16) * D + col0;
#pragma unroll
            for (int bj = 0; bj < 2; ++bj) { const f32x4 v0 = acc[ai][bj][m][0], v1 = acc[ai][bj][m][1];
                u32x4 w; w.x = pk2(act_fn<ACT>(v0[0]), act_fn<ACT>(v0[1])); w.y = pk2(act_fn<ACT>(v0[2]), act_fn<ACT>(v0[3]));
                w.z = pk2(act_fn<ACT>(v1[0]), act_fn<ACT>(v1[1])); w.w = pk2(act_fn<ACT>(v1[2]), act_fn<ACT>(v1[3]));
                *(u32x4*)(rowp + bj * 128) = w; } }
}
struct EpiInProj {
    static constexpr bool PERM = true;
    bf16_t* out9;
    DI void operator()(const f32x4 (&acc)[2][2][4][2], const pg8::Unit& u, int wr, int wc, int fr, int fq) const {
        const int pn = u.pn, row0 = u.pm * 256 + wr * 64 + fr, cl = wc * 32 + 8 * fq;
        if (pn >= 20 && pn < 28) {
            bf16_t* base = out9 + 5 * ARR; const int col0 = 128 * (pn - 20) + cl;
#pragma unroll
            for (int ai = 0; ai < 2; ++ai)
#pragma unroll
                for (int m = 0; m < 4; ++m) { bf16_t* rowp = base + (size_t)(row0 + ai * 128 + m * 16) * D + col0;
                    const f32x4 u0 = acc[ai][0][m][0], u1 = acc[ai][0][m][1], g0 = acc[ai][1][m][0], g1 = acc[ai][1][m][1];
                    u32x4 w; w.x = pk2(geluf_(u0[0]) * siluf_(g0[0]), geluf_(u0[1]) * siluf_(g0[1])); w.y = pk2(geluf_(u0[2]) * siluf_(g0[2]), geluf_(u0[3]) * siluf_(g0[3]));
                    w.z = pk2(geluf_(u1[0]) * siluf_(g1[0]), geluf_(u1[1]) * siluf_(g1[1])); w.w = pk2(geluf_(u1[2]) * siluf_(g1[2]), geluf_(u1[3]) * siluf_(g1[3]));
                    *(u32x4*)rowp = w; }
            return;
        }
        int idx, ct;
        if (pn < 20) { idx = pn >> 2; ct = pn & 3; } else if (pn < 32) { idx = 6; ct = pn - 28; } else { idx = 7 + ((pn - 32) >> 2); ct = (pn - 32) & 3; }
        bf16_t* base = out9 + (size_t)idx * ARR; const int col0 = 256 * ct + cl;
        if (idx == 0) store_act<1>(acc, base, row0, col0);
        else if (idx <= 3) store_act<0>(acc, base, row0, col0);
        else if (idx == 4) store_act<2>(acc, base, row0, col0);
        else if (idx == 6) store_act<3>(acc, base, row0, col0);
        else store_act<4>(acc, base, row0, col0);
    }
};
struct EpiProjAB {
    static constexpr bool PERM = true;
    const bf16_t* SMA; const bf16_t* SMB; bf16_t* MG;
    DI void operator()(const f32x4 (&acc)[2][2][4][2], const pg8::Unit& u, int wr, int wc, int fr, int fq) const {
        const int row0 = u.pm * 256 + wr * 64 + fr, col0 = u.pn * 256 + wc * 32 + 8 * fq;
        const bf16_t* gate = u.sel ? SMB : SMA;
#pragma unroll
        for (int ai = 0; ai < 2; ++ai)
#pragma unroll
            for (int m = 0; m < 4; ++m) { const size_t off = (size_t)(row0 + ai * 128 + m * 16) * D + col0;
#pragma unroll
                for (int bj = 0; bj < 2; ++bj) { const f32x4 v0 = acc[ai][bj][m][0], v1 = acc[ai][bj][m][1];
                    const u32x4 gw = *(const u32x4*)(gate + off + bj * 128);
                    float o[8] = {v0[0] * bflo(gw.x), v0[1] * bfhi(gw.x), v0[2] * bflo(gw.y), v0[3] * bfhi(gw.y), v1[0] * bflo(gw.z), v1[1] * bfhi(gw.z), v1[2] * bflo(gw.w), v1[3] * bfhi(gw.w)};
                    if (u.sel) { const u32x4 tw = *(const u32x4*)(MG + off + bj * 128);
                        o[0] += bflo(tw.x); o[1] += bfhi(tw.x); o[2] += bflo(tw.y); o[3] += bfhi(tw.y); o[4] += bflo(tw.z); o[5] += bfhi(tw.z); o[6] += bflo(tw.w); o[7] += bfhi(tw.w); }
                    u32x4 w; w.x = pk2(o[0], o[1]); w.y = pk2(o[2], o[3]); w.z = pk2(o[4], o[5]); w.w = pk2(o[6], o[7]);
                    *(u32x4*)(MG + off + bj * 128) = w; }
                asm volatile("" ::: "memory"); }
    }
};
struct EpiResid {
    static constexpr bool PERM = false;
    const float* xin; float* out;
    DI void operator()(const f32x4 (&acc)[2][2][4][2], const pg8::Unit& u, int wr, int wc, int fr, int fq) const {
        const int row0 = u.pm * 256 + wr * 64 + fr, col0 = u.pn * 256 + wc * 32 + 4 * fq;
#pragma unroll
        for (int ai = 0; ai < 2; ++ai)
#pragma unroll
            for (int m = 0; m < 4; ++m) { const size_t off = (size_t)(row0 + ai * 128 + m * 16) * D + col0;
#pragma unroll
                for (int bj = 0; bj < 2; ++bj)
#pragma unroll
                    for (int n = 0; n < 2; ++n) { const f32x4 xv = *(const f32x4*)(xin + off + bj * 128 + n * 16); *(f32x4*)(out + off + bj * 128 + n * 16) = xv + acc[ai][bj][m][n]; }
                asm volatile("" ::: "memory"); }
    }
};

DI int src_col(int nv) {
    if (nv < 5120) return nv;
    if (nv < 7168) { const int t = (nv - 5120) >> 8, w = (nv - 5120) & 255; return w < 128 ? 5120 + 128 * t + w : 7168 + 128 * t + (w - 128); }
    if (nv < 8192) return 6144 + (nv - 7168);
    return nv;
}
DI void transpose_item(const float* W, int N, bf16_t* WT, int k0, int nsrc0, int nvirt0, LAS float* scr, int lane) {
#pragma unroll 8
    for (int i = 0; i < 32; ++i) { const int kk = 2 * i + (lane >> 5); scr[kk * 33 + (lane & 31)] = W[(size_t)(k0 + kk) * N + nsrc0 + (lane & 31)]; }
    LDS_WAIT();
    const int c = lane & 7;
#pragma unroll
    for (int j = 0; j < 4; ++j) { const int n = (lane >> 3) + 8 * j; const LAS float* s = scr + (8 * c) * 33 + n;
        u32x4 o; o.x = pk2(s[0 * 33], s[1 * 33]); o.y = pk2(s[2 * 33], s[3 * 33]); o.z = pk2(s[4 * 33], s[5 * 33]); o.w = pk2(s[6 * 33], s[7 * 33]);
        *(u32x4*)(WT + (size_t)(nvirt0 + n) * D + k0 + 8 * c) = o; }
    LDS_WAIT();
}
DI void phase_prep(LAS unsigned char* lds, const float* w_in, const float* wa, const float* wb, const float* wo, unsigned char* ws, int G) {
    const int tid_ = opaque_tid(); const int lane = tid_ & 63, wave = __builtin_amdgcn_readfirstlane(tid_ >> 6);
    LAS float* scr = (LAS float*)(lds + wave * 16384);
    const int gw = blockIdx.x * 8 + wave, NGW = G * 8;
    constexpr int I_IN = 16 * 320, I_P = 16 * 32, PER_L = I_IN + 3 * I_P;
    for (int it = gw; it < DEPTH * PER_L; it += NGW) {
        const int l = it / PER_L; int r = it % PER_L;
        if (r < I_IN) { const int kb = r / 320, nb = r % 320; transpose_item(w_in + (size_t)l * D * NIN, NIN, (bf16_t*)(ws + WS_WIN) + (size_t)l * NIN * D, 64 * kb, src_col(32 * nb), 32 * nb, scr, lane); continue; }
        r -= I_IN; const int which = r / I_P; r %= I_P; const int kb = r / 32, nb = r % 32;
        const float* W = (which == 0 ? wa : which == 1 ? wb : wo) + (size_t)l * D * D;
        bf16_t* WT = (bf16_t*)(ws + (which == 0 ? WS_WA : which == 1 ? WS_WB : WS_WO)) + (size_t)l * D * D;
        transpose_item(W, D, WT, 64 * kb, 32 * nb, 32 * nb, scr, lane);
    }
}
DI void phase_rms_bf16(const float* x, const float* w, bf16_t* h, int nrows, int G) {
    const int tid_ = opaque_tid(); const int lane = tid_ & 63, wave = __builtin_amdgcn_readfirstlane(tid_ >> 6);
    const int gw = blockIdx.x * 8 + wave, NGW = G * 8;
    f32x4 wv[4];
#pragma unroll
    for (int j = 0; j < 4; ++j) wv[j] = ((const f32x4*)w)[lane + 64 * j];
    for (int m = gw; m < nrows; m += NGW) {
        const f32x4* xr = (const f32x4*)(x + (size_t)m * D) + lane; f32x4 v[4]; float s = 0.f;
#pragma unroll
        for (int j = 0; j < 4; ++j) { v[j] = xr[64 * j]; s += (v[j].x * v[j].x + v[j].y * v[j].y) + (v[j].z * v[j].z + v[j].w * v[j].w); }
        const float rstd = rsqrtf(wave_sum(s) * (1.0f / D) + 1e-6f);
        u32x2* o8 = (u32x2*)(h + (size_t)m * D) + lane;
#pragma unroll
        for (int j = 0; j < 4; ++j) { u32x2 o; o.x = pk2(v[j].x * rstd * wv[j].x, v[j].y * rstd * wv[j].y); o.y = pk2(v[j].z * rstd * wv[j].z, v[j].w * rstd * wv[j].w); o8[64 * j] = o; }
    }
}
DI void phase_final(float* x, const float* w, int nrows, int G) {
    const int tid_ = opaque_tid(); const int lane = tid_ & 63, wave = __builtin_amdgcn_readfirstlane(tid_ >> 6);
    const int gw = blockIdx.x * 8 + wave, NGW = G * 8;
    f32x4 wv[4];
#pragma unroll
    for (int j = 0; j < 4; ++j) wv[j] = ((const f32x4*)w)[lane + 64 * j];
    for (int m = gw; m < nrows; m += NGW) {
        f32x4* xr = (f32x4*)(x + (size_t)m * D) + lane; f32x4 v[4]; float s = 0.f;
#pragma unroll
        for (int j = 0; j < 4; ++j) { v[j] = xr[64 * j]; s += (v[j].x * v[j].x + v[j].y * v[j].y) + (v[j].z * v[j].z + v[j].w * v[j].w); }
        const float rstd = rsqrtf(wave_sum(s) * (1.0f / D) + 1e-6f);
#pragma unroll
        for (int j = 0; j < 4; ++j) xr[64 * j] = v[j] * rstd * wv[j];
    }
}
DI void phase_ya(const bf16_t* OF, const bf16_t* OB, const bf16_t* SGA, const float* gw_, bf16_t* YA, int G) {
    const int tid_ = opaque_tid(); const int lane = tid_ & 63, wave = __builtin_amdgcn_readfirstlane(tid_ >> 6);
    const int gw = blockIdx.x * 8 + wave, NGW = G * 8;
    f32x4 gv[4];
#pragma unroll
    for (int j = 0; j < 4; ++j) gv[j] = *(const f32x4*)(gw_ + ((16 * lane) & 127) + 4 * j);
    for (int m = gw; m < MH; m += NGW) {
        const size_t off = (size_t)m * D + 16 * lane;
        const u32x4 a0 = *(const u32x4*)(OF + off), a1 = *(const u32x4*)(OF + off + 8), b0 = *(const u32x4*)(OB + off), b1 = *(const u32x4*)(OB + off + 8);
        const u32x4 s0 = *(const u32x4*)(SGA + off), s1 = *(const u32x4*)(SGA + off + 8);
        const unsigned aw[8] = {a0.x, a0.y, a0.z, a0.w, a1.x, a1.y, a1.z, a1.w}, bw[8] = {b0.x, b0.y, b0.z, b0.w, b1.x, b1.y, b1.z, b1.w}, sw[8] = {s0.x, s0.y, s0.z, s0.w, s1.x, s1.y, s1.z, s1.w};
        float o[16]; float ss = 0.f;
#pragma unroll
        for (int w = 0; w < 8; ++w) { o[2 * w] = bflo(aw[w]) + bflo(bw[w]); o[2 * w + 1] = bfhi(aw[w]) + bfhi(bw[w]); ss += o[2 * w] * o[2 * w] + o[2 * w + 1] * o[2 * w + 1]; }
        ss += __shfl_xor(ss, 1); ss += __shfl_xor(ss, 2); ss += __shfl_xor(ss, 4);
        const float rstd = rsqrtf(ss * (1.0f / 128.0f) + 1e-6f);
        unsigned ow[8];
#pragma unroll
        for (int w = 0; w < 8; ++w) { const float g0 = gv[w >> 1][(2 * w) & 3], g1 = gv[w >> 1][(2 * w + 1) & 3];
            ow[w] = pk2(o[2 * w] * rstd * g0 * bflo(sw[w]), o[2 * w + 1] * rstd * g1 * bfhi(sw[w])); }
        *(u32x4*)(YA + off) = (u32x4){ow[0], ow[1], ow[2], ow[3]}; *(u32x4*)(YA + off + 8) = (u32x4){ow[4], ow[5], ow[6], ow[7]};
    }
}

#define MFMA32(a, b, c) __builtin_amdgcn_mfma_f32_32x32x16_bf16((a), (b), (c), 0, 0, 0)
DI void scan_item(LAS unsigned char* lds, const bf16_t* Q, const bf16_t* Z, const bf16_t* Iv, bf16_t* O, const float* lbraw, int layer, int b, int h, int dir, int dvq) {
    const int tid = opaque_tid(), lane = tid & 63, wave = __builtin_amdgcn_readfirstlane(tid >> 6);
    const int r = lane & 31, hh = lane >> 5, j = tid >> 3, cgp = tid & 7;
    LAS float* LF = (LAS float*)(lds); LAS float* GG = (LAS float*)(lds + 32768);
    LAS bf16_t* QS = (LAS bf16_t*)(lds + 65536);
    LAS bf16_t* KS = (LAS bf16_t*)(lds + 82944);
    LAS bf16_t* KT = (LAS bf16_t*)(lds + 100352);
    LAS bf16_t* VT = (LAS bf16_t*)(lds + 118784);
    LAS bf16_t* PS = (LAS bf16_t*)(lds + 123392);
    LAS bf16_t* ST = (LAS bf16_t*)(lds + 132608);
    LAS float* LBF = (LAS float*)(lds + 141312); LAS float* OML = LBF + 128;
    __syncthreads();
    if (tid < 128) {
        float v[4], mx = -1e30f;
#pragma unroll
        for (int l = 0; l < 4; ++l) { v[l] = lbraw[l * 2048 + tid]; mx = fmaxf(mx, v[l]); }
        float den = 0.f;
#pragma unroll
        for (int l = 0; l < 4; ++l) { v[l] = __expf(v[l] - mx); den += v[l]; }
        float lb = 0.f;
#pragma unroll
        for (int l = 1; l < 4; ++l) if (l <= layer) lb += v[l];
        lb = lb / den;
        LBF[tid] = fmaxf(lb, 1e-20f); OML[tid] = 1.0f - lb;
    }
    const size_t rowbase = (size_t)b * SEQ;
    const int coloff = h * 128 + 16 * cgp, vcol = h * 128 + dvq * 32 + 4 * cgp;
    u32x4 qv0, qv1, zv0, zv1; u32x2 vv;
    {
        const int c0 = dir ? 63 : 0; const size_t row = rowbase + c0 * 64 + (dir ? 63 - j : j);
        qv0 = *(const u32x4*)(Q + row * D + coloff); qv1 = *(const u32x4*)(Q + row * D + coloff + 8);
        zv0 = *(const u32x4*)(Z + row * D + coloff); zv1 = *(const u32x4*)(Z + row * D + coloff + 8);
        vv = *(const u32x2*)(Iv + row * D + vcol);
    }
    __syncthreads();
    f32x16 S;
#pragma unroll
    for (int i = 0; i < 16; ++i) S[i] = 0.f;
    for (int st = 0; st < 64; ++st) {
        const int c = dir ? 63 - st : st;
        float kk[16];
        {
            f32x4 lf4[4];
            const unsigned zw[8] = {zv0.x, zv0.y, zv0.z, zv0.w, zv1.x, zv1.y, zv1.z, zv1.w};
#pragma unroll
            for (int q4 = 0; q4 < 4; ++q4) {
                const f32x4 lb4 = *(const LAS f32x4*)(LBF + 16 * cgp + 4 * q4), om4 = *(const LAS f32x4*)(OML + 16 * cgp + 4 * q4);
#pragma unroll
                for (int e4 = 0; e4 < 4; ++e4) { const int idx = 4 * q4 + e4; const unsigned w = zw[idx >> 1];
                    float z = (idx & 1) ? bfhi(w) : bflo(w); z = fminf(fmaxf(z, -30.f), 30.f);
                    const float e = fexp2(-z * LOG2E), sg = frcp(1.0f + e);
                    const float f = lb4[e4] + om4[e4] * sg; kk[idx] = om4[e4] * e * sg; lf4[q4][e4] = __builtin_amdgcn_logf(f); }
                *(LAS f32x4*)(LF + j * 128 + 16 * cgp + 4 * q4) = lf4[q4];
            }
        }
        __syncthreads();
        {
            const int ch = tid & 127, qt = wave >> 1; float s = 0.f;
            for (int blk = 0; blk <= qt; ++blk) {
                float v[16];
#pragma unroll
                for (int i = 0; i < 16; ++i) v[i] = LF[(16 * blk + i) * 128 + ch];
#pragma unroll
                for (int i = 0; i < 16; ++i) { s += v[i]; v[i] = s; }
                if (blk == qt) {
#pragma unroll
                    for (int i = 0; i < 16; ++i) GG[(16 * blk + i) * 128 + ch] = v[i];
                }
            }
        }
        __syncthreads();
        {
            const unsigned qw[8] = {qv0.x, qv0.y, qv0.z, qv0.w, qv1.x, qv1.y, qv1.z, qv1.w};
            unsigned qo[8], ko[8];
#pragma unroll
            for (int q4 = 0; q4 < 4; ++q4) {
                const f32x4 g4 = *(const LAS f32x4*)(GG + j * 128 + 16 * cgp + 4 * q4), r4 = *(const LAS f32x4*)(GG + 31 * 128 + 16 * cgp + 4 * q4);
                float qt_[4], kt_[4];
#pragma unroll
                for (int e4 = 0; e4 < 4; ++e4) { const int idx = 4 * q4 + e4; const unsigned w = qw[idx >> 1]; const float qf = (idx & 1) ? bfhi(w) : bflo(w);
                    const float dq = g4[e4] - r4[e4];
                    qt_[e4] = qf * fexp2(fminf(dq, 100.f)); kt_[e4] = kk[idx] * fexp2(fminf(-dq, 100.f)); }
                qo[2 * q4] = pk2(qt_[0], qt_[1]); qo[2 * q4 + 1] = pk2(qt_[2], qt_[3]); ko[2 * q4] = pk2(kt_[0], kt_[1]); ko[2 * q4 + 1] = pk2(kt_[2], kt_[3]);
            }
            *(LAS u32x4*)(QS + j * 136 + 16 * cgp) = (u32x4){qo[0], qo[1], qo[2], qo[3]}; *(LAS u32x4*)(QS + j * 136 + 16 * cgp + 8) = (u32x4){qo[4], qo[5], qo[6], qo[7]};
            *(LAS u32x4*)(KS + j * 136 + 16 * cgp) = (u32x4){ko[0], ko[1], ko[2], ko[3]}; *(LAS u32x4*)(KS + j * 136 + 16 * cgp + 8) = (u32x4){ko[4], ko[5], ko[6], ko[7]};
#pragma unroll
            for (int w = 0; w < 8; ++w) { KT[(16 * cgp + 2 * w) * 72 + j] = (bf16_t)(ko[w] & 0xffffu); KT[(16 * cgp + 2 * w + 1) * 72 + j] = (bf16_t)(ko[w] >> 16); }
            VT[(4 * cgp + 0) * 72 + j] = (bf16_t)(vv.x & 0xffffu); VT[(4 * cgp + 1) * 72 + j] = (bf16_t)(vv.x >> 16);
            VT[(4 * cgp + 2) * 72 + j] = (bf16_t)(vv.y & 0xffffu); VT[(4 * cgp + 3) * 72 + j] = (bf16_t)(vv.y >> 16);
            if (st < 63) {
                const int cn = dir ? c - 1 : c + 1; const size_t row = rowbase + cn * 64 + (dir ? 63 - j : j);
                qv0 = *(const u32x4*)(Q + row * D + coloff); qv1 = *(const u32x4*)(Q + row * D + coloff + 8);
                zv0 = *(const u32x4*)(Z + row * D + coloff); zv1 = *(const u32x4*)(Z + row * D + coloff + 8);
                vv = *(const u32x2*)(Iv + row * D + vcol);
            }
        }
        __syncthreads();
        if (wave < 4) {
            const int d = 32 * wave + r;
            const float g31 = GG[31 * 128 + d], g63 = GG[63 * 128 + d];
            const float e1 = fexp2(g31), e2 = fexp2(g63 - g31);
#pragma unroll
            for (int i = 0; i < 16; ++i) { S[i] *= e1; }
#pragma unroll
            for (int i = 0; i < 16; i += 2) { const unsigned p = pk2(S[i], S[i + 1]); const int v0 = (i & 3) + 8 * (i >> 2) + 4 * hh;
                ST[v0 * 136 + d] = (bf16_t)(p & 0xffffu); ST[(v0 + 1) * 136 + d] = (bf16_t)(p >> 16); }
#pragma unroll
            for (int ks = 0; ks < 4; ++ks) { const bf16x8 a = *(const LAS bf16x8*)(VT + r * 72 + 16 * ks + 8 * hh), bb = *(const LAS bf16x8*)(KT + d * 72 + 16 * ks + 8 * hh); S = MFMA32(a, bb, S); }
#pragma unroll
            for (int i = 0; i < 16; ++i) S[i] *= e2;
        } else if (wave < 7) {
            const int tm = (wave == 6) ? 1 : 0, tn = (wave == 4) ? 0 : 1;
            f32x16 acc;
#pragma unroll
            for (int i = 0; i < 16; ++i) acc[i] = 0.f;
#pragma unroll
            for (int ks = 0; ks < 8; ++ks) { const bf16x8 a = *(const LAS bf16x8*)(KS + (32 * tm + r) * 136 + 16 * ks + 8 * hh), bb = *(const LAS bf16x8*)(QS + (32 * tn + r) * 136 + 16 * ks + 8 * hh); acc = MFMA32(a, bb, acc); }
            const int t = 32 * tn + r;
#pragma unroll
            for (int g = 0; g < 4; ++g) { const int s0 = 32 * tm + 8 * g + 4 * hh;
                const float p0 = (s0 + 0 <= t) ? acc[4 * g + 0] : 0.f, p1 = (s0 + 1 <= t) ? acc[4 * g + 1] : 0.f, p2 = (s0 + 2 <= t) ? acc[4 * g + 2] : 0.f, p3 = (s0 + 3 <= t) ? acc[4 * g + 3] : 0.f;
                *(LAS u32x2*)(PS + t * 72 + s0) = (u32x2){pk2(p0, p1), pk2(p2, p3)}; }
        }
        __syncthreads();
        if (wave == 4 || wave == 5) {
            const int tn = wave - 4;
            f32x16 acc;
#pragma unroll
            for (int i = 0; i < 16; ++i) acc[i] = 0.f;
#pragma unroll
            for (int ks = 0; ks < 4; ++ks) { if (ks < 2 * (tn + 1)) { const bf16x8 a = *(const LAS bf16x8*)(VT + r * 72 + 16 * ks + 8 * hh), bb = *(const LAS bf16x8*)(PS + (32 * tn + r) * 72 + 16 * ks + 8 * hh); acc = MFMA32(a, bb, acc); } }
#pragma unroll
            for (int ks = 0; ks < 8; ++ks) { const bf16x8 a = *(const LAS bf16x8*)(ST + r * 136 + 16 * ks + 8 * hh), bb = *(const LAS bf16x8*)(QS + (32 * tn + r) * 136 + 16 * ks + 8 * hh); acc = MFMA32(a, bb, acc); }
            const int jj = 32 * tn + r; const size_t row = rowbase + c * 64 + (dir ? 63 - jj : jj);
            bf16_t* op = O + row * D + h * 128 + dvq * 32 + 4 * hh;
#pragma unroll
            for (int g = 0; g < 4; ++g) *(u32x2*)(op + 8 * g) = (u32x2){pk2(acc[4 * g], acc[4 * g + 1]), pk2(acc[4 * g + 2], acc[4 * g + 3])};
        }
    }
}

DI void spatial_item(LAS unsigned char* lds, const bf16_t* GV, bf16_t* UG, const float* ln_w, const float* ln_b, const float* w_s, const float* b_s, int b, int n) {
    const int tid = opaque_tid(), lane = tid & 63, wave = __builtin_amdgcn_readfirstlane(tid >> 6);
    const int r = lane & 31, hh = lane >> 5;
    LAS f32x2* STAT = (LAS f32x2*)(lds);
    LAS bf16_t* VL = (LAS bf16_t*)(lds + 1024);
    LAS bf16_t* WS = (LAS bf16_t*)(lds + 1024 + 34816);
    const size_t rowbase = (size_t)b * SEQ + (size_t)n * 128;
    __syncthreads();
    for (int i = 0; i < 16; ++i) {
        const int s = wave * 16 + i; const bf16_t* p = GV + (rowbase + s) * D + 16 * lane;
        const u32x4 a0 = *(const u32x4*)p, a1 = *(const u32x4*)(p + 8);
        const unsigned aw[8] = {a0.x, a0.y, a0.z, a0.w, a1.x, a1.y, a1.z, a1.w};
        float s1 = 0.f, s2 = 0.f;
#pragma unroll
        for (int w = 0; w < 8; ++w) { const float x0 = bflo(aw[w]), x1 = bfhi(aw[w]); s1 += x0 + x1; s2 += x0 * x0 + x1 * x1; }
        s1 = wave_sum(s1); s2 = wave_sum(s2);
        const float mean = s1 * (1.0f / D), var = fmaxf(s2 * (1.0f / D) - mean * mean, 0.f);
        if (lane == 0) STAT[s] = (f32x2){mean, rsqrtf(var + 1e-5f)};
    }
    __syncthreads();
    for (int g = 0; g < 8; ++g) {
        {
            const int s = tid >> 2, cq = tid & 3; const f32x2 st = STAT[s];
            const bf16_t* p = GV + (rowbase + s) * D + 128 * g + 32 * cq;
#pragma unroll
            for (int q = 0; q < 4; ++q) { const u32x4 a = *(const u32x4*)(p + 8 * q); const unsigned aw[4] = {a.x, a.y, a.z, a.w};
                const f32x4 w0 = *(const f32x4*)(ln_w + 128 * g + 32 * cq + 8 * q), w1 = *(const f32x4*)(ln_w + 128 * g + 32 * cq + 8 * q + 4);
                const f32x4 c0 = *(const f32x4*)(ln_b + 128 * g + 32 * cq + 8 * q), c1 = *(const f32x4*)(ln_b + 128 * g + 32 * cq + 8 * q + 4);
                const float wv[8] = {w0.x, w0.y, w0.z, w0.w, w1.x, w1.y, w1.z, w1.w}, bv[8] = {c0.x, c0.y, c0.z, c0.w, c1.x, c1.y, c1.z, c1.w};
#pragma unroll
                for (int w = 0; w < 4; ++w) { const float y0 = (bflo(aw[w]) - st.x) * st.y * wv[2 * w] + bv[2 * w], y1 = (bfhi(aw[w]) - st.x) * st.y * wv[2 * w + 1] + bv[2 * w + 1];
                    const unsigned pk = pk2(y0, y1); const int c = 32 * cq + 8 * q + 2 * w;
                    VL[c * 136 + s] = (bf16_t)(pk & 0xffffu); VL[(c + 1) * 136 + s] = (bf16_t)(pk >> 16); } }
            const int t = tid >> 2, sq = tid & 3; const float* wp = w_s + ((size_t)g * 128 + t) * 128 + 32 * sq;
#pragma unroll
            for (int q = 0; q < 4; ++q) { const f32x4 x0 = *(const f32x4*)(wp + 8 * q), x1 = *(const f32x4*)(wp + 8 * q + 4);
                *(LAS u32x4*)(WS + t * 136 + 32 * sq + 8 * q) = (u32x4){pk2(x0.x, x0.y), pk2(x0.z, x0.w), pk2(x1.x, x1.y), pk2(x1.z, x1.w)}; }
        }
        __syncthreads();
        {
            const int cm = wave & 3;
#pragma unroll
            for (int tt = 0; tt < 2; ++tt) {
                const int tn = 2 * (wave >> 2) + tt;
                f32x16 acc;
#pragma unroll
                for (int i = 0; i < 16; ++i) acc[i] = 0.f;
#pragma unroll
                for (int ks = 0; ks < 8; ++ks) { const bf16x8 a = *(const LAS bf16x8*)(VL + (32 * cm + r) * 136 + 16 * ks + 8 * hh), bb = *(const LAS bf16x8*)(WS + (32 * tn + r) * 136 + 16 * ks + 8 * hh); acc = MFMA32(a, bb, acc); }
                const int t = 32 * tn + r; const float bias = b_s[g * 128 + t];
                bf16_t* up = UG + (rowbase + t) * D + 128 * g + 32 * cm + 4 * hh;
#pragma unroll
                for (int q = 0; q < 4; ++q) { const u32x2 uw = *(const u32x2*)(up + 8 * q);
                    *(u32x2*)(up + 8 * q) = (u32x2){pk2(bflo(uw.x) * (acc[4 * q] + bias), bfhi(uw.x) * (acc[4 * q + 1] + bias)), pk2(bflo(uw.y) * (acc[4 * q + 2] + bias), bfhi(uw.y) * (acc[4 * q + 3] + bias))}; }
            }
        }
        __syncthreads();
    }
}

struct Args { const float* in[13]; float* out; unsigned char* ws; int ph_lo, ph_hi; };
constexpr int NPH = 46;

__global__ void __launch_bounds__(512, 2) mega(Args a) {
    extern __shared__ __attribute__((aligned(16))) unsigned char shm[];
    LAS unsigned char* lds = (LAS unsigned char*)shm;
    cg::grid_group grid = cg::this_grid();
    const int G = gridDim.x, blk = blockIdx.x;
    unsigned char* ws = a.ws;
    const float* x0 = a.in[0];
    bf16_t* Hb = (bf16_t*)(ws + WS_H); bf16_t* out9 = (bf16_t*)(ws + WS_OUT9);
    bf16_t* Qb = out9, *ZFb = out9 + ARR, *ZBb = out9 + 2 * ARR, *Ib = out9 + 3 * ARR, *SGAb = out9 + 4 * ARR, *UGb = out9 + 5 * ARR, *GVb = out9 + 6 * ARR, *SMAb = out9 + 7 * ARR, *SMBb = out9 + 8 * ARR;
    bf16_t* OFb = (bf16_t*)(ws + WS_OF); bf16_t* OBb = (bf16_t*)(ws + WS_OB);
    bf16_t* MGb = Qb;
    for (int ph = a.ph_lo; ph < a.ph_hi; ++ph) {
        if (ph > a.ph_lo) grid.sync();
        if (ph == 0) { phase_prep(lds, a.in[2], a.in[9], a.in[10], a.in[11], ws, G); continue; }
        if (ph == NPH - 1) { phase_final(a.out, a.in[12], M_ALL, G); continue; }
        const int q = ph - 1, l = q / 11, rr = q % 11;
        const float* xin = (l == 0) ? x0 : a.out;
        if (rr == 0) { phase_rms_bf16(xin, a.in[1] + l * D, Hb, M_ALL, G); continue; }
        const int hf = (rr - 1) / 5, k = (rr - 1) % 5;
        bf16_t* Hh = Hb + (size_t)hf * ARR;
        if (k == 0) {
            pg8::Gemm g{Hh, Hh, (const bf16_t*)(ws + WS_WIN) + (size_t)l * NIN * D, (const bf16_t*)(ws + WS_WIN) + (size_t)l * NIN * D, D};
            pg8::Order S; S.init(MH, NIN, G, blk, 0);
            EpiInProj E{out9};
            pg8::gemm_phase<EpiInProj>(lds, g, S, E);
        } else if (k == 1) {
            for (int it = blk; it < 256; it += G) {
                const int xcd = it & 7, idx = it >> 3, grp = xcd * 8 + (idx >> 2), dvq = idx & 3;
                const int b = grp >> 4, h = (grp >> 1) & 7, dir = grp & 1;
                scan_item(lds, Qb, dir ? ZBb : ZFb, Ib, dir ? OBb : OFb, a.in[3] + dir * 1024 + h * 128, l, b, h, dir, dvq);
            }
            for (int it = blk; it < 128; it += G)
                spatial_item(lds, GVb, UGb, a.in[5] + l * D, a.in[6] + l * D, a.in[7] + (size_t)l * 8 * 128 * 128, a.in[8] + l * 8 * 128, it >> 5, it & 31);
        } else if (k == 2) {
            phase_ya(OFb, OBb, SGAb, a.in[4] + l * 128, Hh, G);
        } else if (k == 3) {
            pg8::Gemm g{Hh, UGb, (const bf16_t*)(ws + WS_WA) + (size_t)l * D * D, (const bf16_t*)(ws + WS_WB) + (size_t)l * D * D, D};
            pg8::Order S; S.init(MH, D, G, blk, 1);
            EpiProjAB E{SMAb, SMBb, MGb};
            pg8::gemm_phase<EpiProjAB>(lds, g, S, E);
        } else {
            pg8::Gemm g{MGb, MGb, (const bf16_t*)(ws + WS_WO) + (size_t)l * D * D, (const bf16_t*)(ws + WS_WO) + (size_t)l * D * D, D};
            pg8::Order S; S.init(MH, D, G, blk, 0);
            EpiResid E{xin + (size_t)hf * ARR, a.out + (size_t)hf * ARR};
            pg8::gemm_phase<EpiResid>(lds, g, S, E);
        }
    }
}

extern "C" void kernel_launch(void* const* d_in, const int* in_sizes, int n_in, void* d_out, int out_size, void* d_ws, size_t ws_size, hipStream_t stream) {
    static int grid = 0;
    if (grid == 0) {
        if (n_in != 13 || ws_size < WS_END) { fprintf(stderr, "kernel_launch: unexpected inputs (n_in %d, ws %zu, need %zu)\n", n_in, ws_size, (size_t)WS_END); grid = -1; return; }
        int dev = 0, cus = 0, per_cu = 0;
        hipGetDevice(&dev); hipDeviceGetAttribute(&cus, hipDeviceAttributeMultiprocessorCount, dev);
        if (hipFuncSetAttribute((const void*)mega, hipFuncAttributeMaxDynamicSharedMemorySize, LDS_BYTES) != hipSuccess) { fprintf(stderr, "kernel_launch: hipFuncSetAttribute failed\n"); grid = -1; return; }
        if (hipOccupancyMaxActiveBlocksPerMultiprocessor(&per_cu, (const void*)mega, 512, LDS_BYTES) != hipSuccess || per_cu < 1) { fprintf(stderr, "kernel_launch: occupancy query gave %d\n", per_cu); per_cu = 1; }
        (void)hipGetLastError();
        grid = cus * 1;
        fprintf(stderr, "kernel_launch: cus %d per_cu %d grid %d\n", cus, per_cu, grid);
    }
    if (grid < 0) return;
    Args a{};
    for (int i = 0; i < 13; ++i) a.in[i] = (const float*)d_in[i];
    a.out = (float*)d_out; a.ws = (unsigned char*)d_ws; a.ph_lo = 0; a.ph_hi = NPH;
    void* args[] = {&a};
    hipError_t e = hipLaunchCooperativeKernel((const void*)mega, dim3(grid), dim3(512), args, LDS_BYTES, stream);
    if (e != hipSuccess) fprintf(stderr, "kernel_launch: cooperative launch failed: %s (grid %d)\n", hipGetErrorString(e), grid);
}
```

```cpp
#include <hip/hip_runtime.h>
#include <hip/hip_cooperative_groups.h>
#include <cstdio>
namespace cg = cooperative_groups;

#define LAS __attribute__((address_space(3)))
#define DI __device__ __forceinline__
typedef unsigned short bf16_t;
typedef short bf16x8 __attribute__((ext_vector_type(8)));
typedef float f32x4 __attribute__((ext_vector_type(4)));
typedef float f32x2 __attribute__((ext_vector_type(2)));
typedef float f32x16 __attribute__((ext_vector_type(16)));
typedef unsigned u32x4 __attribute__((ext_vector_type(4)));
typedef unsigned u32x2 __attribute__((ext_vector_type(2)));
typedef __bf16 bf16v2 __attribute__((ext_vector_type(2)));

constexpr int D = 1024, SEQ = 4096, MH = 16384, M_ALL = 32768, DEPTH = 4, NIN = 10240;
constexpr int LDS_BYTES = 147456;
constexpr float LOG2E = 1.4426950408889634f;
constexpr size_t ARR = (size_t)MH * D;

constexpr size_t WS_WIN = 1ull << 20;
constexpr size_t WS_WA = WS_WIN + (size_t)DEPTH * NIN * D * 2;
constexpr size_t WS_WB = WS_WA + (size_t)DEPTH * D * D * 2;
constexpr size_t WS_WO = WS_WB + (size_t)DEPTH * D * D * 2;
constexpr size_t WS_H = WS_WO + (size_t)DEPTH * D * D * 2;
constexpr size_t WS_OUT9 = WS_H + (size_t)M_ALL * D * 2;
constexpr size_t WS_OF = WS_OUT9 + 9 * ARR * 2;
constexpr size_t WS_OB = WS_OF + ARR * 2;
constexpr size_t WS_END = WS_OB + ARR * 2;

DI unsigned pk2(float lo, float hi) { f32x2 v = {lo, hi}; bf16v2 r = __builtin_convertvector(v, bf16v2); return __builtin_bit_cast(unsigned, r); }
DI float bflo(unsigned w) { return __uint_as_float(w << 16); }
DI float bfhi(unsigned w) { return __uint_as_float(w & 0xffff0000u); }
DI float fexp2(float x) { return __builtin_amdgcn_exp2f(x); }
DI float frcp(float x) { return __builtin_amdgcn_rcpf(x); }
DI float sigmoidf_(float x) { return frcp(1.0f + fexp2(-x * LOG2E)); }
DI float siluf_(float x) { return x * sigmoidf_(x); }
DI float geluf_(float x) { const float t = x + 0.044715f * x * x * x; return x * frcp(1.0f + fexp2(-2.3022082f * t)); }
DI float wave_sum(float v) {
#pragma unroll
    for (int o = 1; o < 64; o <<= 1) v += __shfl_xor(v, o);
    return v;
}
#define LDS_WAIT() asm volatile("s_waitcnt lgkmcnt(0)" ::: "memory")
DI int opaque_tid() { int t = threadIdx.x; asm volatile("" : "+v"(t)); return t; }


#define XB_TMO      128
#define XB_XCNT(j)  (256  + 64 * (j))
#define XB_XSUB(j)  (1280 + 64 * (j))
#define XB_XGEN(j)  (2304 + 64 * (j))
#define XB_TOP      3328
#define XB_TOPGEN   3392
#define XCD_BAR_WORDS 3456
#define XB_SPIN_CAP (1u << 18)
DI unsigned xb_ld(unsigned* p)              { return __hip_atomic_load(p, __ATOMIC_RELAXED, __HIP_MEMORY_SCOPE_AGENT); }
DI unsigned xb_add(unsigned* p, unsigned v) { return __hip_atomic_fetch_add(p, v, __ATOMIC_RELAXED, __HIP_MEMORY_SCOPE_AGENT); }
DI unsigned xb_xcc_id() { return (unsigned)__builtin_amdgcn_s_getreg((3 << 11) | 20) & 0xFu; }
#define XB_SPIN(cond, bar) do { unsigned _sp = 0; while (cond) { __builtin_amdgcn_s_sleep(1); \
    if ((++_sp & 255u) == 0u) { if (xb_ld(&(bar)[XB_TMO])) break; if (_sp > XB_SPIN_CAP) { atomicAdd(&(bar)[XB_TMO], 1u); break; } } } } while (0)
struct XcdBarrier { unsigned* bar; unsigned x; volatile LAS unsigned* st; };
DI XcdBarrier xcd_barrier_post(unsigned* bar, volatile LAS unsigned* st) {
    XcdBarrier b; b.bar = bar; b.x = xb_xcc_id(); b.st = st;
    if (threadIdx.x == 0) (void)xb_add(&bar[XB_XCNT(b.x)], 1u);
    return b;
}
DI void xcd_barrier_complete(unsigned* bar, unsigned x, unsigned& nloc, unsigned& nx) {
    const unsigned G = gridDim.x * gridDim.y * gridDim.z;
    unsigned sum, cnt, mine, sp = 0u;
    for (;;) {
        sum = 0u; cnt = 0u; mine = 0u;
#pragma unroll
        for (unsigned j = 0; j < 16; ++j) { const unsigned c = xb_ld(&bar[XB_XCNT(j)]); sum += c; cnt += (c > 0u) ? 1u : 0u; mine = (j == x) ? c : mine; }
        if (sum == G) break;
        __builtin_amdgcn_s_sleep(1);
        if ((++sp & 255u) == 0u) { if (xb_ld(&bar[XB_TMO])) break; if (sp > XB_SPIN_CAP) { atomicAdd(&bar[XB_TMO], 1u); break; } }
    }
    nloc = mine > 0u ? mine : 1u; nx = cnt > 0u ? cnt : 1u;
}
DI void xcd_barrier(const XcdBarrier& b) {
    asm volatile("s_waitcnt vmcnt(0)" ::: "memory");
    __syncthreads();
    if (threadIdx.x == 0) {
        unsigned* bar = b.bar;
        __builtin_amdgcn_s_waitcnt(0);
        unsigned nloc = b.st[0], nx = b.st[1];
        if (nloc == 0u) { xcd_barrier_complete(bar, b.x, nloc, nx); b.st[0] = nloc; b.st[1] = nx; }
        const unsigned old = xb_add(&bar[XB_XSUB(b.x)], 1u);
        const unsigned gen = old / nloc;
        if (old + 1u == (gen + 1u) * nloc) {
            __builtin_amdgcn_fence(__ATOMIC_RELEASE, "agent");
            asm volatile("s_waitcnt vmcnt(0)" ::: "memory");
            const unsigned og = xb_add(&bar[XB_TOP], 1u);
            const unsigned tg = og / nx;
            if (og + 1u == (tg + 1u) * nx) xb_add(&bar[XB_TOPGEN], 1u);
            else XB_SPIN(xb_ld(&bar[XB_TOPGEN]) == tg, bar);
            __builtin_amdgcn_fence(__ATOMIC_ACQUIRE, "agent");
            xb_add(&bar[XB_XGEN(b.x)], 1u);
            asm volatile("s_waitcnt vmcnt(0)" ::: "memory");
        } else {
            XB_SPIN(xb_ld(&bar[XB_XGEN(b.x)]) == gen, bar);
            __builtin_amdgcn_fence(__ATOMIC_ACQUIRE, "agent");
            asm volatile("s_waitcnt vmcnt(0)" ::: "memory");
        }
    }
    __syncthreads();
}

namespace pg8 {
constexpr int BM = 256, BK = 64, HALF = 128, HTB = HALF * BK * 2, STAGE_BYTES = 8 * HTB, NXCD = 8, WGM = 8;
DI int lds_byte(int r, int c) { const int st = (r >> 4) * 2 + (c >> 5), rr = r & 15, cc = c & 31, ob = rr * 64 + cc * 2; return st * 1024 + (ob ^ (((ob >> 9) & 1) << 5)); }
DI void stage_rc(int b, int& R, int& C) { const int st = b / 1024, sb = b % 1024, swz = sb ^ (((sb >> 9) & 1) << 5); R = (st >> 1) * 16 + swz / 64; C = (st & 1) * 32 + (swz % 64) / 2; }
DI int perm32(int rho) { const int n = rho >> 4, i = rho & 15; return 8 * (i >> 2) + 4 * n + (i & 3); }

struct Unit { int pm, pn, sel; };
struct Gemm { const bf16_t* A0; const bf16_t* A1; const bf16_t* B0; const bf16_t* B1; int K; };
struct Order {
    int nM, nN, nwg, G, c, dual;
    DI void init(int M, int N, int G_, int c_, int dual_) { nM = M / BM; nN = N / BM; nwg = nM * nN; G = G_; c = c_; dual = dual_; }
    DI bool next(int i, Unit& u) const {
        const int ti = dual ? (i >> 1) : i; u.sel = dual ? (i & 1) : 0;
        const long L = (long)ti * G + c; if (L >= nwg) return false;
        int wgid = (int)L; { const int q = nwg / NXCD, r = nwg % NXCD, xcd = wgid % NXCD, off = wgid / NXCD; wgid = (xcd < r ? xcd * (q + 1) : r * (q + 1) + (xcd - r) * q) + off; }
        const int nig = WGM * nN, gid = wgid / nig, fm = gid * WGM, gsz = (nM - fm) < WGM ? (nM - fm) : WGM;
        u.pm = fm + ((wgid % nig) % gsz); u.pn = (wgid % nig) / gsz; return true;
    }
};

template <class Epi>
DI void gemm_phase(LAS unsigned char* lds, const Gemm g, const Order& S, const Epi& E) {
    const int tid = opaque_tid(), wid = __builtin_amdgcn_readfirstlane(tid >> 6), lane = tid & 63, wr = wid >> 2, wc = wid & 3, fr = lane & 15, fq = lane >> 4;
    const int K = g.K, nt = K / BK;
    unsigned voffA[2], voffB[2];
#pragma unroll
    for (int i = 0; i < 2; ++i) { int R, C; stage_rc(tid * 16 + i * 8192, R, C); const int Rb = Epi::PERM ? ((R & ~31) + perm32(R & 31)) : R;
        voffA[i] = (unsigned)(R * K + C) * 2u; voffB[i] = (unsigned)(Rb * K + C) * 2u; }
    const size_t kstep = (size_t)(BK * 2);
    const size_t hstep = (size_t)HALF * K * 2;
    const size_t tstep = 2 * hstep;
    const unsigned ldsw = (unsigned)wid * 1024u;
    const int aoff = lds_byte(wr * 64 + fr, fq * 8), boff = lds_byte(wc * 32 + fr, fq * 8);
#define PG8_SA(b, h) (((b) * 2 + (h)) * HTB)
#define PG8_SB(b, h) ((4 + (b) * 2 + (h)) * HTB)
#define PG8_STAGE(bufoff, gbase, voff) do { _Pragma("unroll") for (int _i = 0; _i < 2; ++_i) \
        __builtin_amdgcn_global_load_lds((const unsigned*)((const char*)(gbase) + (voff)[_i]), (LAS unsigned*)(lds + (bufoff) + ldsw + _i * 8192), 16, 0, 0); } while (0)
#define PG8_LDA(dst, b, h) do { _Pragma("unroll") for (int m = 0; m < 4; ++m) _Pragma("unroll") for (int k = 0; k < 2; ++k) dst[m][k] = *(const LAS bf16x8*)(lds + PG8_SA(b, h) + aoff + m * 2048 + k * 1024); } while (0)
#define PG8_LDB(dst, b, h) do { _Pragma("unroll") for (int n = 0; n < 2; ++n) _Pragma("unroll") for (int k = 0; k < 2; ++k) dst[n][k] = *(const LAS bf16x8*)(lds + PG8_SB(b, h) + boff + n * 2048 + k * 1024); } while (0)
#define PG8_MMA(ai, bj, At, Bt) do { __builtin_amdgcn_s_setprio(1); _Pragma("unroll") for (int m = 0; m < 4; ++m) _Pragma("unroll") for (int n = 0; n < 2; ++n) _Pragma("unroll") for (int k = 0; k < 2; ++k) \
        acc[ai][bj][m][n] = __builtin_amdgcn_mfma_f32_16x16x32_bf16(Bt[n][k], At[m][k], acc[ai][bj][m][n], 0, 0, 0); __builtin_amdgcn_s_setprio(0); } while (0)
#define PG8_WAIT_V(n) asm volatile("s_waitcnt vmcnt(" #n ")" ::: "memory")
#define PG8_WAIT_L(n) asm volatile("s_waitcnt lgkmcnt(" #n ")" ::: "memory")
#define PG8_BAR __builtin_amdgcn_s_barrier()
#define PG8_SCHED __builtin_amdgcn_sched_barrier(0)
    Unit cur, nxt; int ui = 0;
    if (!S.next(0, cur)) return;
    f32x4 acc[2][2][4][2];
#pragma unroll
    for (int a = 0; a < 2; ++a)
#pragma unroll
        for (int b = 0; b < 2; ++b)
#pragma unroll
            for (int m = 0; m < 4; ++m)
#pragma unroll
                for (int n = 0; n < 2; ++n) acc[a][b][m][n] = (f32x4){0.f, 0.f, 0.f, 0.f};
    bf16x8 At[4][2], B0[2][2], B1[2][2];
    const char* cA = (const char*)(cur.sel ? g.A1 : g.A0) + (size_t)cur.pm * tstep; const char* cB = (const char*)(cur.sel ? g.B1 : g.B0) + (size_t)cur.pn * tstep;
    PG8_STAGE(PG8_SB(0, 0), cB, voffB); PG8_STAGE(PG8_SB(0, 1), cB + hstep, voffB); PG8_STAGE(PG8_SA(0, 0), cA, voffA); PG8_STAGE(PG8_SA(0, 1), cA + hstep, voffA);
    if (wr == 1) PG8_BAR;
    PG8_WAIT_V(2); PG8_BAR;
    PG8_STAGE(PG8_SB(1, 0), cB + kstep, voffB); PG8_STAGE(PG8_SA(1, 0), cA + kstep, voffA); PG8_STAGE(PG8_SB(1, 1), cB + hstep + kstep, voffB);
    PG8_WAIT_V(6); PG8_BAR;
    for (;;) {
        const bool has_next = S.next(ui + 1, nxt);
        const char* nA = has_next ? (const char*)(nxt.sel ? g.A1 : g.A0) + (size_t)nxt.pm * tstep : cA; const char* nB = has_next ? (const char*)(nxt.sel ? g.B1 : g.B0) + (size_t)nxt.pn * tstep : cB;
        for (int t = 0; t < nt; t += 2) {
            const bool last = (t == nt - 2);
            const char* a1 = cA + (size_t)(t + 1) * kstep;
            const char* a2 = last ? nA : cA + (size_t)(t + 2) * kstep; const char* b2 = last ? nB : cB + (size_t)(t + 2) * kstep;
            const char* a3 = a2 + kstep; const char* b3 = b2 + kstep;
            PG8_LDB(B0, 0, 0); PG8_LDB(B1, 0, 1); PG8_SCHED; PG8_LDA(At, 0, 0); PG8_STAGE(PG8_SA(1, 1), a1 + hstep, voffA);
            PG8_WAIT_V(8); PG8_WAIT_L(0); PG8_BAR; PG8_MMA(0, 0, At, B0); PG8_MMA(0, 1, At, B1); PG8_BAR; PG8_SCHED;
            PG8_LDA(At, 0, 1); PG8_STAGE(PG8_SB(0, 0), b2, voffB); PG8_STAGE(PG8_SB(0, 1), b2 + hstep, voffB); PG8_STAGE(PG8_SA(0, 0), a2, voffA);
            PG8_WAIT_V(8); PG8_WAIT_L(0); PG8_BAR; PG8_MMA(1, 0, At, B0); PG8_MMA(1, 1, At, B1); PG8_BAR; PG8_SCHED;
            PG8_LDB(B0, 1, 0); PG8_LDB(B1, 1, 1); PG8_SCHED; PG8_LDA(At, 1, 0); PG8_STAGE(PG8_SA(0, 1), a2 + hstep, voffA);
            PG8_WAIT_V(8); PG8_WAIT_L(0); PG8_BAR; PG8_MMA(0, 0, At, B0); PG8_MMA(0, 1, At, B1); PG8_BAR; PG8_SCHED;
            PG8_LDA(At, 1, 1); PG8_STAGE(PG8_SB(1, 0), b3, voffB); PG8_STAGE(PG8_SB(1, 1), b3 + hstep, voffB); PG8_STAGE(PG8_SA(1, 0), a3, voffA);
            PG8_WAIT_V(8); PG8_WAIT_L(0); PG8_BAR; PG8_MMA(1, 0, At, B0); PG8_MMA(1, 1, At, B1); PG8_BAR; PG8_SCHED;
        }
        if (wr == 0) PG8_BAR;
        E(acc, cur, wr, wc, fr, fq);
        if (!has_next) break;
#pragma unroll
        for (int a = 0; a < 2; ++a)
#pragma unroll
            for (int b = 0; b < 2; ++b)
#pragma unroll
                for (int m = 0; m < 4; ++m)
#pragma unroll
                    for (int n = 0; n < 2; ++n) acc[a][b][m][n] = (f32x4){0.f, 0.f, 0.f, 0.f};
        cur = nxt; cA = nA; cB = nB; ++ui;
        if (wr == 1) PG8_BAR;
    }
    PG8_WAIT_V(0);
    PG8_BAR;
#undef PG8_SA
#undef PG8_SB
#undef PG8_STAGE
#undef PG8_LDA
#undef PG8_LDB
#undef PG8_MMA
#undef PG8_WAIT_V
#undef PG8_WAIT_L
#undef PG8_BAR
#undef PG8_SCHED
}
}

template <int ACT> DI float act_fn(float x) {
    if (ACT == 0) return x;
    if (ACT == 1) return siluf_(x) * 0.08838834764831845f;
    if (ACT == 2) return siluf_(x);
    if (ACT == 3) return geluf_(x);
    return sigmoidf_(x);
}
template <int ACT> DI void store_act(const f32x4 (&acc)[2][2][4][2], bf16_t* base, int row0, int col0) {
#pragma unroll
    for (int ai = 0; ai < 2; ++ai)
#pragma unroll
        for (int m = 0; m < 4; ++m) { bf16_t* rowp = base + (size_t)(row0 + ai * 128 + m * 16) * D + col0;
#pragma unroll
            for (int bj = 0; bj < 2; ++bj) { const f32x4 v0 = acc[ai][bj][m][0], v1 = acc[ai][bj][m][1];
                u32x4 w; w.x = pk2(act_fn<ACT>(v0[0]), act_fn<ACT>(v0[1])); w.y = pk2(act_fn<ACT>(v0[2]), act_fn<ACT>(v0[3]));
                w.z = pk2(act_fn<ACT>(v1[0]), act_fn<ACT>(v1[1])); w.w = pk2(act_fn<ACT>(v1[2]), act_fn<ACT>(v1[3]));
                *(u32x4*)(rowp + bj * 128) = w; } }
}
struct EpiInProj {
    static constexpr bool PERM = true;
    bf16_t* out9;
    DI void operator()(const f32x4 (&acc)[2][2][4][2], const pg8::Unit& u, int wr, int wc, int fr, int fq) const {
        const int pn = u.pn, row0 = u.pm * 256 + wr * 64 + fr, cl = wc * 32 + 8 * fq;
        if (pn >= 20 && pn < 28) {
            bf16_t* base = out9 + 5 * ARR; const int col0 = 128 * (pn - 20) + cl;
#pragma unroll
            for (int ai = 0; ai < 2; ++ai)
#pragma unroll
                for (int m = 0; m < 4; ++m) { bf16_t* rowp = base + (size_t)(row0 + ai * 128 + m * 16) * D + col0;
                    const f32x4 u0 = acc[ai][0][m][0], u1 = acc[ai][0][m][1], g0 = acc[ai][1][m][0], g1 = acc[ai][1][m][1];
                    u32x4 w; w.x = pk2(geluf_(u0[0]) * siluf_(g0[0]), geluf_(u0[1]) * siluf_(g0[1])); w.y = pk2(geluf_(u0[2]) * siluf_(g0[2]), geluf_(u0[3]) * siluf_(g0[3]));
                    w.z = pk2(geluf_(u1[0]) * siluf_(g1[0]), geluf_(u1[1]) * siluf_(g1[1])); w.w = pk2(geluf_(u1[2]) * siluf_(g1[2]), geluf_(u1[3]) * siluf_(g1[3]));
                    *(u32x4*)rowp = w; }
            return;
        }
        int idx, ct;
        if (pn < 20) { idx = pn >> 2; ct = pn & 3; } else if (pn < 32) { idx = 6; ct = pn - 28; } else { idx = 7 + ((pn - 32) >> 2); ct = (pn - 32) & 3; }
        bf16_t* base = out9 + (size_t)idx * ARR; const int col0 = 256 * ct + cl;
        if (idx == 0) store_act<1>(acc, base, row0, col0);
        else if (idx <= 3) store_act<0>(acc, base, row0, col0);
        else if (idx == 4) store_act<2>(acc, base, row0, col0);
        else if (idx == 6) store_act<3>(acc, base, row0, col0);
        else store_act<4>(acc, base, row0, col0);
    }
};
struct EpiProjAB {
    static constexpr bool PERM = true;
    const bf16_t* SMA; const bf16_t* SMB; bf16_t* MG;
    DI void operator()(const f32x4 (&acc)[2][2][4][2], const pg8::Unit& u, int wr, int wc, int fr, int fq) const {
        const int row0 = u.pm * 256 + wr * 64 + fr, col0 = u.pn * 256 + wc * 32 + 8 * fq;
        const bf16_t* gate = u.sel ? SMB : SMA;
#pragma unroll
        for (int ai = 0; ai < 2; ++ai)
#pragma unroll
            for (int m = 0; m < 4; ++m) { const size_t off = (size_t)(row0 + ai * 128 + m * 16) * D + col0;
#pragma unroll
                for (int bj = 0; bj < 2; ++bj) { const f32x4 v0 = acc[ai][bj][m][0], v1 = acc[ai][bj][m][1];
                    const u32x4 gw = *(const u32x4*)(gate + off + bj * 128);
                    float o[8] = {v0[0] * bflo(gw.x), v0[1] * bfhi(gw.x), v0[2] * bflo(gw.y), v0[3] * bfhi(gw.y), v1[0] * bflo(gw.z), v1[1] * bfhi(gw.z), v1[2] * bflo(gw.w), v1[3] * bfhi(gw.w)};
                    if (u.sel) { const u32x4 tw = *(const u32x4*)(MG + off + bj * 128);
                        o[0] += bflo(tw.x); o[1] += bfhi(tw.x); o[2] += bflo(tw.y); o[3] += bfhi(tw.y); o[4] += bflo(tw.z); o[5] += bfhi(tw.z); o[6] += bflo(tw.w); o[7] += bfhi(tw.w); }
                    u32x4 w; w.x = pk2(o[0], o[1]); w.y = pk2(o[2], o[3]); w.z = pk2(o[4], o[5]); w.w = pk2(o[6], o[7]);
                    *(u32x4*)(MG + off + bj * 128) = w; }
                asm volatile("" ::: "memory"); }
    }
};
struct EpiResid {
    static constexpr bool PERM = false;
    const float* xin; float* out;
    DI void operator()(const f32x4 (&acc)[2][2][4][2], const pg8::Unit& u, int wr, int wc, int fr, int fq) const {
        const int row0 = u.pm * 256 + wr * 64 + fr, col0 = u.pn * 256 + wc * 32 + 4 * fq;
#pragma unroll
        for (int ai = 0; ai < 2; ++ai)
#pragma unroll
            for (int m = 0; m < 4; ++m) { const size_t off = (size_t)(row0 + ai * 128 + m * 16) * D + col0;
#pragma unroll
                for (int bj = 0; bj < 2; ++bj)
#pragma unroll
                    for (int n = 0; n < 2; ++n) { const f32x4 xv = *(const f32x4*)(xin + off + bj * 128 + n * 16); *(f32x4*)(out + off + bj * 128 + n * 16) = xv + acc[ai][bj][m][n]; }
                asm volatile("" ::: "memory"); }
    }
};

DI int src_col(int nv) {
    if (nv < 5120) return nv;
    if (nv < 7168) { const int t = (nv - 5120) >> 8, w = (nv - 5120) & 255; return w < 128 ? 5120 + 128 * t + w : 7168 + 128 * t + (w - 128); }
    if (nv < 8192) return 6144 + (nv - 7168);
    return nv;
}
DI void transpose_item(const float* W, int N, bf16_t* WT, int k0, int nsrc0, int nvirt0, LAS float* scr, int lane) {
#pragma unroll 8
    for (int i = 0; i < 32; ++i) { const int kk = 2 * i + (lane >> 5); scr[kk * 33 + (lane & 31)] = W[(size_t)(k0 + kk) * N + nsrc0 + (lane & 31)]; }
    LDS_WAIT();
    const int c = lane & 7;
#pragma unroll
    for (int j = 0; j < 4; ++j) { const int n = (lane >> 3) + 8 * j; const LAS float* s = scr + (8 * c) * 33 + n;
        u32x4 o; o.x = pk2(s[0 * 33], s[1 * 33]); o.y = pk2(s[2 * 33], s[3 * 33]); o.z = pk2(s[4 * 33], s[5 * 33]); o.w = pk2(s[6 * 33], s[7 * 33]);
        *(u32x4*)(WT + (size_t)(nvirt0 + n) * D + k0 + 8 * c) = o; }
    LDS_WAIT();
}
DI void phase_prep(LAS unsigned char* lds, const float* w_in, const float* wa, const float* wb, const float* wo, unsigned char* ws, int G) {
    const int tid_ = opaque_tid(); const int lane = tid_ & 63, wave = __builtin_amdgcn_readfirstlane(tid_ >> 6);
    LAS float* scr = (LAS float*)(lds + wave * 16384);
    const int gw = blockIdx.x * 8 + wave, NGW = G * 8;
    constexpr int I_IN = 16 * 320, I_P = 16 * 32, PER_L = I_IN + 3 * I_P;
    for (int it = gw; it < DEPTH * PER_L; it += NGW) {
        const int l = it / PER_L; int r = it % PER_L;
        if (r < I_IN) { const int kb = r / 320, nb = r % 320; transpose_item(w_in + (size_t)l * D * NIN, NIN, (bf16_t*)(ws + WS_WIN) + (size_t)l * NIN * D, 64 * kb, src_col(32 * nb), 32 * nb, scr, lane); continue; }
        r -= I_IN; const int which = r / I_P; r %= I_P; const int kb = r / 32, nb = r % 32;
        const float* W = (which == 0 ? wa : which == 1 ? wb : wo) + (size_t)l * D * D;
        bf16_t* WT = (bf16_t*)(ws + (which == 0 ? WS_WA : which == 1 ? WS_WB : WS_WO)) + (size_t)l * D * D;
        transpose_item(W, D, WT, 64 * kb, 32 * nb, 32 * nb, scr, lane);
    }
}
DI void phase_rms_bf16(const float* x, const float* w, bf16_t* h, int nrows, int G) {
    const int tid_ = opaque_tid(); const int lane = tid_ & 63, wave = __builtin_amdgcn_readfirstlane(tid_ >> 6);
    const int gw = blockIdx.x * 8 + wave, NGW = G * 8;
    f32x4 wv[4];
#pragma unroll
    for (int j = 0; j < 4; ++j) wv[j] = ((const f32x4*)w)[lane + 64 * j];
    for (int m = gw; m < nrows; m += NGW) {
        const f32x4* xr = (const f32x4*)(x + (size_t)m * D) + lane; f32x4 v[4]; float s = 0.f;
#pragma unroll
        for (int j = 0; j < 4; ++j) { v[j] = xr[64 * j]; s += (v[j].x * v[j].x + v[j].y * v[j].y) + (v[j].z * v[j].z + v[j].w * v[j].w); }
        const float rstd = rsqrtf(wave_sum(s) * (1.0f / D) + 1e-6f);
        u32x2* o8 = (u32x2*)(h + (size_t)m * D) + lane;
#pragma unroll
        for (int j = 0; j < 4; ++j) { u32x2 o; o.x = pk2(v[j].x * rstd * wv[j].x, v[j].y * rstd * wv[j].y); o.y = pk2(v[j].z * rstd * wv[j].z, v[j].w * rstd * wv[j].w); o8[64 * j] = o; }
    }
}
DI void phase_final(float* x, const float* w, int nrows, int G) {
    const int tid_ = opaque_tid(); const int lane = tid_ & 63, wave = __builtin_amdgcn_readfirstlane(tid_ >> 6);
    const int gw = blockIdx.x * 8 + wave, NGW = G * 8;
    f32x4 wv[4];
#pragma unroll
    for (int j = 0; j < 4; ++j) wv[j] = ((const f32x4*)w)[lane + 64 * j];
    for (int m = gw; m < nrows; m += NGW) {
        f32x4* xr = (f32x4*)(x + (size_t)m * D) + lane; f32x4 v[4]; float s = 0.f;
#pragma unroll
        for (int j = 0; j < 4; ++j) { v[j] = xr[64 * j]; s += (v[j].x * v[j].x + v[j].y * v[j].y) + (v[j].z * v[j].z + v[j].w * v[j].w); }
        const float rstd = rsqrtf(wave_sum(s) * (1.0f / D) + 1e-6f);
#pragma unroll
        for (int j = 0; j < 4; ++j) xr[64 * j] = v[j] * rstd * wv[j];
    }
}
DI void phase_ya(const bf16_t* OF, const bf16_t* OB, const bf16_t* SGA, const float* gw_, bf16_t* YA, int G) {
    const int tid_ = opaque_tid(); const int lane = tid_ & 63, wave = __builtin_amdgcn_readfirstlane(tid_ >> 6);
    const int gw = blockIdx.x * 8 + wave, NGW = G * 8;
    f32x4 gv[4];
#pragma unroll
    for (int j = 0; j < 4; ++j) gv[j] = *(const f32x4*)(gw_ + ((16 * lane) & 127) + 4 * j);
    for (int m = gw; m < MH; m += NGW) {
        const size_t off = (size_t)m * D + 16 * lane;
        const u32x4 a0 = *(const u32x4*)(OF + off), a1 = *(const u32x4*)(OF + off + 8), b0 = *(const u32x4*)(OB + off), b1 = *(const u32x4*)(OB + off + 8);
        const u32x4 s0 = *(const u32x4*)(SGA + off), s1 = *(const u32x4*)(SGA + off + 8);
        const unsigned aw[8] = {a0.x, a0.y, a0.z, a0.w, a1.x, a1.y, a1.z, a1.w}, bw[8] = {b0.x, b0.y, b0.z, b0.w, b1.x, b1.y, b1.z, b1.w}, sw[8] = {s0.x, s0.y, s0.z, s0.w, s1.x, s1.y, s1.z, s1.w};
        float o[16]; float ss = 0.f;
#pragma unroll
        for (int w = 0; w < 8; ++w) { o[2 * w] = bflo(aw[w]) + bflo(bw[w]); o[2 * w + 1] = bfhi(aw[w]) + bfhi(bw[w]); ss += o[2 * w] * o[2 * w] + o[2 * w + 1] * o[2 * w + 1]; }
        ss += __shfl_xor(ss, 1); ss += __shfl_xor(ss, 2); ss += __shfl_xor(ss, 4);
        const float rstd = rsqrtf(ss * (1.0f / 128.0f) + 1e-6f);
        unsigned ow[8];
#pragma unroll
        for (int w = 0; w < 8; ++w) { const float g0 = gv[w >> 1][(2 * w) & 3], g1 = gv[w >> 1][(2 * w + 1) & 3];
            ow[w] = pk2(o[2 * w] * rstd * g0 * bflo(sw[w]), o[2 * w + 1] * rstd * g1 * bfhi(sw[w])); }
        *(u32x4*)(YA + off) = (u32x4){ow[0], ow[1], ow[2], ow[3]}; *(u32x4*)(YA + off + 8) = (u32x4){ow[4], ow[5], ow[6], ow[7]};
    }
}

#define MFMA32(a, b, c) __builtin_amdgcn_mfma_f32_32x32x16_bf16((a), (b), (c), 0, 0, 0)
DI void scan_item(LAS unsigned char* lds, const bf16_t* Q, const bf16_t* Z, const bf16_t* Iv, bf16_t* O, const float* lbraw, int layer, int b, int h, int dir, int dvq) {
    const int tid = opaque_tid(), lane = tid & 63, wave = __builtin_amdgcn_readfirstlane(tid >> 6);
    const int r = lane & 31, hh = lane >> 5, j = tid >> 3, cgp = tid & 7;
    LAS float* LF = (LAS float*)(lds); LAS float* GG = (LAS float*)(lds + 32768);
    LAS bf16_t* QS = (LAS bf16_t*)(lds + 65536);
    LAS bf16_t* KS = (LAS bf16_t*)(lds + 82944);
    LAS bf16_t* KT = (LAS bf16_t*)(lds + 100352);
    LAS bf16_t* VT = (LAS bf16_t*)(lds + 118784);
    LAS bf16_t* PS = (LAS bf16_t*)(lds + 123392);
    LAS bf16_t* ST = (LAS bf16_t*)(lds + 132608);
    LAS float* LBF = (LAS float*)(lds + 141312); LAS float* OML = LBF + 128;
    __syncthreads();
    if (tid < 128) {
        float v[4], mx = -1e30f;
#pragma unroll
        for (int l = 0; l < 4; ++l) { v[l] = lbraw[l * 2048 + tid]; mx = fmaxf(mx, v[l]); }
        float den = 0.f;
#pragma unroll
        for (int l = 0; l < 4; ++l) { v[l] = __expf(v[l] - mx); den += v[l]; }
        float lb = 0.f;
#pragma unroll
        for (int l = 1; l < 4; ++l) if (l <= layer) lb += v[l];
        lb = lb / den;
        LBF[tid] = fmaxf(lb, 1e-20f); OML[tid] = 1.0f - lb;
    }
    const size_t rowbase = (size_t)b * SEQ;
    const int coloff = h * 128 + 16 * cgp, vcol = h * 128 + dvq * 32 + 4 * cgp;
    u32x4 qv0, qv1, zv0, zv1; u32x2 vv;
    {
        const int c0 = dir ? 63 : 0; const size_t row = rowbase + c0 * 64 + (dir ? 63 - j : j);
        qv0 = *(const u32x4*)(Q + row * D + coloff); qv1 = *(const u32x4*)(Q + row * D + coloff + 8);
        zv0 = *(const u32x4*)(Z + row * D + coloff); zv1 = *(const u32x4*)(Z + row * D + coloff + 8);
        vv = *(const u32x2*)(Iv + row * D + vcol);
    }
    __syncthreads();
    f32x16 S;
#pragma unroll
    for (int i = 0; i < 16; ++i) S[i] = 0.f;
    for (int st = 0; st < 64; ++st) {
        const int c = dir ? 63 - st : st;
        float kk[16];
        {
            f32x4 lf4[4];
            const unsigned zw[8] = {zv0.x, zv0.y, zv0.z, zv0.w, zv1.x, zv1.y, zv1.z, zv1.w};
#pragma unroll
            for (int q4 = 0; q4 < 4; ++q4) {
                const f32x4 lb4 = *(const LAS f32x4*)(LBF + 16 * cgp + 4 * q4), om4 = *(const LAS f32x4*)(OML + 16 * cgp + 4 * q4);
#pragma unroll
                for (int e4 = 0; e4 < 4; ++e4) { const int idx = 4 * q4 + e4; const unsigned w = zw[idx >> 1];
                    float z = (idx & 1) ? bfhi(w) : bflo(w); z = fminf(fmaxf(z, -30.f), 30.f);
                    const float e = fexp2(-z * LOG2E), sg = frcp(1.0f + e);
                    const float f = lb4[e4] + om4[e4] * sg; kk[idx] = om4[e4] * e * sg; lf4[q4][e4] = __builtin_amdgcn_logf(f); }
                *(LAS f32x4*)(LF + j * 128 + 16 * cgp + 4 * q4) = lf4[q4];
            }
        }
        __syncthreads();
        {
            const int ch = tid & 127, qt = wave >> 1; float s = 0.f;
            for (int blk = 0; blk <= qt; ++blk) {
                float v[16];
#pragma unroll
                for (int i = 0; i < 16; ++i) v[i] = LF[(16 * blk + i) * 128 + ch];
#pragma unroll
                for (int i = 0; i < 16; ++i) { s += v[i]; v[i] = s; }
                if (blk == qt) {
#pragma unroll
                    for (int i = 0; i < 16; ++i) GG[(16 * blk + i) * 128 + ch] = v[i];
                }
            }
        }
        __syncthreads();
        {
            const unsigned qw[8] = {qv0.x, qv0.y, qv0.z, qv0.w, qv1.x, qv1.y, qv1.z, qv1.w};
            unsigned qo[8], ko[8];
#pragma unroll
            for (int q4 = 0; q4 < 4; ++q4) {
                const f32x4 g4 = *(const LAS f32x4*)(GG + j * 128 + 16 * cgp + 4 * q4), r4 = *(const LAS f32x4*)(GG + 31 * 128 + 16 * cgp + 4 * q4);
                float qt_[4], kt_[4];
#pragma unroll
                for (int e4 = 0; e4 < 4; ++e4) { const int idx = 4 * q4 + e4; const unsigned w = qw[idx >> 1]; const float qf = (idx & 1) ? bfhi(w) : bflo(w);
                    const float dq = g4[e4] - r4[e4];
                    qt_[e4] = qf * fexp2(fminf(dq, 100.f)); kt_[e4] = kk[idx] * fexp2(fminf(-dq, 100.f)); }
                qo[2 * q4] = pk2(qt_[0], qt_[1]); qo[2 * q4 + 1] = pk2(qt_[2], qt_[3]); ko[2 * q4] = pk2(kt_[0], kt_[1]); ko[2 * q4 + 1] = pk2(kt_[2], kt_[3]);
            }
            *(LAS u32x4*)(QS + j * 136 + 16 * cgp) = (u32x4){qo[0], qo[1], qo[2], qo[3]}; *(LAS u32x4*)(QS + j * 136 + 16 * cgp + 8) = (u32x4){qo[4], qo[5], qo[6], qo[7]};
            *(LAS u32x4*)(KS + j * 136 + 16 * cgp) = (u32x4){ko[0], ko[1], ko[2], ko[3]}; *(LAS u32x4*)(KS + j * 136 + 16 * cgp + 8) = (u32x4){ko[4], ko[5], ko[6], ko[7]};
#pragma unroll
            for (int w = 0; w < 8; ++w) { KT[(16 * cgp + 2 * w) * 72 + j] = (bf16_t)(ko[w] & 0xffffu); KT[(16 * cgp + 2 * w + 1) * 72 + j] = (bf16_t)(ko[w] >> 16); }
            VT[(4 * cgp + 0) * 72 + j] = (bf16_t)(vv.x & 0xffffu); VT[(4 * cgp + 1) * 72 + j] = (bf16_t)(vv.x >> 16);
            VT[(4 * cgp + 2) * 72 + j] = (bf16_t)(vv.y & 0xffffu); VT[(4 * cgp + 3) * 72 + j] = (bf16_t)(vv.y >> 16);
            if (st < 63) {
                const int cn = dir ? c - 1 : c + 1; const size_t row = rowbase + cn * 64 + (dir ? 63 - j : j);
                qv0 = *(const u32x4*)(Q + row * D + coloff); qv1 = *(const u32x4*)(Q + row * D + coloff + 8);
                zv0 = *(const u32x4*)(Z + row * D + coloff); zv1 = *(const u32x4*)(Z + row * D + coloff + 8);
                vv = *(const u32x2*)(Iv + row * D + vcol);
            }
        }
        __syncthreads();
        if (wave < 4) {
            const int d = 32 * wave + r;
            const float g31 = GG[31 * 128 + d], g63 = GG[63 * 128 + d];
            const float e1 = fexp2(g31), e2 = fexp2(g63 - g31);
#pragma unroll
            for (int i = 0; i < 16; ++i) { S[i] *= e1; }
#pragma unroll
            for (int i = 0; i < 16; i += 2) { const unsigned p = pk2(S[i], S[i + 1]); const int v0 = (i & 3) + 8 * (i >> 2) + 4 * hh;
                ST[v0 * 136 + d] = (bf16_t)(p & 0xffffu); ST[(v0 + 1) * 136 + d] = (bf16_t)(p >> 16); }
#pragma unroll
            for (int ks = 0; ks < 4; ++ks) { const bf16x8 a = *(const LAS bf16x8*)(VT + r * 72 + 16 * ks + 8 * hh), bb = *(const LAS bf16x8*)(KT + d * 72 + 16 * ks + 8 * hh); S = MFMA32(a, bb, S); }
#pragma unroll
            for (int i = 0; i < 16; ++i) S[i] *= e2;
        } else if (wave < 7) {
            const int tm = (wave == 6) ? 1 : 0, tn = (wave == 4) ? 0 : 1;
            f32x16 acc;
#pragma unroll
            for (int i = 0; i < 16; ++i) acc[i] = 0.f;
#pragma unroll
            for (int ks = 0; ks < 8; ++ks) { const bf16x8 a = *(const LAS bf16x8*)(KS + (32 * tm + r) * 136 + 16 * ks + 8 * hh), bb = *(const LAS bf16x8*)(QS + (32 * tn + r) * 136 + 16 * ks + 8 * hh); acc = MFMA32(a, bb, acc); }
            const int t = 32 * tn + r;
#pragma unroll
            for (int g = 0; g < 4; ++g) { const int s0 = 32 * tm + 8 * g + 4 * hh;
                const float p0 = (s0 + 0 <= t) ? acc[4 * g + 0] : 0.f, p1 = (s0 + 1 <= t) ? acc[4 * g + 1] : 0.f, p2 = (s0 + 2 <= t) ? acc[4 * g + 2] : 0.f, p3 = (s0 + 3 <= t) ? acc[4 * g + 3] : 0.f;
                *(LAS u32x2*)(PS + t * 72 + s0) = (u32x2){pk2(p0, p1), pk2(p2, p3)}; }
        }
        __syncthreads();
        if (wave == 4 || wave == 5) {
            const int tn = wave - 4;
            f32x16 acc;
#pragma unroll
            for (int i = 0; i < 16; ++i) acc[i] = 0.f;
#pragma unroll
            for (int ks = 0; ks < 4; ++ks) { if (ks < 2 * (tn + 1)) { const bf16x8 a = *(const LAS bf16x8*)(VT + r * 72 + 16 * ks + 8 * hh), bb = *(const LAS bf16x8*)(PS + (32 * tn + r) * 72 + 16 * ks + 8 * hh); acc = MFMA32(a, bb, acc); } }
#pragma unroll
            for (int ks = 0; ks < 8; ++ks) { const bf16x8 a = *(const LAS bf16x8*)(ST + r * 136 + 16 * ks + 8 * hh), bb = *(const LAS bf16x8*)(QS + (32 * tn + r) * 136 + 16 * ks + 8 * hh); acc = MFMA32(a, bb, acc); }
            const int jj = 32 * tn + r; const size_t row = rowbase + c * 64 + (dir ? 63 - jj : jj);
            bf16_t* op = O + row * D + h * 128 + dvq * 32 + 4 * hh;
#pragma unroll
            for (int g = 0; g < 4; ++g) *(u32x2*)(op + 8 * g) = (u32x2){pk2(acc[4 * g], acc[4 * g + 1]), pk2(acc[4 * g + 2], acc[4 * g + 3])};
        }
    }
}

DI void spatial_item(LAS unsigned char* lds, const bf16_t* GV, bf16_t* UG, const float* ln_w, const float* ln_b, const float* w_s, const float* b_s, int b, int n) {
    const int tid = opaque_tid(), lane = tid & 63, wave = __builtin_amdgcn_readfirstlane(tid >> 6);
    const int r = lane & 31, hh = lane >> 5;
    LAS f32x2* STAT = (LAS f32x2*)(lds);
    LAS bf16_t* VL = (LAS bf16_t*)(lds + 1024);
    LAS bf16_t* WS = (LAS bf16_t*)(lds + 1024 + 34816);
    const size_t rowbase = (size_t)b * SEQ + (size_t)n * 128;
    __syncthreads();
    for (int i = 0; i < 16; ++i) {
        const int s = wave * 16 + i; const bf16_t* p = GV + (rowbase + s) * D + 16 * lane;
        const u32x4 a0 = *(const u32x4*)p, a1 = *(const u32x4*)(p + 8);
        const unsigned aw[8] = {a0.x, a0.y, a0.z, a0.w, a1.x, a1.y, a1.z, a1.w};
        float s1 = 0.f, s2 = 0.f;
#pragma unroll
        for (int w = 0; w < 8; ++w) { const float x0 = bflo(aw[w]), x1 = bfhi(aw[w]); s1 += x0 + x1; s2 += x0 * x0 + x1 * x1; }
        s1 = wave_sum(s1); s2 = wave_sum(s2);
        const float mean = s1 * (1.0f / D), var = fmaxf(s2 * (1.0f / D) - mean * mean, 0.f);
        if (lane == 0) STAT[s] = (f32x2){mean, rsqrtf(var + 1e-5f)};
    }
    __syncthreads();
    for (int g = 0; g < 8; ++g) {
        {
            const int s = tid >> 2, cq = tid & 3; const f32x2 st = STAT[s];
            const bf16_t* p = GV + (rowbase + s) * D + 128 * g + 32 * cq;
#pragma unroll
            for (int q = 0; q < 4; ++q) { const u32x4 a = *(const u32x4*)(p + 8 * q); const unsigned aw[4] = {a.x, a.y, a.z, a.w};
                const f32x4 w0 = *(const f32x4*)(ln_w + 128 * g + 32 * cq + 8 * q), w1 = *(const f32x4*)(ln_w + 128 * g + 32 * cq + 8 * q + 4);
                const f32x4 c0 = *(const f32x4*)(ln_b + 128 * g + 32 * cq + 8 * q), c1 = *(const f32x4*)(ln_b + 128 * g + 32 * cq + 8 * q + 4);
                const float wv[8] = {w0.x, w0.y, w0.z, w0.w, w1.x, w1.y, w1.z, w1.w}, bv[8] = {c0.x, c0.y, c0.z, c0.w, c1.x, c1.y, c1.z, c1.w};
#pragma unroll
                for (int w = 0; w < 4; ++w) { const float y0 = (bflo(aw[w]) - st.x) * st.y * wv[2 * w] + bv[2 * w], y1 = (bfhi(aw[w]) - st.x) * st.y * wv[2 * w + 1] + bv[2 * w + 1];
                    const unsigned pk = pk2(y0, y1); const int c = 32 * cq + 8 * q + 2 * w;
                    VL[c * 136 + s] = (bf16_t)(pk & 0xffffu); VL[(c + 1) * 136 + s] = (bf16_t)(pk >> 16); } }
            const int t = tid >> 2, sq = tid & 3; const float* wp = w_s + ((size_t)g * 128 + t) * 128 + 32 * sq;
#pragma unroll
            for (int q = 0; q < 4; ++q) { const f32x4 x0 = *(const f32x4*)(wp + 8 * q), x1 = *(const f32x4*)(wp + 8 * q + 4);
                *(LAS u32x4*)(WS + t * 136 + 32 * sq + 8 * q) = (u32x4){pk2(x0.x, x0.y), pk2(x0.z, x0.w), pk2(x1.x, x1.y), pk2(x1.z, x1.w)}; }
        }
        __syncthreads();
        {
            const int cm = wave & 3;
#pragma unroll
            for (int tt = 0; tt < 2; ++tt) {
                const int tn = 2 * (wave >> 2) + tt;
                f32x16 acc;
#pragma unroll
                for (int i = 0; i < 16; ++i) acc[i] = 0.f;
#pragma unroll
                for (int ks = 0; ks < 8; ++ks) { const bf16x8 a = *(const LAS bf16x8*)(VL + (32 * cm + r) * 136 + 16 * ks + 8 * hh), bb = *(const LAS bf16x8*)(WS + (32 * tn + r) * 136 + 16 * ks + 8 * hh); acc = MFMA32(a, bb, acc); }
                const int t = 32 * tn + r; const float bias = b_s[g * 128 + t];
                bf16_t* up = UG + (rowbase + t) * D + 128 * g + 32 * cm + 4 * hh;
#pragma unroll
                for (int q = 0; q < 4; ++q) { const u32x2 uw = *(const u32x2*)(up + 8 * q);
                    *(u32x2*)(up + 8 * q) = (u32x2){pk2(bflo(uw.x) * (acc[4 * q] + bias), bfhi(uw.x) * (acc[4 * q + 1] + bias)), pk2(bflo(uw.y) * (acc[4 * q + 2] + bias), bfhi(uw.y) * (acc[4 * q + 3] + bias))}; }
            }
        }
        __syncthreads();
    }
}

struct Args { const float* in[13]; float* out; unsigned char* ws; int ph_lo, ph_hi; };
constexpr int NPH = 46;

__global__ void __launch_bounds__(512, 2) mega(Args a) {
    extern __shared__ __attribute__((aligned(16))) unsigned char shm[];
    LAS unsigned char* lds = (LAS unsigned char*)shm;
    cg::grid_group grid = cg::this_grid();
    const int G = gridDim.x, blk = blockIdx.x;
    unsigned char* ws = a.ws;
    const float* x0 = a.in[0];
    bf16_t* Hb = (bf16_t*)(ws + WS_H); bf16_t* out9 = (bf16_t*)(ws + WS_OUT9);
    bf16_t* Qb = out9, *ZFb = out9 + ARR, *ZBb = out9 + 2 * ARR, *Ib = out9 + 3 * ARR, *SGAb = out9 + 4 * ARR, *UGb = out9 + 5 * ARR, *GVb = out9 + 6 * ARR, *SMAb = out9 + 7 * ARR, *SMBb = out9 + 8 * ARR;
    bf16_t* OFb = (bf16_t*)(ws + WS_OF); bf16_t* OBb = (bf16_t*)(ws + WS_OB);
    bf16_t* MGb = Qb;
    volatile LAS unsigned* bst = (volatile LAS unsigned*)(lds + LDS_BYTES - 16);
    if (threadIdx.x < 4) bst[threadIdx.x] = 0u;
    if (blk == 0) for (int i = threadIdx.x; i < XCD_BAR_WORDS; i += 512) ((unsigned*)ws)[i] = 0u;
    __syncthreads();
    XcdBarrier xb; xb.bar = (unsigned*)ws; xb.x = 0; xb.st = bst;
    for (int ph = a.ph_lo; ph < a.ph_hi; ++ph) {
        if (ph == a.ph_lo + 1) { grid.sync(); xb = xcd_barrier_post((unsigned*)ws, bst); }
        else if (ph > a.ph_lo + 1) xcd_barrier(xb);
        if (ph == 0) { phase_prep(lds, a.in[2], a.in[9], a.in[10], a.in[11], ws, G); continue; }
        if (ph == NPH - 1) { phase_final(a.out, a.in[12], M_ALL, G); continue; }
        const int q = ph - 1, l = q / 11, rr = q % 11;
        const float* xin = (l == 0) ? x0 : a.out;
        if (rr == 0) { phase_rms_bf16(xin, a.in[1] + l * D, Hb, M_ALL, G); continue; }
        const int hf = (rr - 1) / 5, k = (rr - 1) % 5;
        bf16_t* Hh = Hb + (size_t)hf * ARR;
        if (k == 0) {
            pg8::Gemm g{Hh, Hh, (const bf16_t*)(ws + WS_WIN) + (size_t)l * NIN * D, (const bf16_t*)(ws + WS_WIN) + (size_t)l * NIN * D, D};
            pg8::Order S; S.init(MH, NIN, G, blk, 0);
            EpiInProj E{out9};
            pg8::gemm_phase<EpiInProj>(lds, g, S, E);
        } else if (k == 1) {
            for (int it = blk; it < 256; it += G) {
                const int xcd = it & 7, idx = it >> 3, grp = xcd * 8 + (idx >> 2), dvq = idx & 3;
                const int b = grp >> 4, h = (grp >> 1) & 7, dir = grp & 1;
                scan_item(lds, Qb, dir ? ZBb : ZFb, Ib, dir ? OBb : OFb, a.in[3] + dir * 1024 + h * 128, l, b, h, dir, dvq);
            }
            for (int it = blk; it < 128; it += G)
                spatial_item(lds, GVb, UGb, a.in[5] + l * D, a.in[6] + l * D, a.in[7] + (size_t)l * 8 * 128 * 128, a.in[8] + l * 8 * 128, it >> 5, it & 31);
        } else if (k == 2) {
            phase_ya(OFb, OBb, SGAb, a.in[4] + l * 128, Hh, G);
        } else if (k == 3) {
            pg8::Gemm g{Hh, UGb, (const bf16_t*)(ws + WS_WA) + (size_t)l * D * D, (const bf16_t*)(ws + WS_WB) + (size_t)l * D * D, D};
            pg8::Order S; S.init(MH, D, G, blk, 1);
            EpiProjAB E{SMAb, SMBb, MGb};
            pg8::gemm_phase<EpiProjAB>(lds, g, S, E);
        } else {
            pg8::Gemm g{MGb, MGb, (const bf16_t*)(ws + WS_WO) + (size_t)l * D * D, (const bf16_t*)(ws + WS_WO) + (size_t)l * D * D, D};
            pg8::Order S; S.init(MH, D, G, blk, 0);
            EpiResid E{xin + (size_t)hf * ARR, a.out + (size_t)hf * ARR};
            pg8::gemm_phase<EpiResid>(lds, g, S, E);
        }
    }
}

extern "C" void kernel_launch(void* const* d_in, const int* in_sizes, int n_in, void* d_out, int out_size, void* d_ws, size_t ws_size, hipStream_t stream) {
    static int grid = 0;
    if (grid == 0) {
        if (n_in != 13 || ws_size < WS_END) { fprintf(stderr, "kernel_launch: unexpected inputs (n_in %d, ws %zu, need %zu)\n", n_in, ws_size, (size_t)WS_END); grid = -1; return; }
        int dev = 0, cus = 0, per_cu = 0;
        hipGetDevice(&dev); hipDeviceGetAttribute(&cus, hipDeviceAttributeMultiprocessorCount, dev);
        if (hipFuncSetAttribute((const void*)mega, hipFuncAttributeMaxDynamicSharedMemorySize, LDS_BYTES) != hipSuccess) { fprintf(stderr, "kernel_launch: hipFuncSetAttribute failed\n"); grid = -1; return; }
        if (hipOccupancyMaxActiveBlocksPerMultiprocessor(&per_cu, (const void*)mega, 512, LDS_BYTES) != hipSuccess || per_cu < 1) { fprintf(stderr, "kernel_launch: occupancy query gave %d\n", per_cu); per_cu = 1; }
        (void)hipGetLastError();
        grid = cus * 1;
        fprintf(stderr, "kernel_launch: cus %d per_cu %d grid %d\n", cus, per_cu, grid);
    }
    if (grid < 0) return;
    Args a{};
    for (int i = 0; i < 13; ++i) a.in[i] = (const float*)d_in[i];
    a.out = (float*)d_out; a.ws = (unsigned char*)d_ws; a.ph_lo = 0; a.ph_hi = NPH;
    void* args[] = {&a};
    hipError_t e = hipLaunchCooperativeKernel((const void*)mega, dim3(grid), dim3(512), args, LDS_BYTES, stream);
    if (e != hipSuccess) fprintf(stderr, "kernel_launch: cooperative launch failed: %s (grid %d)\n", hipGetErrorString(e), grid);
}
```

```cpp
#include <hip/hip_runtime.h>
#include <hip/hip_cooperative_groups.h>
#include <cstdio>
namespace cg = cooperative_groups;

#define LAS __attribute__((address_space(3)))
#define DI __device__ __forceinline__
typedef unsigned short bf16_t;
typedef short bf16x8 __attribute__((ext_vector_type(8)));
typedef float f32x4 __attribute__((ext_vector_type(4)));
typedef float f32x2 __attribute__((ext_vector_type(2)));
typedef float f32x16 __attribute__((ext_vector_type(16)));
typedef unsigned u32x4 __attribute__((ext_vector_type(4)));
typedef unsigned u32x2 __attribute__((ext_vector_type(2)));
typedef __bf16 bf16v2 __attribute__((ext_vector_type(2)));

constexpr int D = 1024, SEQ = 4096, MH = 16384, M_ALL = 32768, DEPTH = 4, NIN = 10240;
constexpr int LDS_BYTES = 147456;
constexpr float LOG2E = 1.4426950408889634f;
constexpr size_t ARR = (size_t)MH * D;

constexpr size_t WS_WIN = 1ull << 20;
constexpr size_t WS_WA = WS_WIN + (size_t)NIN * D * 2;
constexpr size_t WS_WB = WS_WA + (size_t)D * D * 2;
constexpr size_t WS_WO = WS_WB + (size_t)D * D * 2;
constexpr size_t WS_H = WS_WO + (size_t)D * D * 2;
constexpr size_t WS_OUT9 = WS_H + (size_t)M_ALL * D * 2;
constexpr size_t WS_OF = WS_OUT9 + 9 * ARR * 2;
constexpr size_t WS_X = WS_OF + 2 * ARR * 2;
constexpr size_t WS_AC = WS_X + (size_t)64 * 64 * 16384 * 2;
constexpr size_t WS_ST = WS_AC + (size_t)64 * 64 * 128 * 4;
constexpr size_t WS_LBT = WS_ST + (size_t)MH * 8;
constexpr size_t WS_END = WS_LBT + 4096 * 4;

DI unsigned pk2(float lo, float hi) { f32x2 v = {lo, hi}; bf16v2 r = __builtin_convertvector(v, bf16v2); return __builtin_bit_cast(unsigned, r); }
DI float bflo(unsigned w) { return __uint_as_float(w << 16); }
DI float bfhi(unsigned w) { return __uint_as_float(w & 0xffff0000u); }
DI float fexp2(float x) { return __builtin_amdgcn_exp2f(x); }
DI float frcp(float x) { return __builtin_amdgcn_rcpf(x); }
DI float sigmoidf_(float x) { return frcp(1.0f + fexp2(-x * LOG2E)); }
DI float siluf_(float x) { return x * sigmoidf_(x); }
DI float geluf_(float x) { const float t = x + 0.044715f * x * x * x; return x * frcp(1.0f + fexp2(-2.3022082f * t)); }
DI float wave_sum(float v) {
#pragma unroll
    for (int o = 1; o < 64; o <<= 1) v += __shfl_xor(v, o);
    return v;
}
#define LDS_WAIT() asm volatile("s_waitcnt lgkmcnt(0)" ::: "memory")
DI int opaque_tid() { int t = threadIdx.x; asm volatile("" : "+v"(t)); return t; }


#define XB_TMO      128
#define XB_XCNT(j)  (256  + 64 * (j))
#define XB_XSUB(j)  (1280 + 64 * (j))
#define XB_XGEN(j)  (2304 + 64 * (j))
#define XB_TOP      3328
#define XB_TOPGEN   3392
#define XCD_BAR_WORDS 3456
#define XB_SPIN_CAP (1u << 18)
DI unsigned xb_ld(unsigned* p)              { return __hip_atomic_load(p, __ATOMIC_RELAXED, __HIP_MEMORY_SCOPE_AGENT); }
DI unsigned xb_add(unsigned* p, unsigned v) { return __hip_atomic_fetch_add(p, v, __ATOMIC_RELAXED, __HIP_MEMORY_SCOPE_AGENT); }
DI unsigned xb_xcc_id() { return (unsigned)__builtin_amdgcn_s_getreg((3 << 11) | 20) & 0xFu; }
#define XB_SPIN(cond, bar) do { unsigned _sp = 0; while (cond) { __builtin_amdgcn_s_sleep(1); \
    if ((++_sp & 255u) == 0u) { if (xb_ld(&(bar)[XB_TMO])) break; if (_sp > XB_SPIN_CAP) { atomicAdd(&(bar)[XB_TMO], 1u); break; } } } } while (0)
struct XcdBarrier { unsigned* bar; unsigned x; volatile LAS unsigned* st; };
DI XcdBarrier xcd_barrier_post(unsigned* bar, volatile LAS unsigned* st) {
    XcdBarrier b; b.bar = bar; b.x = xb_xcc_id(); b.st = st;
    if (threadIdx.x == 0) (void)xb_add(&bar[XB_XCNT(b.x)], 1u);
    return b;
}
DI void xcd_barrier_complete(unsigned* bar, unsigned x, unsigned& nloc, unsigned& nx) {
    const unsigned G = gridDim.x * gridDim.y * gridDim.z;
    unsigned sum, cnt, mine, sp = 0u;
    for (;;) {
        sum = 0u; cnt = 0u; mine = 0u;
#pragma unroll
        for (unsigned j = 0; j < 16; ++j) { const unsigned c = xb_ld(&bar[XB_XCNT(j)]); sum += c; cnt += (c > 0u) ? 1u : 0u; mine = (j == x) ? c : mine; }
        if (sum == G) break;
        __builtin_amdgcn_s_sleep(1);
        if ((++sp & 255u) == 0u) { if (xb_ld(&bar[XB_TMO])) break; if (sp > XB_SPIN_CAP) { atomicAdd(&bar[XB_TMO], 1u); break; } }
    }
    nloc = mine > 0u ? mine : 1u; nx = cnt > 0u ? cnt : 1u;
}
DI void xcd_barrier(const XcdBarrier& b) {
    asm volatile("s_waitcnt vmcnt(0)" ::: "memory");
    __syncthreads();
    if (threadIdx.x == 0) {
        unsigned* bar = b.bar;
        __builtin_amdgcn_s_waitcnt(0);
        unsigned nloc = b.st[0], nx = b.st[1];
        if (nloc == 0u) { xcd_barrier_complete(bar, b.x, nloc, nx); b.st[0] = nloc; b.st[1] = nx; }
        const unsigned old = xb_add(&bar[XB_XSUB(b.x)], 1u);
        const unsigned gen = old / nloc;
        if (old + 1u == (gen + 1u) * nloc) {
            __builtin_amdgcn_fence(__ATOMIC_RELEASE, "agent");
            asm volatile("s_waitcnt vmcnt(0)" ::: "memory");
            const unsigned og = xb_add(&bar[XB_TOP], 1u);
            const unsigned tg = og / nx;
            if (og + 1u == (tg + 1u) * nx) xb_add(&bar[XB_TOPGEN], 1u);
            else XB_SPIN(xb_ld(&bar[XB_TOPGEN]) == tg, bar);
            __builtin_amdgcn_fence(__ATOMIC_ACQUIRE, "agent");
            xb_add(&bar[XB_XGEN(b.x)], 1u);
            asm volatile("s_waitcnt vmcnt(0)" ::: "memory");
        } else {
            XB_SPIN(xb_ld(&bar[XB_XGEN(b.x)]) == gen, bar);
            __builtin_amdgcn_fence(__ATOMIC_ACQUIRE, "agent");
            asm volatile("s_waitcnt vmcnt(0)" ::: "memory");
        }
    }
    __syncthreads();
}

namespace pg8 {
constexpr int BM = 256, BK = 64, HALF = 128, HTB = HALF * BK * 2, STAGE_BYTES = 8 * HTB, NXCD = 8, WGM = 8;
DI int lds_byte(int r, int c) { const int st = (r >> 4) * 2 + (c >> 5), rr = r & 15, cc = c & 31, ob = rr * 64 + cc * 2; return st * 1024 + (ob ^ (((ob >> 9) & 1) << 5)); }
DI void stage_rc(int b, int& R, int& C) { const int st = b / 1024, sb = b % 1024, swz = sb ^ (((sb >> 9) & 1) << 5); R = (st >> 1) * 16 + swz / 64; C = (st & 1) * 32 + (swz % 64) / 2; }
DI int perm32(int rho) { const int n = rho >> 4, i = rho & 15; return 8 * (i >> 2) + 4 * n + (i & 3); }

struct Unit { int pm, pn, sel; };
struct Gemm { const bf16_t* A0; const bf16_t* A1; const bf16_t* B0; const bf16_t* B1; int K; };
struct Order {
    int nM, nN, nwg, G, c, dual;
    DI void init(int M, int N, int G_, int c_, int dual_) { nM = M / BM; nN = N / BM; nwg = nM * nN; G = G_; c = c_; dual = dual_; }
    DI bool next(int i, Unit& u) const {
        const int ti = dual ? (i >> 1) : i; u.sel = dual ? (i & 1) : 0;
        const long L = (long)ti * G + c; if (L >= nwg) return false;
        int wgid = (int)L; { const int q = nwg / NXCD, r = nwg % NXCD, xcd = wgid % NXCD, off = wgid / NXCD; wgid = (xcd < r ? xcd * (q + 1) : r * (q + 1) + (xcd - r) * q) + off; }
        const int nig = WGM * nN, gid = wgid / nig, fm = gid * WGM, gsz = (nM - fm) < WGM ? (nM - fm) : WGM;
        u.pm = fm + ((wgid % nig) % gsz); u.pn = (wgid % nig) / gsz; return true;
    }
};

template <class Epi>
DI void gemm_phase(LAS unsigned char* lds, const Gemm g, const Order& S, const Epi& E) {
    const int tid = opaque_tid(), wid = __builtin_amdgcn_readfirstlane(tid >> 6), lane = tid & 63, wr = wid >> 2, wc = wid & 3, fr = lane & 15, fq = lane >> 4;
    const int K = g.K, nt = K / BK;
    unsigned voffA[2], voffB[2];
#pragma unroll
    for (int i = 0; i < 2; ++i) { int R, C; stage_rc(tid * 16 + i * 8192, R, C); const int Rb = Epi::PERM ? ((R & ~31) + perm32(R & 31)) : R;
        voffA[i] = (unsigned)(R * K + C) * 2u; voffB[i] = (unsigned)(Rb * K + C) * 2u; }
    const size_t kstep = (size_t)(BK * 2);
    const size_t hstep = (size_t)HALF * K * 2;
    const size_t tstep = 2 * hstep;
    const unsigned ldsw = (unsigned)wid * 1024u;
    const int aoff = lds_byte(wr * 64 + fr, fq * 8), boff = lds_byte(wc * 32 + fr, fq * 8);
#define PG8_SA(b, h) (((b) * 2 + (h)) * HTB)
#define PG8_SB(b, h) ((4 + (b) * 2 + (h)) * HTB)
#define PG8_STAGE(bufoff, gbase, voff) do { _Pragma("unroll") for (int _i = 0; _i < 2; ++_i) \
        __builtin_amdgcn_global_load_lds((const unsigned*)((const char*)(gbase) + (voff)[_i]), (LAS unsigned*)(lds + (bufoff) + ldsw + _i * 8192), 16, 0, 0); } while (0)
#define PG8_LDA(dst, b, h) do { _Pragma("unroll") for (int m = 0; m < 4; ++m) _Pragma("unroll") for (int k = 0; k < 2; ++k) dst[m][k] = *(const LAS bf16x8*)(lds + PG8_SA(b, h) + aoff + m * 2048 + k * 1024); } while (0)
#define PG8_LDB(dst, b, h) do { _Pragma("unroll") for (int n = 0; n < 2; ++n) _Pragma("unroll") for (int k = 0; k < 2; ++k) dst[n][k] = *(const LAS bf16x8*)(lds + PG8_SB(b, h) + boff + n * 2048 + k * 1024); } while (0)
#define PG8_MMA(ai, bj, At, Bt) do { __builtin_amdgcn_s_setprio(1); _Pragma("unroll") for (int m = 0; m < 4; ++m) _Pragma("unroll") for (int n = 0; n < 2; ++n) _Pragma("unroll") for (int k = 0; k < 2; ++k) \
        acc[ai][bj][m][n] = __builtin_amdgcn_mfma_f32_16x16x32_bf16(Bt[n][k], At[m][k], acc[ai][bj][m][n], 0, 0, 0); __builtin_amdgcn_s_setprio(0); } while (0)
#define PG8_WAIT_V(n) asm volatile("s_waitcnt vmcnt(" #n ")" ::: "memory")
#define PG8_WAIT_L(n) asm volatile("s_waitcnt lgkmcnt(" #n ")" ::: "memory")
#define PG8_BAR __builtin_amdgcn_s_barrier()
#define PG8_SCHED __builtin_amdgcn_sched_barrier(0)
    Unit cur, nxt; int ui = 0;
    if (!S.next(0, cur)) return;
    f32x4 acc[2][2][4][2];
#pragma unroll
    for (int a = 0; a < 2; ++a)
#pragma unroll
        for (int b = 0; b < 2; ++b)
#pragma unroll
            for (int m = 0; m < 4; ++m)
#pragma unroll
                for (int n = 0; n < 2; ++n) acc[a][b][m][n] = (f32x4){0.f, 0.f, 0.f, 0.f};
    bf16x8 At[4][2], B0[2][2], B1[2][2];
    const char* cA = (const char*)(cur.sel ? g.A1 : g.A0) + (size_t)cur.pm * tstep; const char* cB = (const char*)(cur.sel ? g.B1 : g.B0) + (size_t)cur.pn * tstep;
    PG8_STAGE(PG8_SB(0, 0), cB, voffB); PG8_STAGE(PG8_SB(0, 1), cB + hstep, voffB); PG8_STAGE(PG8_SA(0, 0), cA, voffA); PG8_STAGE(PG8_SA(0, 1), cA + hstep, voffA);
    if (wr == 1) PG8_BAR;
    PG8_WAIT_V(2); PG8_BAR;
    PG8_STAGE(PG8_SB(1, 0), cB + kstep, voffB); PG8_STAGE(PG8_SA(1, 0), cA + kstep, voffA); PG8_STAGE(PG8_SB(1, 1), cB + hstep + kstep, voffB);
    PG8_WAIT_V(6); PG8_BAR;
    for (;;) {
        const bool has_next = S.next(ui + 1, nxt);
        const char* nA = has_next ? (const char*)(nxt.sel ? g.A1 : g.A0) + (size_t)nxt.pm * tstep : cA; const char* nB = has_next ? (const char*)(nxt.sel ? g.B1 : g.B0) + (size_t)nxt.pn * tstep : cB;
        for (int t = 0; t < nt; t += 2) {
            const bool last = (t == nt - 2);
            const char* a1 = cA + (size_t)(t + 1) * kstep;
            const char* a2 = last ? nA : cA + (size_t)(t + 2) * kstep; const char* b2 = last ? nB : cB + (size_t)(t + 2) * kstep;
            const char* a3 = a2 + kstep; const char* b3 = b2 + kstep;
            PG8_LDB(B0, 0, 0); PG8_LDB(B1, 0, 1); PG8_SCHED; PG8_LDA(At, 0, 0); PG8_STAGE(PG8_SA(1, 1), a1 + hstep, voffA);
            PG8_WAIT_V(8); PG8_WAIT_L(0); PG8_BAR; PG8_MMA(0, 0, At, B0); PG8_MMA(0, 1, At, B1); PG8_BAR; PG8_SCHED;
            PG8_LDA(At, 0, 1); PG8_STAGE(PG8_SB(0, 0), b2, voffB); PG8_STAGE(PG8_SB(0, 1), b2 + hstep, voffB); PG8_STAGE(PG8_SA(0, 0), a2, voffA);
            PG8_WAIT_V(8); PG8_WAIT_L(0); PG8_BAR; PG8_MMA(1, 0, At, B0); PG8_MMA(1, 1, At, B1); PG8_BAR; PG8_SCHED;
            PG8_LDB(B0, 1, 0); PG8_LDB(B1, 1, 1); PG8_SCHED; PG8_LDA(At, 1, 0); PG8_STAGE(PG8_SA(0, 1), a2 + hstep, voffA);
            PG8_WAIT_V(8); PG8_WAIT_L(0); PG8_BAR; PG8_MMA(0, 0, At, B0); PG8_MMA(0, 1, At, B1); PG8_BAR; PG8_SCHED;
            PG8_LDA(At, 1, 1); PG8_STAGE(PG8_SB(1, 0), b3, voffB); PG8_STAGE(PG8_SB(1, 1), b3 + hstep, voffB); PG8_STAGE(PG8_SA(1, 0), a3, voffA);
            PG8_WAIT_V(8); PG8_WAIT_L(0); PG8_BAR; PG8_MMA(1, 0, At, B0); PG8_MMA(1, 1, At, B1); PG8_BAR; PG8_SCHED;
        }
        if (wr == 0) PG8_BAR;
        E(acc, cur, wr, wc, fr, fq);
        if (!has_next) break;
#pragma unroll
        for (int a = 0; a < 2; ++a)
#pragma unroll
            for (int b = 0; b < 2; ++b)
#pragma unroll
                for (int m = 0; m < 4; ++m)
#pragma unroll
                    for (int n = 0; n < 2; ++n) acc[a][b][m][n] = (f32x4){0.f, 0.f, 0.f, 0.f};
        cur = nxt; cA = nA; cB = nB; ++ui;
        if (wr == 1) PG8_BAR;
    }
    PG8_WAIT_V(0);
    PG8_BAR;
#undef PG8_SA
#undef PG8_SB
#undef PG8_STAGE
#undef PG8_LDA
#undef PG8_LDB
#undef PG8_MMA
#undef PG8_WAIT_V
#undef PG8_WAIT_L
#undef PG8_BAR
#undef PG8_SCHED
}
}

template <int ACT> DI float act_fn(float x) {
    if (ACT == 0) return x;
    if (ACT == 1) return siluf_(x) * 0.08838834764831845f;
    if (ACT == 2) return siluf_(x);
    if (ACT == 3) return geluf_(x);
    return sigmoidf_(x);
}
template <int ACT> DI void store_act(const f32x4 (&acc)[2][2][4][2], bf16_t* base, int row0, int col0) {
#pragma unroll
    for (int ai = 0; ai < 2; ++ai)
#pragma unroll
        for (int m = 0; m < 4; ++m) { bf16_t* rowp = base + (size_t)(row0 + ai * 128 + m * 16) * D + col0;
#pragma unroll
            for (int bj = 0; bj < 2; ++bj) { const f32x4 v0 = acc[ai][bj][m][0], v1 = acc[ai][bj][m][1];
                u32x4 w; w.x = pk2(act_fn<ACT>(v0[0]), act_fn<ACT>(v0[1])); w.y = pk2(act_fn<ACT>(v0[2]), act_fn<ACT>(v0[3]));
                w.z = pk2(act_fn<ACT>(v1[0]), act_fn<ACT>(v1[1])); w.w = pk2(act_fn<ACT>(v1[2]), act_fn<ACT>(v1[3]));
                *(u32x4*)(rowp + bj * 128) = w; } }
}
struct EpiInProj {
    static constexpr bool PERM = true;
    bf16_t* out9;
    DI void operator()(const f32x4 (&acc)[2][2][4][2], const pg8::Unit& u, int wr, int wc, int fr, int fq) const {
        const int pn = u.pn, row0 = u.pm * 256 + wr * 64 + fr, cl = wc * 32 + 8 * fq;
        if (pn >= 20 && pn < 28) {
            bf16_t* base = out9 + 5 * ARR; const int col0 = 128 * (pn - 20) + cl;
#pragma unroll
            for (int ai = 0; ai < 2; ++ai)
#pragma unroll
                for (int m = 0; m < 4; ++m) { bf16_t* rowp = base + (size_t)(row0 + ai * 128 + m * 16) * D + col0;
                    const f32x4 u0 = acc[ai][0][m][0], u1 = acc[ai][0][m][1], g0 = acc[ai][1][m][0], g1 = acc[ai][1][m][1];
                    u32x4 w; w.x = pk2(geluf_(u0[0]) * siluf_(g0[0]), geluf_(u0[1]) * siluf_(g0[1])); w.y = pk2(geluf_(u0[2]) * siluf_(g0[2]), geluf_(u0[3]) * siluf_(g0[3]));
                    w.z = pk2(geluf_(u1[0]) * siluf_(g1[0]), geluf_(u1[1]) * siluf_(g1[1])); w.w = pk2(geluf_(u1[2]) * siluf_(g1[2]), geluf_(u1[3]) * siluf_(g1[3]));
                    *(u32x4*)rowp = w; }
            return;
        }
        int idx, ct;
        if (pn < 20) { idx = pn >> 2; ct = pn & 3; } else if (pn < 32) { idx = 6; ct = pn - 28; } else { idx = 7 + ((pn - 32) >> 2); ct = (pn - 32) & 3; }
        bf16_t* base = out9 + (size_t)idx * ARR; const int col0 = 256 * ct + cl;
        if (idx == 0) store_act<1>(acc, base, row0, col0);
        else if (idx <= 3) store_act<0>(acc, base, row0, col0);
        else if (idx == 4) store_act<2>(acc, base, row0, col0);
        else if (idx == 6) store_act<3>(acc, base, row0, col0);
        else store_act<4>(acc, base, row0, col0);
    }
};
struct EpiProjAB {
    static constexpr bool PERM = true;
    const bf16_t* SMA; const bf16_t* SMB; bf16_t* MG;
    DI void operator()(const f32x4 (&acc)[2][2][4][2], const pg8::Unit& u, int wr, int wc, int fr, int fq) const {
        const int row0 = u.pm * 256 + wr * 64 + fr, col0 = u.pn * 256 + wc * 32 + 8 * fq;
        const bf16_t* gate = u.sel ? SMB : SMA;
#pragma unroll
        for (int ai = 0; ai < 2; ++ai)
#pragma unroll
            for (int m = 0; m < 4; ++m) { const size_t off = (size_t)(row0 + ai * 128 + m * 16) * D + col0;
#pragma unroll
                for (int bj = 0; bj < 2; ++bj) { const f32x4 v0 = acc[ai][bj][m][0], v1 = acc[ai][bj][m][1];
                    const u32x4 gw = *(const u32x4*)(gate + off + bj * 128);
                    float o[8] = {v0[0] * bflo(gw.x), v0[1] * bfhi(gw.x), v0[2] * bflo(gw.y), v0[3] * bfhi(gw.y), v1[0] * bflo(gw.z), v1[1] * bfhi(gw.z), v1[2] * bflo(gw.w), v1[3] * bfhi(gw.w)};
                    if (u.sel) { const u32x4 tw = *(const u32x4*)(MG + off + bj * 128);
                        o[0] += bflo(tw.x); o[1] += bfhi(tw.x); o[2] += bflo(tw.y); o[3] += bfhi(tw.y); o[4] += bflo(tw.z); o[5] += bfhi(tw.z); o[6] += bflo(tw.w); o[7] += bfhi(tw.w); }
                    u32x4 w; w.x = pk2(o[0], o[1]); w.y = pk2(o[2], o[3]); w.z = pk2(o[4], o[5]); w.w = pk2(o[6], o[7]);
                    *(u32x4*)(MG + off + bj * 128) = w; }
                asm volatile("" ::: "memory"); }
    }
};
struct EpiResid {
    static constexpr bool PERM = false;
    const float* xin; float* out;
    DI void operator()(const f32x4 (&acc)[2][2][4][2], const pg8::Unit& u, int wr, int wc, int fr, int fq) const {
        const int row0 = u.pm * 256 + wr * 64 + fr, col0 = u.pn * 256 + wc * 32 + 4 * fq;
#pragma unroll
        for (int ai = 0; ai < 2; ++ai)
#pragma unroll
            for (int m = 0; m < 4; ++m) { const size_t off = (size_t)(row0 + ai * 128 + m * 16) * D + col0;
#pragma unroll
                for (int bj = 0; bj < 2; ++bj)
#pragma unroll
                    for (int n = 0; n < 2; ++n) { const f32x4 xv = *(const f32x4*)(xin + off + bj * 128 + n * 16); *(f32x4*)(out + off + bj * 128 + n * 16) = xv + acc[ai][bj][m][n]; }
                asm volatile("" ::: "memory"); }
    }
};

DI int src_col(int nv) {
    if (nv < 5120) return nv;
    if (nv < 7168) { const int t = (nv - 5120) >> 8, w = (nv - 5120) & 255; return w < 128 ? 5120 + 128 * t + w : 7168 + 128 * t + (w - 128); }
    if (nv < 8192) return 6144 + (nv - 7168);
    return nv;
}
DI void transpose_item(const float* W, int N, bf16_t* WT, int k0, int nsrc0, int nvirt0, LAS float* scr, int lane) {
#pragma unroll 8
    for (int i = 0; i < 32; ++i) { const int kk = 2 * i + (lane >> 5); scr[kk * 33 + (lane & 31)] = W[(size_t)(k0 + kk) * N + nsrc0 + (lane & 31)]; }
    LDS_WAIT();
    const int c = lane & 7;
#pragma unroll
    for (int j = 0; j < 4; ++j) { const int n = (lane >> 3) + 8 * j; const LAS float* s = scr + (8 * c) * 33 + n;
        u32x4 o; o.x = pk2(s[0 * 33], s[1 * 33]); o.y = pk2(s[2 * 33], s[3 * 33]); o.z = pk2(s[4 * 33], s[5 * 33]); o.w = pk2(s[6 * 33], s[7 * 33]);
        *(u32x4*)(WT + (size_t)(nvirt0 + n) * D + k0 + 8 * c) = o; }
    LDS_WAIT();
}
DI void phase_prep(LAS unsigned char* lds, const float* w_in, const float* wa, const float* wb, const float* wo, unsigned char* ws, int G) {
    const int tid_ = opaque_tid(); const int lane = tid_ & 63, wave = __builtin_amdgcn_readfirstlane(tid_ >> 6);
    LAS float* scr = (LAS float*)(lds + wave * 16384);
    const int gw = blockIdx.x * 8 + wave, NGW = G * 8;
    constexpr int I_IN = 16 * 320, I_P = 16 * 32, PER_L = I_IN + 3 * I_P;
    for (int it = gw; it < PER_L; it += NGW) {
        int r = it;
        if (r < I_IN) { const int kb = r / 320, nb = r % 320; transpose_item(w_in, NIN, (bf16_t*)(ws + WS_WIN), 64 * kb, src_col(32 * nb), 32 * nb, scr, lane); continue; }
        r -= I_IN; const int which = r / I_P; r %= I_P; const int kb = r / 32, nb = r % 32;
        const float* W = (which == 0 ? wa : which == 1 ? wb : wo);
        bf16_t* WT = (bf16_t*)(ws + (which == 0 ? WS_WA : which == 1 ? WS_WB : WS_WO));
        transpose_item(W, D, WT, 64 * kb, 32 * nb, 32 * nb, scr, lane);
    }
}
DI void phase_rms_bf16(const float* x, const float* w, bf16_t* h, int nrows, int G) {
    const int tid_ = opaque_tid(); const int lane = tid_ & 63, wave = __builtin_amdgcn_readfirstlane(tid_ >> 6);
    const int gw = blockIdx.x * 8 + wave, NGW = G * 8;
    f32x4 wv[4];
#pragma unroll
    for (int j = 0; j < 4; ++j) wv[j] = ((const f32x4*)w)[lane + 64 * j];
    for (int m = gw; m < nrows; m += NGW) {
        const f32x4* xr = (const f32x4*)(x + (size_t)m * D) + lane; f32x4 v[4]; float s = 0.f;
#pragma unroll
        for (int j = 0; j < 4; ++j) { v[j] = xr[64 * j]; s += (v[j].x * v[j].x + v[j].y * v[j].y) + (v[j].z * v[j].z + v[j].w * v[j].w); }
        const float rstd = rsqrtf(wave_sum(s) * (1.0f / D) + 1e-6f);
        u32x2* o8 = (u32x2*)(h + (size_t)m * D) + lane;
#pragma unroll
        for (int j = 0; j < 4; ++j) { u32x2 o; o.x = pk2(v[j].x * rstd * wv[j].x, v[j].y * rstd * wv[j].y); o.y = pk2(v[j].z * rstd * wv[j].z, v[j].w * rstd * wv[j].w); o8[64 * j] = o; }
    }
}
DI void phase_final(float* x, const float* w, int nrows, int G) {
    const int tid_ = opaque_tid(); const int lane = tid_ & 63, wave = __builtin_amdgcn_readfirstlane(tid_ >> 6);
    const int gw = blockIdx.x * 8 + wave, NGW = G * 8;
    f32x4 wv[4];
#pragma unroll
    for (int j = 0; j < 4; ++j) wv[j] = ((const f32x4*)w)[lane + 64 * j];
    for (int m = gw; m < nrows; m += NGW) {
        f32x4* xr = (f32x4*)(x + (size_t)m * D) + lane; f32x4 v[4]; float s = 0.f;
#pragma unroll
        for (int j = 0; j < 4; ++j) { v[j] = xr[64 * j]; s += (v[j].x * v[j].x + v[j].y * v[j].y) + (v[j].z * v[j].z + v[j].w * v[j].w); }
        const float rstd = rsqrtf(wave_sum(s) * (1.0f / D) + 1e-6f);
#pragma unroll
        for (int j = 0; j < 4; ++j) xr[64 * j] = v[j] * rstd * wv[j];
    }
}
#define MFMA32(a, b, c) __builtin_amdgcn_mfma_f32_32x32x16_bf16((a), (b), (c), 0, 0, 0)
struct S1Regs { u32x4 q0, q1, z0, z1, v0, v1; };
DI void s1_load(S1Regs& R, const bf16_t* Q, const bf16_t* Z, const bf16_t* Iv, int it, int tid) {
    const int c = it & 63, dir = (it >> 6) & 1, h = (it >> 7) & 7, b = it >> 10, j = tid >> 3, cg = tid & 7;
    const size_t off = ((size_t)b * SEQ + c * 64 + (dir ? 63 - j : j)) * D + h * 128 + 16 * cg;
    const bf16_t* zp = Z + (size_t)dir * ARR;
    R.q0 = *(const u32x4*)(Q + off); R.q1 = *(const u32x4*)(Q + off + 8);
    R.z0 = *(const u32x4*)(zp + off); R.z1 = *(const u32x4*)(zp + off + 8);
    R.v0 = *(const u32x4*)(Iv + off); R.v1 = *(const u32x4*)(Iv + off + 8);
}
DI void phase_s1(LAS unsigned char* lds, const bf16_t* Q, bf16_t* Z, const bf16_t* Iv, bf16_t* O, bf16_t* X, float* AC, const float* LBT, int G) {
    const int tid = opaque_tid(), lane = tid & 63, wave = __builtin_amdgcn_readfirstlane(tid >> 6);
    const int r = lane & 31, hh = lane >> 5, j8 = tid >> 3, cg8 = tid & 7;
    LAS bf16_t* TQ = (LAS bf16_t*)(lds);
    LAS bf16_t* TV = (LAS bf16_t*)(lds + 17408);
    LAS bf16_t* TZ = (LAS bf16_t*)(lds + 34816);
    LAS bf16_t* QS = (LAS bf16_t*)(lds + 52224);
    LAS bf16_t* KS = (LAS bf16_t*)(lds + 69632);
    LAS bf16_t* KHT = (LAS bf16_t*)(lds + 87040);
    LAS bf16_t* VT = (LAS bf16_t*)(lds + 105472);
    LAS bf16_t* PS = (LAS bf16_t*)(lds + 123904);
    LAS bf16_t* DS = TQ;
    S1Regs R;
    int it = blockIdx.x;
    if (it < 4096) s1_load(R, Q, Z, Iv, it, tid);
    __syncthreads();
    for (; it < 4096; it += G) {
        const int c = it & 63, dir = (it >> 6) & 1, h = (it >> 7) & 7, b = it >> 10, seq = (b * 8 + h) * 2 + dir;
        const size_t rowbase = (size_t)b * SEQ + c * 64;
        *(LAS u32x4*)(TQ + j8 * 136 + 16 * cg8) = R.q0; *(LAS u32x4*)(TQ + j8 * 136 + 16 * cg8 + 8) = R.q1;
        *(LAS u32x4*)(TZ + j8 * 136 + 16 * cg8) = R.z0; *(LAS u32x4*)(TZ + j8 * 136 + 16 * cg8 + 8) = R.z1;
        *(LAS u32x4*)(TV + j8 * 136 + 16 * cg8) = R.v0; *(LAS u32x4*)(TV + j8 * 136 + 16 * cg8 + 8) = R.v1;
        if (it + G < 4096) s1_load(R, Q, Z, Iv, it + G, tid);
        __syncthreads();
        {
            const float* lp = LBT + dir * 2048 + h * 128 + 16 * wave;
            const u32x4 z0 = *(const LAS u32x4*)(TZ + lane * 136 + 16 * wave), z1 = *(const LAS u32x4*)(TZ + lane * 136 + 16 * wave + 8);
            const u32x4 q0 = *(const LAS u32x4*)(TQ + lane * 136 + 16 * wave), q1 = *(const LAS u32x4*)(TQ + lane * 136 + 16 * wave + 8);
            const u32x4 v0 = *(const LAS u32x4*)(TV + lane * 136 + 16 * wave), v1 = *(const LAS u32x4*)(TV + lane * 136 + 16 * wave + 8);
            const unsigned zw[8] = {z0.x, z0.y, z0.z, z0.w, z1.x, z1.y, z1.z, z1.w};
            const unsigned qw[8] = {q0.x, q0.y, q0.z, q0.w, q1.x, q1.y, q1.z, q1.w};
            const unsigned vw[8] = {v0.x, v0.y, v0.z, v0.w, v1.x, v1.y, v1.z, v1.w};
            float kk[16], gg[16];
#pragma unroll
            for (int i = 0; i < 16; ++i) { const unsigned w = zw[i >> 1]; float z = (i & 1) ? bfhi(w) : bflo(w); z = fminf(fmaxf(z, -30.f), 30.f);
                const float e = fexp2(-z * LOG2E), sg = frcp(1.0f + e); const float om = lp[1024 + i];
                kk[i] = om * e * sg; gg[i] = __builtin_amdgcn_logf(lp[i] + om * sg); }
#pragma unroll
            for (int off = 1; off < 64; off <<= 1) {
#pragma unroll
                for (int i = 0; i < 16; ++i) { const float t = __shfl_up(gg[i], off); gg[i] += (lane >= off) ? t : 0.f; }
            }
            unsigned qo[8], ko[8], kh[8], qh[8];
            float a16[16];
#pragma unroll
            for (int w = 0; w < 8; ++w) {
                float qt_[2], kt_[2], kh_[2], qh_[2];
#pragma unroll
                for (int e2 = 0; e2 < 2; ++e2) { const int i = 2 * w + e2; const float qf = e2 ? bfhi(qw[w]) : bflo(qw[w]);
                    const float Rr = __int_as_float(__builtin_amdgcn_readlane(__float_as_int(gg[i]), 31)), G63 = __int_as_float(__builtin_amdgcn_readlane(__float_as_int(gg[i]), 63));
                    const float dq = gg[i] - Rr;
                    qt_[e2] = qf * fexp2(fminf(dq, 100.f)); kt_[e2] = kk[i] * fexp2(fminf(-dq, 100.f));
                    a16[i] = fexp2(gg[i]); kh_[e2] = kk[i] * fexp2(G63 - gg[i]); qh_[e2] = qf * a16[i]; }
                qo[w] = pk2(qt_[0], qt_[1]); ko[w] = pk2(kt_[0], kt_[1]); kh[w] = pk2(kh_[0], kh_[1]); qh[w] = pk2(qh_[0], qh_[1]);
            }
            *(LAS u32x4*)(QS + lane * 136 + 16 * wave) = (u32x4){qo[0], qo[1], qo[2], qo[3]}; *(LAS u32x4*)(QS + lane * 136 + 16 * wave + 8) = (u32x4){qo[4], qo[5], qo[6], qo[7]};
            *(LAS u32x4*)(KS + lane * 136 + 16 * wave) = (u32x4){ko[0], ko[1], ko[2], ko[3]}; *(LAS u32x4*)(KS + lane * 136 + 16 * wave + 8) = (u32x4){ko[4], ko[5], ko[6], ko[7]};
            *(LAS u32x4*)(TZ + lane * 136 + 16 * wave) = (u32x4){qh[0], qh[1], qh[2], qh[3]}; *(LAS u32x4*)(TZ + lane * 136 + 16 * wave + 8) = (u32x4){qh[4], qh[5], qh[6], qh[7]};
#pragma unroll
            for (int w = 0; w < 8; ++w) {
                KHT[(16 * wave + 2 * w) * 72 + lane] = (bf16_t)(kh[w] & 0xffffu); KHT[(16 * wave + 2 * w + 1) * 72 + lane] = (bf16_t)(kh[w] >> 16);
                VT[(16 * wave + 2 * w) * 72 + lane] = (bf16_t)(vw[w] & 0xffffu); VT[(16 * wave + 2 * w + 1) * 72 + lane] = (bf16_t)(vw[w] >> 16);
            }
            if (lane == 63) { float* ap = AC + ((size_t)seq * 64 + c) * 128 + 16 * wave;
#pragma unroll
                for (int q4 = 0; q4 < 4; ++q4) *(f32x4*)(ap + 4 * q4) = (f32x4){a16[4 * q4], a16[4 * q4 + 1], a16[4 * q4 + 2], a16[4 * q4 + 3]}; }
        }
        __syncthreads();
        {
            if (wave < 3) {
                const int tm = (wave == 2) ? 1 : 0, tn = (wave == 0) ? 0 : 1;
                f32x16 acc;
#pragma unroll
                for (int i = 0; i < 16; ++i) acc[i] = 0.f;
#pragma unroll
                for (int ks = 0; ks < 8; ++ks) { const bf16x8 a = *(const LAS bf16x8*)(KS + (32 * tm + r) * 136 + 16 * ks + 8 * hh), bb = *(const LAS bf16x8*)(QS + (32 * tn + r) * 136 + 16 * ks + 8 * hh); acc = MFMA32(a, bb, acc); }
                const int t = 32 * tn + r;
#pragma unroll
                for (int g = 0; g < 4; ++g) { const int s0 = 32 * tm + 8 * g + 4 * hh;
                    const float p0 = (s0 + 0 <= t) ? acc[4 * g + 0] : 0.f, p1 = (s0 + 1 <= t) ? acc[4 * g + 1] : 0.f, p2 = (s0 + 2 <= t) ? acc[4 * g + 2] : 0.f, p3 = (s0 + 3 <= t) ? acc[4 * g + 3] : 0.f;
                    *(LAS u32x2*)(PS + t * 72 + s0) = (u32x2){pk2(p0, p1), pk2(p2, p3)}; }
            }
            const int nd = (wave < 3) ? 1 : ((wave < 6) ? 3 : 2);
            for (int k = 0; k < nd; ++k) {
                const int tile = (wave < 3) ? 13 + wave : (wave - 3) + 5 * k;
                const int dt = tile >> 2, vt = tile & 3;
                f32x16 acc;
#pragma unroll
                for (int i = 0; i < 16; ++i) acc[i] = 0.f;
#pragma unroll
                for (int ks = 0; ks < 4; ++ks) { const bf16x8 a = *(const LAS bf16x8*)(KHT + (32 * dt + r) * 72 + 16 * ks + 8 * hh), bb = *(const LAS bf16x8*)(VT + (32 * vt + r) * 72 + 16 * ks + 8 * hh); acc = MFMA32(a, bb, acc); }
                LAS bf16_t* xp = DS + (32 * vt + r) * 136 + 32 * dt + 4 * hh;
#pragma unroll
                for (int g = 0; g < 4; ++g) *(LAS u32x2*)(xp + 8 * g) = (u32x2){pk2(acc[4 * g], acc[4 * g + 1]), pk2(acc[4 * g + 2], acc[4 * g + 3])};
            }
            {
                bf16_t* zp = Z + (size_t)dir * ARR + (rowbase + (dir ? 63 - j8 : j8)) * D + h * 128 + 16 * cg8;
                *(u32x4*)zp = *(const LAS u32x4*)(TZ + j8 * 136 + 16 * cg8); *(u32x4*)(zp + 8) = *(const LAS u32x4*)(TZ + j8 * 136 + 16 * cg8 + 8);
            }
        }
        __syncthreads();
        {
            const int vt = wave & 3, tn = wave >> 2;
            f32x16 acc;
#pragma unroll
            for (int i = 0; i < 16; ++i) acc[i] = 0.f;
#pragma unroll
            for (int ks = 0; ks < 4; ++ks) { if (ks < 2 * (tn + 1)) { const bf16x8 a = *(const LAS bf16x8*)(VT + (32 * vt + r) * 72 + 16 * ks + 8 * hh), bb = *(const LAS bf16x8*)(PS + (32 * tn + r) * 72 + 16 * ks + 8 * hh); acc = MFMA32(a, bb, acc); } }
            LAS bf16_t* op = QS + (32 * tn + r) * 136 + 32 * vt + 4 * hh;
#pragma unroll
            for (int g = 0; g < 4; ++g) *(LAS u32x2*)(op + 8 * g) = (u32x2){pk2(acc[4 * g], acc[4 * g + 1]), pk2(acc[4 * g + 2], acc[4 * g + 3])};
            bf16_t* xb = X + ((size_t)seq * 64 + c) * 16384;
#pragma unroll
            for (int k = 0; k < 4; ++k) { const int id = tid + 512 * k, v = id >> 4, sg = id & 15; *(u32x4*)(xb + v * 128 + 8 * sg) = *(const LAS u32x4*)(DS + v * 136 + 8 * sg); }
        }
        __syncthreads();
        {
            bf16_t* op = O + (size_t)dir * ARR + (rowbase + (dir ? 63 - j8 : j8)) * D + h * 128 + 16 * cg8;
            *(u32x4*)op = *(const LAS u32x4*)(QS + j8 * 136 + 16 * cg8); *(u32x4*)(op + 8) = *(const LAS u32x4*)(QS + j8 * 136 + 16 * cg8 + 8);
        }
    }
}
DI void phase_lnstats(const bf16_t* GV, f32x2* STATS, int G) {
    const int tid_ = opaque_tid(); const int lane = tid_ & 63, wave = __builtin_amdgcn_readfirstlane(tid_ >> 6);
    const int gw = blockIdx.x * 8 + wave, NGW = G * 8;
    for (int m = gw; m < MH; m += NGW) {
        const bf16_t* p = GV + (size_t)m * D + 16 * lane;
        const u32x4 a0 = *(const u32x4*)p, a1 = *(const u32x4*)(p + 8);
        const unsigned aw[8] = {a0.x, a0.y, a0.z, a0.w, a1.x, a1.y, a1.z, a1.w};
        float s1 = 0.f, s2 = 0.f;
#pragma unroll
        for (int w = 0; w < 8; ++w) { const float x0 = bflo(aw[w]), x1 = bfhi(aw[w]); s1 += x0 + x1; s2 += x0 * x0 + x1 * x1; }
        s1 = wave_sum(s1); s2 = wave_sum(s2);
        const float mean = s1 * (1.0f / D), var = fmaxf(s2 * (1.0f / D) - mean * mean, 0.f);
        if (lane == 0) STATS[m] = (f32x2){mean, rsqrtf(var + 1e-5f)};
    }
}
DI void phase_s2(bf16_t* X, const float* AC, int G) {
    const int tid = opaque_tid();
    for (int gid = blockIdx.x * 512 + tid; gid < 64 * 2048; gid += G * 512) {
        const int seq = gid >> 11, e = gid & 2047, d0 = (e & 15) * 8, dir = seq & 1;
        bf16_t* xp = X + (size_t)seq * 64 * 16384 + (size_t)(e >> 4) * 128 + d0;
        const float* ap = AC + (size_t)seq * 64 * 128 + d0;
        float S[8];
#pragma unroll
        for (int i = 0; i < 8; ++i) S[i] = 0.f;
        for (int st = 0; st < 64; st += 4) {
            u32x4 dv[4]; f32x4 a0[4], a1[4];
#pragma unroll
            for (int u = 0; u < 4; ++u) { const int c = dir ? 63 - (st + u) : st + u; dv[u] = *(const u32x4*)(xp + (size_t)c * 16384); a0[u] = *(const f32x4*)(ap + c * 128); a1[u] = *(const f32x4*)(ap + c * 128 + 4); }
#pragma unroll
            for (int u = 0; u < 4; ++u) { const int c = dir ? 63 - (st + u) : st + u;
                *(u32x4*)(xp + (size_t)c * 16384) = (u32x4){pk2(S[0], S[1]), pk2(S[2], S[3]), pk2(S[4], S[5]), pk2(S[6], S[7])};
                S[0] = a0[u].x * S[0] + bflo(dv[u].x); S[1] = a0[u].y * S[1] + bfhi(dv[u].x); S[2] = a0[u].z * S[2] + bflo(dv[u].y); S[3] = a0[u].w * S[3] + bfhi(dv[u].y);
                S[4] = a1[u].x * S[4] + bflo(dv[u].z); S[5] = a1[u].y * S[5] + bfhi(dv[u].z); S[6] = a1[u].z * S[6] + bflo(dv[u].w); S[7] = a1[u].w * S[7] + bfhi(dv[u].w); }
        }
    }
}
struct S3Regs { u32x4 x[8], q[8]; };
DI void s3_load(S3Regs& R, const bf16_t* QH, const bf16_t* X, int it, int dir, int ts, int vt, int lane) {
    const int c = it & 63, h = (it >> 6) & 7, b = it >> 9;
    const bf16_t* xp = X + ((size_t)((b * 8 + h) * 2 + dir) * 64 + c) * 16384 + (size_t)(32 * vt) * 128 + 8 * lane;
    const bf16_t* qp = QH + (size_t)dir * ARR + ((size_t)b * SEQ + c * 64 + 32 * ts + (lane >> 4)) * D + h * 128 + 8 * (lane & 15);
#pragma unroll
    for (int k = 0; k < 8; ++k) { R.x[k] = *(const u32x4*)(xp + 512 * k); R.q[k] = *(const u32x4*)(qp + (size_t)(4 * k) * D); }
}
DI void phase_s3(LAS unsigned char* lds, const bf16_t* QH, const bf16_t* O, const bf16_t* X, const bf16_t* SGA, const float* gw_, bf16_t* YA, int G) {
    const int tid = opaque_tid(), lane = tid & 63, wave = __builtin_amdgcn_readfirstlane(tid >> 6);
    const int r = lane & 31, hh = lane >> 5, ts = wave >> 2, vt = wave & 3;
    LAS bf16_t* XW = (LAS bf16_t*)(lds + wave * 17408);
    LAS bf16_t* QW = XW + 32 * 136;
    LAS float* SS = (LAS float*)(lds + 8 * 17408);
    S3Regs R;
    int it = blockIdx.x;
    if (it < 2048) s3_load(R, QH, X, it, 0, ts, vt, lane);
    __syncthreads();
    for (; it < 2048; it += G) {
        const int c = it & 63, h = (it >> 6) & 7, b = it >> 9;
        const size_t row = (size_t)b * SEQ + c * 64 + 32 * ts + r;
        f32x16 acc;
#pragma unroll
        for (int i = 0; i < 16; ++i) acc[i] = 0.f;
#pragma unroll
        for (int dir = 0; dir < 2; ++dir) {
#pragma unroll
            for (int k = 0; k < 8; ++k) { const int id = 64 * k + lane; *(LAS u32x4*)(XW + (id >> 4) * 136 + 8 * (id & 15)) = R.x[k]; *(LAS u32x4*)(QW + (id >> 4) * 136 + 8 * (id & 15)) = R.q[k]; }
            if (dir == 0) s3_load(R, QH, X, it, 1, ts, vt, lane); else if (it + G < 2048) s3_load(R, QH, X, it + G, 0, ts, vt, lane);
#pragma unroll
            for (int ks = 0; ks < 8; ++ks) { const bf16x8 a = *(const LAS bf16x8*)(XW + r * 136 + 16 * ks + 8 * hh), bb = *(const LAS bf16x8*)(QW + r * 136 + 16 * ks + 8 * hh); acc = MFMA32(a, bb, acc); }
        }
        const size_t ooff = row * D + h * 128 + 32 * vt + 4 * hh;
        float o[16]; float ss = 0.f;
#pragma unroll
        for (int g = 0; g < 4; ++g) { const u32x2 f = *(const u32x2*)(O + ooff + 8 * g), bk = *(const u32x2*)(O + ARR + ooff + 8 * g);
            o[4 * g] = acc[4 * g] + bflo(f.x) + bflo(bk.x); o[4 * g + 1] = acc[4 * g + 1] + bfhi(f.x) + bfhi(bk.x); o[4 * g + 2] = acc[4 * g + 2] + bflo(f.y) + bflo(bk.y); o[4 * g + 3] = acc[4 * g + 3] + bfhi(f.y) + bfhi(bk.y); }
#pragma unroll
        for (int i = 0; i < 16; ++i) ss += o[i] * o[i];
        ss += __shfl_xor(ss, 32);
        __syncthreads();
        if (hh == 0) SS[(32 * ts + r) * 4 + vt] = ss;
        __syncthreads();
        const f32x4 s4 = *(const LAS f32x4*)(SS + (32 * ts + r) * 4);
        const float rstd = rsqrtf((s4.x + s4.y + s4.z + s4.w) * (1.0f / 128.0f) + 1e-6f);
#pragma unroll
        for (int g = 0; g < 4; ++g) { const u32x2 sg = *(const u32x2*)(SGA + ooff + 8 * g); const f32x4 gv = *(const f32x4*)(gw_ + 32 * vt + 8 * g + 4 * hh);
            *(u32x2*)(YA + ooff + 8 * g) = (u32x2){pk2(o[4 * g] * rstd * gv.x * bflo(sg.x), o[4 * g + 1] * rstd * gv.y * bfhi(sg.x)), pk2(o[4 * g + 2] * rstd * gv.z * bflo(sg.y), o[4 * g + 3] * rstd * gv.w * bfhi(sg.y))}; }
    }
}

DI void phase_spatial(LAS unsigned char* lds, const bf16_t* GV, bf16_t* UG, const f32x2* STATS, const float* ln_w, const float* ln_b, const float* w_s, const float* b_s, int G) {
    const int tid = opaque_tid(), lane = tid & 63, wave = __builtin_amdgcn_readfirstlane(tid >> 6);
    const int r = lane & 31, hh = lane >> 5;
    LAS bf16_t* VL = (LAS bf16_t*)(lds);
    LAS bf16_t* WS = (LAS bf16_t*)(lds + 34816);
    for (int it = blockIdx.x; it < 1024; it += G) {
        const int g = it & 7, n = (it >> 3) & 31, b = it >> 8;
        const size_t rowbase = (size_t)b * SEQ + (size_t)n * 128;
        __syncthreads();
        {
            const int s = tid >> 2, cq = tid & 3; const f32x2 st = STATS[rowbase + s];
            const bf16_t* p = GV + (rowbase + s) * D + 128 * g + 32 * cq;
#pragma unroll
            for (int q = 0; q < 4; ++q) { const u32x4 a = *(const u32x4*)(p + 8 * q); const unsigned aw[4] = {a.x, a.y, a.z, a.w};
                const f32x4 w0 = *(const f32x4*)(ln_w + 128 * g + 32 * cq + 8 * q), w1 = *(const f32x4*)(ln_w + 128 * g + 32 * cq + 8 * q + 4);
                const f32x4 c0 = *(const f32x4*)(ln_b + 128 * g + 32 * cq + 8 * q), c1 = *(const f32x4*)(ln_b + 128 * g + 32 * cq + 8 * q + 4);
                const float wv[8] = {w0.x, w0.y, w0.z, w0.w, w1.x, w1.y, w1.z, w1.w}, bv[8] = {c0.x, c0.y, c0.z, c0.w, c1.x, c1.y, c1.z, c1.w};
#pragma unroll
                for (int w = 0; w < 4; ++w) { const float y0 = (bflo(aw[w]) - st.x) * st.y * wv[2 * w] + bv[2 * w], y1 = (bfhi(aw[w]) - st.x) * st.y * wv[2 * w + 1] + bv[2 * w + 1];
                    const unsigned pk = pk2(y0, y1); const int cc = 32 * cq + 8 * q + 2 * w;
                    VL[cc * 136 + s] = (bf16_t)(pk & 0xffffu); VL[(cc + 1) * 136 + s] = (bf16_t)(pk >> 16); } }
            const int t = tid >> 2, sq = tid & 3; const float* wp = w_s + ((size_t)g * 128 + t) * 128 + 32 * sq;
#pragma unroll
            for (int q = 0; q < 4; ++q) { const f32x4 x0 = *(const f32x4*)(wp + 8 * q), x1 = *(const f32x4*)(wp + 8 * q + 4);
                *(LAS u32x4*)(WS + t * 136 + 32 * sq + 8 * q) = (u32x4){pk2(x0.x, x0.y), pk2(x0.z, x0.w), pk2(x1.x, x1.y), pk2(x1.z, x1.w)}; }
        }
        __syncthreads();
        {
            const int cm = wave & 3;
#pragma unroll
            for (int tt = 0; tt < 2; ++tt) {
                const int tn = 2 * (wave >> 2) + tt;
                f32x16 acc;
#pragma unroll
                for (int i = 0; i < 16; ++i) acc[i] = 0.f;
#pragma unroll
                for (int ks = 0; ks < 8; ++ks) { const bf16x8 a = *(const LAS bf16x8*)(VL + (32 * cm + r) * 136 + 16 * ks + 8 * hh), bb = *(const LAS bf16x8*)(WS + (32 * tn + r) * 136 + 16 * ks + 8 * hh); acc = MFMA32(a, bb, acc); }
                const int t = 32 * tn + r; const float bias = b_s[g * 128 + t];
                bf16_t* up = UG + (rowbase + t) * D + 128 * g + 32 * cm + 4 * hh;
#pragma unroll
                for (int q = 0; q < 4; ++q) { const u32x2 uw = *(const u32x2*)(up + 8 * q);
                    *(u32x2*)(up + 8 * q) = (u32x2){pk2(bflo(uw.x) * (acc[4 * q] + bias), bfhi(uw.x) * (acc[4 * q + 1] + bias)), pk2(bflo(uw.y) * (acc[4 * q + 2] + bias), bfhi(uw.y) * (acc[4 * q + 3] + bias))}; }
            }
        }
    }
}

struct Args { const float* in[13]; float* out; unsigned char* ws; int ph_lo, ph_hi; };
constexpr int NPH = 4 * 13 + 1;

__global__ void __launch_bounds__(512, 2) mega(Args a) {
    extern __shared__ __attribute__((aligned(16))) unsigned char shm[];
    LAS unsigned char* lds = (LAS unsigned char*)shm;
    cg::grid_group grid = cg::this_grid();
    const int G = gridDim.x, blk = blockIdx.x;
    unsigned char* ws = a.ws;
    const float* x0 = a.in[0];
    bf16_t* Hb = (bf16_t*)(ws + WS_H); bf16_t* out9 = (bf16_t*)(ws + WS_OUT9);
    bf16_t* Qb = out9, *ZFb = out9 + ARR, *Ib = out9 + 3 * ARR, *SGAb = out9 + 4 * ARR, *UGb = out9 + 5 * ARR, *GVb = out9 + 6 * ARR, *SMAb = out9 + 7 * ARR, *SMBb = out9 + 8 * ARR;
    bf16_t* OFb = (bf16_t*)(ws + WS_OF); bf16_t* Xb = (bf16_t*)(ws + WS_X); float* ACb = (float*)(ws + WS_AC); f32x2* STb = (f32x2*)(ws + WS_ST);
    bf16_t* MGb = Qb;
    volatile LAS unsigned* bst = (volatile LAS unsigned*)(lds + LDS_BYTES - 16);
    if (threadIdx.x < 4) bst[threadIdx.x] = 0u;
    if (blk == 0) for (int i = threadIdx.x; i < XCD_BAR_WORDS; i += 512) ((unsigned*)ws)[i] = 0u;
    __syncthreads();
    XcdBarrier xb; xb.bar = (unsigned*)ws; xb.x = 0; xb.st = bst;
    for (int ph = a.ph_lo; ph < a.ph_hi; ++ph) {
        if (ph == a.ph_lo + 1) { grid.sync(); xb = xcd_barrier_post((unsigned*)ws, bst); }
        else if (ph > a.ph_lo + 1) xcd_barrier(xb);
        if (ph == NPH - 1) { phase_final(a.out, a.in[12], M_ALL, G); continue; }
        const int l = ph / 13, rr = ph % 13;
        const float* xin = (l == 0) ? x0 : a.out;
        if (rr == 0) {
            phase_prep(lds, a.in[2] + (size_t)l * D * NIN, a.in[9] + (size_t)l * D * D, a.in[10] + (size_t)l * D * D, a.in[11] + (size_t)l * D * D, ws, G);
            phase_rms_bf16(xin, a.in[1] + l * D, Hb, M_ALL, G);
            if (blk == 0) {
                float* LBT = (float*)(ws + WS_LBT);
                for (int i = threadIdx.x; i < 2048; i += 512) { const float* lp = a.in[3] + i;
                    const float v0 = lp[0], v1 = lp[2048], v2 = lp[4096], v3 = lp[6144], mx = fmaxf(fmaxf(v0, v1), fmaxf(v2, v3));
                    const float e0 = __expf(v0 - mx), e1 = __expf(v1 - mx), e2 = __expf(v2 - mx), e3 = __expf(v3 - mx);
                    float lb = 0.f; if (l >= 1) lb += e1; if (l >= 2) lb += e2; if (l >= 3) lb += e3;
                    lb = lb / (e0 + e1 + e2 + e3);
                    LBT[(i >> 10) * 2048 + (i & 1023)] = fmaxf(lb, 1e-20f); LBT[(i >> 10) * 2048 + 1024 + (i & 1023)] = 1.0f - lb; }
            }
            continue;
        }
        const int hf = (rr - 1) / 6, k = (rr - 1) % 6;
        bf16_t* Hh = Hb + (size_t)hf * ARR;
        if (k == 0) {
            pg8::Gemm g{Hh, Hh, (const bf16_t*)(ws + WS_WIN), (const bf16_t*)(ws + WS_WIN), D};
            pg8::Order S; S.init(MH, NIN, G, blk, 0);
            EpiInProj E{out9};
            pg8::gemm_phase<EpiInProj>(lds, g, S, E);
        } else if (k == 1) {
            phase_lnstats(GVb, STb, G);
            phase_s1(lds, Qb, ZFb, Ib, OFb, Xb, ACb, (const float*)(ws + WS_LBT), G);
        } else if (k == 2) {
            phase_s2(Xb, ACb, G);
            phase_spatial(lds, GVb, UGb, STb, a.in[5] + l * D, a.in[6] + l * D, a.in[7] + (size_t)l * 8 * 128 * 128, a.in[8] + l * 8 * 128, G);
        } else if (k == 3) {
            phase_s3(lds, ZFb, OFb, Xb, SGAb, a.in[4] + l * 128, Hh, G);
        } else if (k == 4) {
            pg8::Gemm g{Hh, UGb, (const bf16_t*)(ws + WS_WA), (const bf16_t*)(ws + WS_WB), D};
            pg8::Order S; S.init(MH, D, G, blk, 1);
            EpiProjAB E{SMAb, SMBb, MGb};
            pg8::gemm_phase<EpiProjAB>(lds, g, S, E);
        } else {
            pg8::Gemm g{MGb, MGb, (const bf16_t*)(ws + WS_WO), (const bf16_t*)(ws + WS_WO), D};
            pg8::Order S; S.init(MH, D, G, blk, 0);
            EpiResid E{xin + (size_t)hf * ARR, a.out + (size_t)hf * ARR};
            pg8::gemm_phase<EpiResid>(lds, g, S, E);
        }
    }
}


extern "C" void kernel_launch(void* const* d_in, const int* in_sizes, int n_in, void* d_out, int out_size, void* d_ws, size_t ws_size, hipStream_t stream) {
    static int grid = 0;
    if (grid == 0) {
        if (n_in != 13 || ws_size < WS_END) { fprintf(stderr, "kernel_launch: unexpected inputs (n_in %d, ws %zu, need %zu)\n", n_in, ws_size, (size_t)WS_END); grid = -1; return; }
        int dev = 0, cus = 0, per_cu = 0;
        hipGetDevice(&dev); hipDeviceGetAttribute(&cus, hipDeviceAttributeMultiprocessorCount, dev);
        if (hipFuncSetAttribute((const void*)mega, hipFuncAttributeMaxDynamicSharedMemorySize, LDS_BYTES) != hipSuccess) { fprintf(stderr, "kernel_launch: hipFuncSetAttribute failed\n"); grid = -1; return; }
        if (hipOccupancyMaxActiveBlocksPerMultiprocessor(&per_cu, (const void*)mega, 512, LDS_BYTES) != hipSuccess || per_cu < 1) { fprintf(stderr, "kernel_launch: occupancy query gave %d\n", per_cu); per_cu = 1; }
        (void)hipGetLastError();
        grid = cus * 1;
        fprintf(stderr, "kernel_launch: cus %d per_cu %d grid %d\n", cus, per_cu, grid);
    }
    if (grid < 0) return;
    Args a{};
    for (int i = 0; i < 13; ++i) a.in[i] = (const float*)d_in[i];
    a.out = (float*)d_out; a.ws = (unsigned char*)d_ws; a.ph_lo = 0; a.ph_hi = NPH;
    void* args[] = {&a};
    hipError_t e = hipLaunchCooperativeKernel((const void*)mega, dim3(grid), dim3(512), args, LDS_BYTES, stream);
    if (e != hipSuccess) fprintf(stderr, "kernel_launch: cooperative launch failed: %s (grid %d)\n", hipGetErrorString(e), grid);
}
```

```cpp
#include <hip/hip_runtime.h>
#include <hip/hip_cooperative_groups.h>
#include <cstdio>
namespace cg = cooperative_groups;

#define LAS __attribute__((address_space(3)))
#define DI __device__ __forceinline__
typedef unsigned short bf16_t;
typedef short bf16x8 __attribute__((ext_vector_type(8)));
typedef float f32x4 __attribute__((ext_vector_type(4)));
typedef float f32x2 __attribute__((ext_vector_type(2)));
typedef float f32x16 __attribute__((ext_vector_type(16)));
typedef unsigned u32x4 __attribute__((ext_vector_type(4)));
typedef unsigned u32x2 __attribute__((ext_vector_type(2)));
typedef __bf16 bf16v2 __attribute__((ext_vector_type(2)));

constexpr int D = 1024, SEQ = 4096, MH = 16384, M_ALL = 32768, DEPTH = 4, NIN = 10240;
constexpr int LDS_BYTES = 147456;
constexpr float LOG2E = 1.4426950408889634f;
constexpr size_t ARR = (size_t)MH * D;

constexpr size_t WS_WIN = 1ull << 20;
constexpr size_t WS_WA = WS_WIN + (size_t)NIN * D * 2;
constexpr size_t WS_WB = WS_WA + (size_t)D * D * 2;
constexpr size_t WS_WO = WS_WB + (size_t)D * D * 2;
constexpr size_t WS_H = WS_WO + (size_t)D * D * 2;
constexpr size_t WS_OUT9 = WS_H + (size_t)M_ALL * D * 2;
constexpr size_t WS_OF = WS_OUT9 + 9 * ARR * 2;
constexpr size_t WS_X = WS_OF + 2 * ARR * 2;
constexpr size_t WS_AC = WS_X + (size_t)64 * 64 * 16384 * 2;
constexpr size_t WS_ST = WS_AC + (size_t)64 * 64 * 128 * 4;
constexpr size_t WS_LBT = WS_ST + (size_t)MH * 8;
constexpr size_t WS_END = WS_LBT + 4096 * 4;

DI unsigned pk2(float lo, float hi) { f32x2 v = {lo, hi}; bf16v2 r = __builtin_convertvector(v, bf16v2); return __builtin_bit_cast(unsigned, r); }
DI float bflo(unsigned w) { return __uint_as_float(w << 16); }
DI float bfhi(unsigned w) { return __uint_as_float(w & 0xffff0000u); }
DI float fexp2(float x) { return __builtin_amdgcn_exp2f(x); }
DI float frcp(float x) { return __builtin_amdgcn_rcpf(x); }
DI float sigmoidf_(float x) { return frcp(1.0f + fexp2(-x * LOG2E)); }
DI float siluf_(float x) { return x * sigmoidf_(x); }
DI float geluf_(float x) { const float t = x + 0.044715f * x * x * x; return x * frcp(1.0f + fexp2(-2.3022082f * t)); }
DI float wave_sum(float v) {
#pragma unroll
    for (int o = 1; o < 64; o <<= 1) v += __shfl_xor(v, o);
    return v;
}
#define LDS_WAIT() asm volatile("s_waitcnt lgkmcnt(0)" ::: "memory")
template <int CTRL, int ROWMASK, bool BC> DI float dpp_f(float x) { return __int_as_float(__builtin_amdgcn_update_dpp(0, __float_as_int(x), CTRL, ROWMASK, 0xf, BC)); }
DI int opaque_tid() { int t = threadIdx.x; asm volatile("" : "+v"(t)); return t; }


#define XB_TMO      128
#define XB_XCNT(j)  (256  + 64 * (j))
#define XB_XSUB(j)  (1280 + 64 * (j))
#define XB_XGEN(j)  (2304 + 64 * (j))
#define XB_TOP      3328
#define XB_TOPGEN   3392
#define XCD_BAR_WORDS 3456
#define XB_SPIN_CAP (1u << 18)
DI unsigned xb_ld(unsigned* p)              { return __hip_atomic_load(p, __ATOMIC_RELAXED, __HIP_MEMORY_SCOPE_AGENT); }
DI unsigned xb_add(unsigned* p, unsigned v) { return __hip_atomic_fetch_add(p, v, __ATOMIC_RELAXED, __HIP_MEMORY_SCOPE_AGENT); }
DI unsigned xb_xcc_id() { return (unsigned)__builtin_amdgcn_s_getreg((3 << 11) | 20) & 0xFu; }
#define XB_SPIN(cond, bar) do { unsigned _sp = 0; while (cond) { __builtin_amdgcn_s_sleep(1); \
    if ((++_sp & 255u) == 0u) { if (xb_ld(&(bar)[XB_TMO])) break; if (_sp > XB_SPIN_CAP) { atomicAdd(&(bar)[XB_TMO], 1u); break; } } } } while (0)
struct XcdBarrier { unsigned* bar; unsigned x; volatile LAS unsigned* st; };
DI XcdBarrier xcd_barrier_post(unsigned* bar, volatile LAS unsigned* st) {
    XcdBarrier b; b.bar = bar; b.x = xb_xcc_id(); b.st = st;
    if (threadIdx.x == 0) (void)xb_add(&bar[XB_XCNT(b.x)], 1u);
    return b;
}
DI void xcd_barrier_complete(unsigned* bar, unsigned x, unsigned& nloc, unsigned& nx) {
    const unsigned G = gridDim.x * gridDim.y * gridDim.z;
    unsigned sum, cnt, mine, sp = 0u;
    for (;;) {
        sum = 0u; cnt = 0u; mine = 0u;
#pragma unroll
        for (unsigned j = 0; j < 16; ++j) { const unsigned c = xb_ld(&bar[XB_XCNT(j)]); sum += c; cnt += (c > 0u) ? 1u : 0u; mine = (j == x) ? c : mine; }
        if (sum == G) break;
        __builtin_amdgcn_s_sleep(1);
        if ((++sp & 255u) == 0u) { if (xb_ld(&bar[XB_TMO])) break; if (sp > XB_SPIN_CAP) { atomicAdd(&bar[XB_TMO], 1u); break; } }
    }
    nloc = mine > 0u ? mine : 1u; nx = cnt > 0u ? cnt : 1u;
}
DI void xcd_barrier(const XcdBarrier& b) {
    asm volatile("s_waitcnt vmcnt(0)" ::: "memory");
    __syncthreads();
    if (threadIdx.x == 0) {
        unsigned* bar = b.bar;
        __builtin_amdgcn_s_waitcnt(0);
        unsigned nloc = b.st[0], nx = b.st[1];
        if (nloc == 0u) { xcd_barrier_complete(bar, b.x, nloc, nx); b.st[0] = nloc; b.st[1] = nx; }
        const unsigned old = xb_add(&bar[XB_XSUB(b.x)], 1u);
        const unsigned gen = old / nloc;
        if (old + 1u == (gen + 1u) * nloc) {
            __builtin_amdgcn_fence(__ATOMIC_RELEASE, "agent");
            asm volatile("s_waitcnt vmcnt(0)" ::: "memory");
            const unsigned og = xb_add(&bar[XB_TOP], 1u);
            const unsigned tg = og / nx;
            if (og + 1u == (tg + 1u) * nx) xb_add(&bar[XB_TOPGEN], 1u);
            else XB_SPIN(xb_ld(&bar[XB_TOPGEN]) == tg, bar);
            __builtin_amdgcn_fence(__ATOMIC_ACQUIRE, "agent");
            xb_add(&bar[XB_XGEN(b.x)], 1u);
            asm volatile("s_waitcnt vmcnt(0)" ::: "memory");
        } else {
            XB_SPIN(xb_ld(&bar[XB_XGEN(b.x)]) == gen, bar);
            __builtin_amdgcn_fence(__ATOMIC_ACQUIRE, "agent");
            asm volatile("s_waitcnt vmcnt(0)" ::: "memory");
        }
    }
    __syncthreads();
}

namespace pg8 {
constexpr int BM = 256, BK = 64, HALF = 128, HTB = HALF * BK * 2, STAGE_BYTES = 8 * HTB, NXCD = 8, WGM = 8;
DI int lds_byte(int r, int c) { const int st = (r >> 4) * 2 + (c >> 5), rr = r & 15, cc = c & 31, ob = rr * 64 + cc * 2; return st * 1024 + (ob ^ (((ob >> 9) & 1) << 5)); }
DI void stage_rc(int b, int& R, int& C) { const int st = b / 1024, sb = b % 1024, swz = sb ^ (((sb >> 9) & 1) << 5); R = (st >> 1) * 16 + swz / 64; C = (st & 1) * 32 + (swz % 64) / 2; }
DI int perm32(int rho) { const int n = rho >> 4, i = rho & 15; return 8 * (i >> 2) + 4 * n + (i & 3); }

struct Unit { int pm, pn, sel; };
struct Gemm { const bf16_t* A0; const bf16_t* A1; const bf16_t* B0; const bf16_t* B1; int K; };
struct Order {
    int nM, nN, nwg, G, c, dual;
    DI void init(int M, int N, int G_, int c_, int dual_) { nM = M / BM; nN = N / BM; nwg = nM * nN; G = G_; c = c_; dual = dual_; }
    DI bool next(int i, Unit& u) const {
        const int ti = dual ? (i >> 1) : i; u.sel = dual ? (i & 1) : 0;
        const long L = (long)ti * G + c; if (L >= nwg) return false;
        int wgid = (int)L; { const int q = nwg / NXCD, r = nwg % NXCD, xcd = wgid % NXCD, off = wgid / NXCD; wgid = (xcd < r ? xcd * (q + 1) : r * (q + 1) + (xcd - r) * q) + off; }
        const int nig = WGM * nN, gid = wgid / nig, fm = gid * WGM, gsz = (nM - fm) < WGM ? (nM - fm) : WGM;
        u.pm = fm + ((wgid % nig) % gsz); u.pn = (wgid % nig) / gsz; return true;
    }
};

template <class Epi>
DI void gemm_phase(LAS unsigned char* lds, const Gemm g, const Order& S, const Epi& E) {
    const int tid = opaque_tid(), wid = __builtin_amdgcn_readfirstlane(tid >> 6), lane = tid & 63, wr = wid >> 2, wc = wid & 3, fr = lane & 15, fq = lane >> 4;
    const int K = g.K, nt = K / BK;
    unsigned voffA[2], voffB[2];
#pragma unroll
    for (int i = 0; i < 2; ++i) { int R, C; stage_rc(tid * 16 + i * 8192, R, C); const int Rb = Epi::PERM ? ((R & ~31) + perm32(R & 31)) : R;
        voffA[i] = (unsigned)(R * K + C) * 2u; voffB[i] = (unsigned)(Rb * K + C) * 2u; }
    const size_t kstep = (size_t)(BK * 2);
    const size_t hstep = (size_t)HALF * K * 2;
    const size_t tstep = 2 * hstep;
    const unsigned ldsw = (unsigned)wid * 1024u;
    const int aoff = lds_byte(wr * 64 + fr, fq * 8), boff = lds_byte(wc * 32 + fr, fq * 8);
#define PG8_SA(b, h) (((b) * 2 + (h)) * HTB)
#define PG8_SB(b, h) ((4 + (b) * 2 + (h)) * HTB)
#define PG8_STAGE(bufoff, gbase, voff) do { _Pragma("unroll") for (int _i = 0; _i < 2; ++_i) \
        __builtin_amdgcn_global_load_lds((const unsigned*)((const char*)(gbase) + (voff)[_i]), (LAS unsigned*)(lds + (bufoff) + ldsw + _i * 8192), 16, 0, 0); } while (0)
#define PG8_LDA(dst, b, h) do { _Pragma("unroll") for (int m = 0; m < 4; ++m) _Pragma("unroll") for (int k = 0; k < 2; ++k) dst[m][k] = *(const LAS bf16x8*)(lds + PG8_SA(b, h) + aoff + m * 2048 + k * 1024); } while (0)
#define PG8_LDB(dst, b, h) do { _Pragma("unroll") for (int n = 0; n < 2; ++n) _Pragma("unroll") for (int k = 0; k < 2; ++k) dst[n][k] = *(const LAS bf16x8*)(lds + PG8_SB(b, h) + boff + n * 2048 + k * 1024); } while (0)
#define PG8_MMA(ai, bj, At, Bt) do { __builtin_amdgcn_s_setprio(1); _Pragma("unroll") for (int m = 0; m < 4; ++m) _Pragma("unroll") for (int n = 0; n < 2; ++n) _Pragma("unroll") for (int k = 0; k < 2; ++k) \
        acc[ai][bj][m][n] = __builtin_amdgcn_mfma_f32_16x16x32_bf16(Bt[n][k], At[m][k], acc[ai][bj][m][n], 0, 0, 0); __builtin_amdgcn_s_setprio(0); } while (0)
#define PG8_WAIT_V(n) asm volatile("s_waitcnt vmcnt(" #n ")" ::: "memory")
#define PG8_WAIT_L(n) asm volatile("s_waitcnt lgkmcnt(" #n ")" ::: "memory")
#define PG8_BAR __builtin_amdgcn_s_barrier()
#define PG8_SCHED __builtin_amdgcn_sched_barrier(0)
    Unit cur, nxt; int ui = 0;
    if (!S.next(0, cur)) return;
    f32x4 acc[2][2][4][2];
#pragma unroll
    for (int a = 0; a < 2; ++a)
#pragma unroll
        for (int b = 0; b < 2; ++b)
#pragma unroll
            for (int m = 0; m < 4; ++m)
#pragma unroll
                for (int n = 0; n < 2; ++n) acc[a][b][m][n] = (f32x4){0.f, 0.f, 0.f, 0.f};
    bf16x8 At[4][2], B0[2][2], B1[2][2];
    const char* cA = (const char*)(cur.sel ? g.A1 : g.A0) + (size_t)cur.pm * tstep; const char* cB = (const char*)(cur.sel ? g.B1 : g.B0) + (size_t)cur.pn * tstep;
    PG8_STAGE(PG8_SB(0, 0), cB, voffB); PG8_STAGE(PG8_SB(0, 1), cB + hstep, voffB); PG8_STAGE(PG8_SA(0, 0), cA, voffA); PG8_STAGE(PG8_SA(0, 1), cA + hstep, voffA);
    if (wr == 1) PG8_BAR;
    PG8_WAIT_V(2); PG8_BAR;
    PG8_STAGE(PG8_SB(1, 0), cB + kstep, voffB); PG8_STAGE(PG8_SA(1, 0), cA + kstep, voffA); PG8_STAGE(PG8_SB(1, 1), cB + hstep + kstep, voffB);
    PG8_WAIT_V(6); PG8_BAR;
    for (;;) {
        const bool has_next = S.next(ui + 1, nxt);
        const char* nA = has_next ? (const char*)(nxt.sel ? g.A1 : g.A0) + (size_t)nxt.pm * tstep : cA; const char* nB = has_next ? (const char*)(nxt.sel ? g.B1 : g.B0) + (size_t)nxt.pn * tstep : cB;
        for (int t = 0; t < nt; t += 2) {
            const bool last = (t == nt - 2);
            const char* a1 = cA + (size_t)(t + 1) * kstep;
            const char* a2 = last ? nA : cA + (size_t)(t + 2) * kstep; const char* b2 = last ? nB : cB + (size_t)(t + 2) * kstep;
            const char* a3 = a2 + kstep; const char* b3 = b2 + kstep;
            PG8_LDB(B0, 0, 0); PG8_LDB(B1, 0, 1); PG8_SCHED; PG8_LDA(At, 0, 0); PG8_STAGE(PG8_SA(1, 1), a1 + hstep, voffA);
            PG8_WAIT_V(8); PG8_WAIT_L(0); PG8_BAR; PG8_MMA(0, 0, At, B0); PG8_MMA(0, 1, At, B1); PG8_BAR; PG8_SCHED;
            PG8_LDA(At, 0, 1); PG8_STAGE(PG8_SB(0, 0), b2, voffB); PG8_STAGE(PG8_SB(0, 1), b2 + hstep, voffB); PG8_STAGE(PG8_SA(0, 0), a2, voffA);
            PG8_WAIT_V(8); PG8_WAIT_L(0); PG8_BAR; PG8_MMA(1, 0, At, B0); PG8_MMA(1, 1, At, B1); PG8_BAR; PG8_SCHED;
            PG8_LDB(B0, 1, 0); PG8_LDB(B1, 1, 1); PG8_SCHED; PG8_LDA(At, 1, 0); PG8_STAGE(PG8_SA(0, 1), a2 + hstep, voffA);
            PG8_WAIT_V(8); PG8_WAIT_L(0); PG8_BAR; PG8_MMA(0, 0, At, B0); PG8_MMA(0, 1, At, B1); PG8_BAR; PG8_SCHED;
            PG8_LDA(At, 1, 1); PG8_STAGE(PG8_SB(1, 0), b3, voffB); PG8_STAGE(PG8_SB(1, 1), b3 + hstep, voffB); PG8_STAGE(PG8_SA(1, 0), a3, voffA);
            PG8_WAIT_V(8); PG8_WAIT_L(0); PG8_BAR; PG8_MMA(1, 0, At, B0); PG8_MMA(1, 1, At, B1); PG8_BAR; PG8_SCHED;
        }
        if (wr == 0) PG8_BAR;
        E(acc, cur, wr, wc, fr, fq);
        if (!has_next) break;
#pragma unroll
        for (int a = 0; a < 2; ++a)
#pragma unroll
            for (int b = 0; b < 2; ++b)
#pragma unroll
                for (int m = 0; m < 4; ++m)
#pragma unroll
                    for (int n = 0; n < 2; ++n) acc[a][b][m][n] = (f32x4){0.f, 0.f, 0.f, 0.f};
        cur = nxt; cA = nA; cB = nB; ++ui;
        if (wr == 1) PG8_BAR;
    }
    PG8_WAIT_V(0);
    PG8_BAR;
#undef PG8_SA
#undef PG8_SB
#undef PG8_STAGE
#undef PG8_LDA
#undef PG8_LDB
#undef PG8_MMA
#undef PG8_WAIT_V
#undef PG8_WAIT_L
#undef PG8_BAR
#undef PG8_SCHED
}
}

template <int ACT> DI float act_fn(float x) {
    if (ACT == 0) return x;
    if (ACT == 1) return siluf_(x) * 0.08838834764831845f;
    if (ACT == 2) return siluf_(x);
    if (ACT == 3) return geluf_(x);
    return sigmoidf_(x);
}
template <int ACT> DI void store_act(const f32x4 (&acc)[2][2][4][2], bf16_t* base, int row0, int col0) {
#pragma unroll
    for (int ai = 0; ai < 2; ++ai)
#pragma unroll
        for (int m = 0; m < 4; ++m) { bf16_t* rowp = base + (size_t)(row0 + ai * 128 + m * 16) * D + col0;
#pragma unroll
            for (int bj = 0; bj < 2; ++bj) { const f32x4 v0 = acc[ai][bj][m][0], v1 = acc[ai][bj][m][1];
                u32x4 w; w.x = pk2(act_fn<ACT>(v0[0]), act_fn<ACT>(v0[1])); w.y = pk2(act_fn<ACT>(v0[2]), act_fn<ACT>(v0[3]));
                w.z = pk2(act_fn<ACT>(v1[0]), act_fn<ACT>(v1[1])); w.w = pk2(act_fn<ACT>(v1[2]), act_fn<ACT>(v1[3]));
                *(u32x4*)(rowp + bj * 128) = w; } }
}
struct EpiInProj {
    static constexpr bool PERM = true;
    bf16_t* out9;
    DI void operator()(const f32x4 (&acc)[2][2][4][2], const pg8::Unit& u, int wr, int wc, int fr, int fq) const {
        const int pn = u.pn, row0 = u.pm * 256 + wr * 64 + fr, cl = wc * 32 + 8 * fq;
        if (pn >= 20 && pn < 28) {
            bf16_t* base = out9 + 5 * ARR; const int col0 = 128 * (pn - 20) + cl;
#pragma unroll
            for (int ai = 0; ai < 2; ++ai)
#pragma unroll
                for (int m = 0; m < 4; ++m) { bf16_t* rowp = base + (size_t)(row0 + ai * 128 + m * 16) * D + col0;
                    const f32x4 u0 = acc[ai][0][m][0], u1 = acc[ai][0][m][1], g0 = acc[ai][1][m][0], g1 = acc[ai][1][m][1];
                    u32x4 w; w.x = pk2(geluf_(u0[0]) * siluf_(g0[0]), geluf_(u0[1]) * siluf_(g0[1])); w.y = pk2(geluf_(u0[2]) * siluf_(g0[2]), geluf_(u0[3]) * siluf_(g0[3]));
                    w.z = pk2(geluf_(u1[0]) * siluf_(g1[0]), geluf_(u1[1]) * siluf_(g1[1])); w.w = pk2(geluf_(u1[2]) * siluf_(g1[2]), geluf_(u1[3]) * siluf_(g1[3]));
                    *(u32x4*)rowp = w; }
            return;
        }
        int idx, ct;
        if (pn < 20) { idx = pn >> 2; ct = pn & 3; } else if (pn < 32) { idx = 6; ct = pn - 28; } else { idx = 7 + ((pn - 32) >> 2); ct = (pn - 32) & 3; }
        bf16_t* base = out9 + (size_t)idx * ARR; const int col0 = 256 * ct + cl;
        if (idx == 0) store_act<1>(acc, base, row0, col0);
        else if (idx <= 3) store_act<0>(acc, base, row0, col0);
        else if (idx == 4) store_act<2>(acc, base, row0, col0);
        else if (idx == 6) store_act<3>(acc, base, row0, col0);
        else store_act<4>(acc, base, row0, col0);
    }
};
struct EpiProjAB {
    static constexpr bool PERM = true;
    const bf16_t* SMA; const bf16_t* SMB; bf16_t* MG;
    DI void operator()(const f32x4 (&acc)[2][2][4][2], const pg8::Unit& u, int wr, int wc, int fr, int fq) const {
        const int row0 = u.pm * 256 + wr * 64 + fr, col0 = u.pn * 256 + wc * 32 + 8 * fq;
        const bf16_t* gate = u.sel ? SMB : SMA;
#pragma unroll
        for (int ai = 0; ai < 2; ++ai)
#pragma unroll
            for (int m = 0; m < 4; ++m) { const size_t off = (size_t)(row0 + ai * 128 + m * 16) * D + col0;
#pragma unroll
                for (int bj = 0; bj < 2; ++bj) { const f32x4 v0 = acc[ai][bj][m][0], v1 = acc[ai][bj][m][1];
                    const u32x4 gw = *(const u32x4*)(gate + off + bj * 128);
                    float o[8] = {v0[0] * bflo(gw.x), v0[1] * bfhi(gw.x), v0[2] * bflo(gw.y), v0[3] * bfhi(gw.y), v1[0] * bflo(gw.z), v1[1] * bfhi(gw.z), v1[2] * bflo(gw.w), v1[3] * bfhi(gw.w)};
                    if (u.sel) { const u32x4 tw = *(const u32x4*)(MG + off + bj * 128);
                        o[0] += bflo(tw.x); o[1] += bfhi(tw.x); o[2] += bflo(tw.y); o[3] += bfhi(tw.y); o[4] += bflo(tw.z); o[5] += bfhi(tw.z); o[6] += bflo(tw.w); o[7] += bfhi(tw.w); }
                    u32x4 w; w.x = pk2(o[0], o[1]); w.y = pk2(o[2], o[3]); w.z = pk2(o[4], o[5]); w.w = pk2(o[6], o[7]);
                    *(u32x4*)(MG + off + bj * 128) = w; }
                asm volatile("" ::: "memory"); }
    }
};
struct EpiResid {
    static constexpr bool PERM = false;
    const float* xin; float* out;
    DI void operator()(const f32x4 (&acc)[2][2][4][2], const pg8::Unit& u, int wr, int wc, int fr, int fq) const {
        const int row0 = u.pm * 256 + wr * 64 + fr, col0 = u.pn * 256 + wc * 32 + 4 * fq;
#pragma unroll
        for (int ai = 0; ai < 2; ++ai)
#pragma unroll
            for (int m = 0; m < 4; ++m) { const size_t off = (size_t)(row0 + ai * 128 + m * 16) * D + col0;
#pragma unroll
                for (int bj = 0; bj < 2; ++bj)
#pragma unroll
                    for (int n = 0; n < 2; ++n) { const f32x4 xv = *(const f32x4*)(xin + off + bj * 128 + n * 16); *(f32x4*)(out + off + bj * 128 + n * 16) = xv + acc[ai][bj][m][n]; }
                asm volatile("" ::: "memory"); }
    }
};

DI int src_col(int nv) {
    if (nv < 5120) return nv;
    if (nv < 7168) { const int t = (nv - 5120) >> 8, w = (nv - 5120) & 255; return w < 128 ? 5120 + 128 * t + w : 7168 + 128 * t + (w - 128); }
    if (nv < 8192) return 6144 + (nv - 7168);
    return nv;
}
DI void transpose_item(const float* W, int N, bf16_t* WT, int k0, int nsrc0, int nvirt0, LAS float* scr, int lane) {
#pragma unroll 8
    for (int i = 0; i < 32; ++i) { const int kk = 2 * i + (lane >> 5); scr[kk * 33 + (lane & 31)] = W[(size_t)(k0 + kk) * N + nsrc0 + (lane & 31)]; }
    LDS_WAIT();
    const int c = lane & 7;
#pragma unroll
    for (int j = 0; j < 4; ++j) { const int n = (lane >> 3) + 8 * j; const LAS float* s = scr + (8 * c) * 33 + n;
        u32x4 o; o.x = pk2(s[0 * 33], s[1 * 33]); o.y = pk2(s[2 * 33], s[3 * 33]); o.z = pk2(s[4 * 33], s[5 * 33]); o.w = pk2(s[6 * 33], s[7 * 33]);
        *(u32x4*)(WT + (size_t)(nvirt0 + n) * D + k0 + 8 * c) = o; }
    LDS_WAIT();
}
DI void phase_prep(LAS unsigned char* lds, const float* w_in, const float* wa, const float* wb, const float* wo, unsigned char* ws, int G) {
    const int tid_ = opaque_tid(); const int lane = tid_ & 63, wave = __builtin_amdgcn_readfirstlane(tid_ >> 6);
    LAS float* scr = (LAS float*)(lds + wave * 16384);
    const int gw = blockIdx.x * 8 + wave, NGW = G * 8;
    constexpr int I_IN = 16 * 320, I_P = 16 * 32, PER_L = I_IN + 3 * I_P;
    for (int it = gw; it < PER_L; it += NGW) {
        int r = it;
        if (r < I_IN) { const int kb = r / 320, nb = r % 320; transpose_item(w_in, NIN, (bf16_t*)(ws + WS_WIN), 64 * kb, src_col(32 * nb), 32 * nb, scr, lane); continue; }
        r -= I_IN; const int which = r / I_P; r %= I_P; const int kb = r / 32, nb = r % 32;
        const float* W = (which == 0 ? wa : which == 1 ? wb : wo);
        bf16_t* WT = (bf16_t*)(ws + (which == 0 ? WS_WA : which == 1 ? WS_WB : WS_WO));
        transpose_item(W, D, WT, 64 * kb, 32 * nb, 32 * nb, scr, lane);
    }
}
DI void phase_rms_bf16(const float* x, const float* w, bf16_t* h, int nrows, int G) {
    const int tid_ = opaque_tid(); const int lane = tid_ & 63, wave = __builtin_amdgcn_readfirstlane(tid_ >> 6);
    const int gw = blockIdx.x * 8 + wave, NGW = G * 8;
    f32x4 wv[4];
#pragma unroll
    for (int j = 0; j < 4; ++j) wv[j] = ((const f32x4*)w)[lane + 64 * j];
    for (int m = gw; m < nrows; m += NGW) {
        const f32x4* xr = (const f32x4*)(x + (size_t)m * D) + lane; f32x4 v[4]; float s = 0.f;
#pragma unroll
        for (int j = 0; j < 4; ++j) { v[j] = xr[64 * j]; s += (v[j].x * v[j].x + v[j].y * v[j].y) + (v[j].z * v[j].z + v[j].w * v[j].w); }
        const float rstd = rsqrtf(wave_sum(s) * (1.0f / D) + 1e-6f);
        u32x2* o8 = (u32x2*)(h + (size_t)m * D) + lane;
#pragma unroll
        for (int j = 0; j < 4; ++j) { u32x2 o; o.x = pk2(v[j].x * rstd * wv[j].x, v[j].y * rstd * wv[j].y); o.y = pk2(v[j].z * rstd * wv[j].z, v[j].w * rstd * wv[j].w); o8[64 * j] = o; }
    }
}
DI void phase_final(float* x, const float* w, int nrows, int G) {
    const int tid_ = opaque_tid(); const int lane = tid_ & 63, wave = __builtin_amdgcn_readfirstlane(tid_ >> 6);
    const int gw = blockIdx.x * 8 + wave, NGW = G * 8;
    f32x4 wv[4];
#pragma unroll
    for (int j = 0; j < 4; ++j) wv[j] = ((const f32x4*)w)[lane + 64 * j];
    for (int m = gw; m < nrows; m += NGW) {
        f32x4* xr = (f32x4*)(x + (size_t)m * D) + lane; f32x4 v[4]; float s = 0.f;
#pragma unroll
        for (int j = 0; j < 4; ++j) { v[j] = xr[64 * j]; s += (v[j].x * v[j].x + v[j].y * v[j].y) + (v[j].z * v[j].z + v[j].w * v[j].w); }
        const float rstd = rsqrtf(wave_sum(s) * (1.0f / D) + 1e-6f);
#pragma unroll
        for (int j = 0; j < 4; ++j) xr[64 * j] = v[j] * rstd * wv[j];
    }
}
#define MFMA32(a, b, c) __builtin_amdgcn_mfma_f32_32x32x16_bf16((a), (b), (c), 0, 0, 0)
struct S1Regs { u32x4 q0, q1, z0, z1, v0, v1; };
DI void s1_load(S1Regs& R, const bf16_t* Q, const bf16_t* Z, const bf16_t* Iv, int it, int tid) {
    const int c = it & 63, dir = (it >> 6) & 1, h = (it >> 7) & 7, b = it >> 10, j = tid >> 3, cg = tid & 7;
    const size_t off = ((size_t)b * SEQ + c * 64 + (dir ? 63 - j : j)) * D + h * 128 + 16 * cg;
    const bf16_t* zp = Z + (size_t)dir * ARR;
    R.q0 = *(const u32x4*)(Q + off); R.q1 = *(const u32x4*)(Q + off + 8);
    R.z0 = *(const u32x4*)(zp + off); R.z1 = *(const u32x4*)(zp + off + 8);
    R.v0 = *(const u32x4*)(Iv + off); R.v1 = *(const u32x4*)(Iv + off + 8);
}
DI void phase_s1(LAS unsigned char* lds, const bf16_t* Q, bf16_t* Z, const bf16_t* Iv, bf16_t* O, bf16_t* X, float* AC, const float* LBT, int G) {
    const int tid = opaque_tid(), lane = tid & 63, wave = __builtin_amdgcn_readfirstlane(tid >> 6);
    const int r = lane & 31, hh = lane >> 5, j8 = tid >> 3, cg8 = tid & 7;
    LAS bf16_t* TQ = (LAS bf16_t*)(lds);
    LAS bf16_t* TV = (LAS bf16_t*)(lds + 17408);
    LAS bf16_t* TZ = (LAS bf16_t*)(lds + 34816);
    LAS bf16_t* QS = (LAS bf16_t*)(lds + 52224);
    LAS bf16_t* KS = (LAS bf16_t*)(lds + 69632);
    LAS bf16_t* KHT = (LAS bf16_t*)(lds + 87040);
    LAS bf16_t* VT = (LAS bf16_t*)(lds + 105472);
    LAS bf16_t* PS = (LAS bf16_t*)(lds + 123904);
    LAS bf16_t* DS = TQ;
    S1Regs R;
    int it = blockIdx.x;
    if (it < 4096) s1_load(R, Q, Z, Iv, it, tid);
    __syncthreads();
    for (; it < 4096; it += G) {
        const int c = it & 63, dir = (it >> 6) & 1, h = (it >> 7) & 7, b = it >> 10, seq = (b * 8 + h) * 2 + dir;
        const size_t rowbase = (size_t)b * SEQ + c * 64;
        *(LAS u32x4*)(TQ + j8 * 136 + 16 * cg8) = R.q0; *(LAS u32x4*)(TQ + j8 * 136 + 16 * cg8 + 8) = R.q1;
        *(LAS u32x4*)(TZ + j8 * 136 + 16 * cg8) = R.z0; *(LAS u32x4*)(TZ + j8 * 136 + 16 * cg8 + 8) = R.z1;
        *(LAS u32x4*)(TV + j8 * 136 + 16 * cg8) = R.v0; *(LAS u32x4*)(TV + j8 * 136 + 16 * cg8 + 8) = R.v1;
        __syncthreads();
        {
            const float* lp = LBT + dir * 2048 + h * 128 + 16 * wave;
            const u32x4 z0 = *(const LAS u32x4*)(TZ + lane * 136 + 16 * wave), z1 = *(const LAS u32x4*)(TZ + lane * 136 + 16 * wave + 8);
            const u32x4 q0 = *(const LAS u32x4*)(TQ + lane * 136 + 16 * wave), q1 = *(const LAS u32x4*)(TQ + lane * 136 + 16 * wave + 8);
            const u32x4 v0 = *(const LAS u32x4*)(TV + lane * 136 + 16 * wave), v1 = *(const LAS u32x4*)(TV + lane * 136 + 16 * wave + 8);
            const unsigned zw[8] = {z0.x, z0.y, z0.z, z0.w, z1.x, z1.y, z1.z, z1.w};
            const unsigned qw[8] = {q0.x, q0.y, q0.z, q0.w, q1.x, q1.y, q1.z, q1.w};
            const unsigned vw[8] = {v0.x, v0.y, v0.z, v0.w, v1.x, v1.y, v1.z, v1.w};
            float kk[16], gg[16], lbv[16], omv[16];
#pragma unroll
            for (int i = 0; i < 16; ++i) { lbv[i] = lp[i]; omv[i] = lp[1024 + i]; }
            if (it + G < 4096) s1_load(R, Q, Z, Iv, it + G, tid);
#pragma unroll
            for (int i = 0; i < 16; ++i) { const unsigned w = zw[i >> 1]; float z = (i & 1) ? bfhi(w) : bflo(w); z = __builtin_amdgcn_fmed3f(z, -30.f, 30.f);
                const float e = fexp2(-z * LOG2E), sg = frcp(1.0f + e); const float om = omv[i];
                kk[i] = om * e * sg; gg[i] = __builtin_amdgcn_logf(lbv[i] + om * sg); }
#pragma unroll
            for (int i = 0; i < 16; ++i) {
                float x = gg[i];
                x += dpp_f<0x111, 0xf, true>(x); x += dpp_f<0x112, 0xf, true>(x); x += dpp_f<0x114, 0xf, true>(x); x += dpp_f<0x118, 0xf, true>(x);
                x += dpp_f<0x142, 0xa, false>(x); x += dpp_f<0x143, 0xc, false>(x);
                gg[i] = x; }
            unsigned qo[8], ko[8], kh[8], qh[8];
            float a16[16];
#pragma unroll
            for (int w = 0; w < 8; ++w) {
                float qt_[2], kt_[2], kh_[2], qh_[2];
#pragma unroll
                for (int e2 = 0; e2 < 2; ++e2) { const int i = 2 * w + e2; const float qf = e2 ? bfhi(qw[w]) : bflo(qw[w]);
                    const float Rr = __int_as_float(__builtin_amdgcn_readlane(__float_as_int(gg[i]), 31)), G63 = __int_as_float(__builtin_amdgcn_readlane(__float_as_int(gg[i]), 63));
                    const float dq = gg[i] - Rr;
                    qt_[e2] = qf * fexp2(fminf(dq, 100.f)); kt_[e2] = kk[i] * fexp2(fminf(-dq, 100.f));
                    a16[i] = fexp2(gg[i]); kh_[e2] = kk[i] * fexp2(G63 - gg[i]); qh_[e2] = qf * a16[i]; }
                qo[w] = pk2(qt_[0], qt_[1]); ko[w] = pk2(kt_[0], kt_[1]); kh[w] = pk2(kh_[0], kh_[1]); qh[w] = pk2(qh_[0], qh_[1]);
            }
            *(LAS u32x4*)(QS + lane * 136 + 16 * wave) = (u32x4){qo[0], qo[1], qo[2], qo[3]}; *(LAS u32x4*)(QS + lane * 136 + 16 * wave + 8) = (u32x4){qo[4], qo[5], qo[6], qo[7]};
            *(LAS u32x4*)(KS + lane * 136 + 16 * wave) = (u32x4){ko[0], ko[1], ko[2], ko[3]}; *(LAS u32x4*)(KS + lane * 136 + 16 * wave + 8) = (u32x4){ko[4], ko[5], ko[6], ko[7]};
            *(LAS u32x4*)(TZ + lane * 136 + 16 * wave) = (u32x4){qh[0], qh[1], qh[2], qh[3]}; *(LAS u32x4*)(TZ + lane * 136 + 16 * wave + 8) = (u32x4){qh[4], qh[5], qh[6], qh[7]};
#pragma unroll
            for (int w = 0; w < 8; ++w) {
                KHT[(16 * wave + 2 * w) * 72 + lane] = (bf16_t)(kh[w] & 0xffffu); KHT[(16 * wave + 2 * w + 1) * 72 + lane] = (bf16_t)(kh[w] >> 16);
                VT[(16 * wave + 2 * w) * 72 + lane] = (bf16_t)(vw[w] & 0xffffu); VT[(16 * wave + 2 * w + 1) * 72 + lane] = (bf16_t)(vw[w] >> 16);
            }
            if (lane == 63) { float* ap = AC + ((size_t)seq * 64 + c) * 128 + 16 * wave;
#pragma unroll
                for (int q4 = 0; q4 < 4; ++q4) *(f32x4*)(ap + 4 * q4) = (f32x4){a16[4 * q4], a16[4 * q4 + 1], a16[4 * q4 + 2], a16[4 * q4 + 3]}; }
        }
        __syncthreads();
        {
            if (wave < 3) {
                const int tm = (wave == 2) ? 1 : 0, tn = (wave == 0) ? 0 : 1;
                f32x16 acc;
#pragma unroll
                for (int i = 0; i < 16; ++i) acc[i] = 0.f;
#pragma unroll
                for (int ks = 0; ks < 8; ++ks) { const bf16x8 a = *(const LAS bf16x8*)(KS + (32 * tm + r) * 136 + 16 * ks + 8 * hh), bb = *(const LAS bf16x8*)(QS + (32 * tn + r) * 136 + 16 * ks + 8 * hh); acc = MFMA32(a, bb, acc); }
                const int t = 32 * tn + r;
#pragma unroll
                for (int g = 0; g < 4; ++g) { const int s0 = 32 * tm + 8 * g + 4 * hh;
                    const float p0 = (s0 + 0 <= t) ? acc[4 * g + 0] : 0.f, p1 = (s0 + 1 <= t) ? acc[4 * g + 1] : 0.f, p2 = (s0 + 2 <= t) ? acc[4 * g + 2] : 0.f, p3 = (s0 + 3 <= t) ? acc[4 * g + 3] : 0.f;
                    *(LAS u32x2*)(PS + t * 72 + s0) = (u32x2){pk2(p0, p1), pk2(p2, p3)}; }
            }
            const int nd = (wave < 3) ? 1 : ((wave < 6) ? 3 : 2);
            for (int k = 0; k < nd; ++k) {
                const int tile = (wave < 3) ? 13 + wave : (wave - 3) + 5 * k;
                const int dt = tile >> 2, vt = tile & 3;
                f32x16 acc;
#pragma unroll
                for (int i = 0; i < 16; ++i) acc[i] = 0.f;
#pragma unroll
                for (int ks = 0; ks < 4; ++ks) { const bf16x8 a = *(const LAS bf16x8*)(KHT + (32 * dt + r) * 72 + 16 * ks + 8 * hh), bb = *(const LAS bf16x8*)(VT + (32 * vt + r) * 72 + 16 * ks + 8 * hh); acc = MFMA32(a, bb, acc); }
                LAS bf16_t* xp = DS + (32 * vt + r) * 136 + 32 * dt + 4 * hh;
#pragma unroll
                for (int g = 0; g < 4; ++g) *(LAS u32x2*)(xp + 8 * g) = (u32x2){pk2(acc[4 * g], acc[4 * g + 1]), pk2(acc[4 * g + 2], acc[4 * g + 3])};
            }
            {
                bf16_t* zp = Z + (size_t)dir * ARR + (rowbase + (dir ? 63 - j8 : j8)) * D + h * 128 + 16 * cg8;
                *(u32x4*)zp = *(const LAS u32x4*)(TZ + j8 * 136 + 16 * cg8); *(u32x4*)(zp + 8) = *(const LAS u32x4*)(TZ + j8 * 136 + 16 * cg8 + 8);
            }
        }
        __syncthreads();
        {
            const int vt = wave & 3, tn = wave >> 2;
            f32x16 acc;
#pragma unroll
            for (int i = 0; i < 16; ++i) acc[i] = 0.f;
#pragma unroll
            for (int ks = 0; ks < 4; ++ks) { if (ks < 2 * (tn + 1)) { const bf16x8 a = *(const LAS bf16x8*)(VT + (32 * vt + r) * 72 + 16 * ks + 8 * hh), bb = *(const LAS bf16x8*)(PS + (32 * tn + r) * 72 + 16 * ks + 8 * hh); acc = MFMA32(a, bb, acc); } }
            LAS bf16_t* op = QS + (32 * tn + r) * 136 + 32 * vt + 4 * hh;
#pragma unroll
            for (int g = 0; g < 4; ++g) *(LAS u32x2*)(op + 8 * g) = (u32x2){pk2(acc[4 * g], acc[4 * g + 1]), pk2(acc[4 * g + 2], acc[4 * g + 3])};
            bf16_t* xb = X + ((size_t)seq * 64 + c) * 16384;
#pragma unroll
            for (int k = 0; k < 4; ++k) { const int id = tid + 512 * k, v = id >> 4, sg = id & 15; *(u32x4*)(xb + v * 128 + 8 * sg) = *(const LAS u32x4*)(DS + v * 136 + 8 * sg); }
        }
        __syncthreads();
        {
            bf16_t* op = O + (size_t)dir * ARR + (rowbase + (dir ? 63 - j8 : j8)) * D + h * 128 + 16 * cg8;
            *(u32x4*)op = *(const LAS u32x4*)(QS + j8 * 136 + 16 * cg8); *(u32x4*)(op + 8) = *(const LAS u32x4*)(QS + j8 * 136 + 16 * cg8 + 8);
        }
    }
}
DI void phase_lnstats(const bf16_t* GV, f32x2* STATS, int G) {
    const int tid_ = opaque_tid(); const int lane = tid_ & 63, wave = __builtin_amdgcn_readfirstlane(tid_ >> 6);
    const int gw = blockIdx.x * 8 + wave, NGW = G * 8;
    for (int m = gw; m < MH; m += NGW) {
        const bf16_t* p = GV + (size_t)m * D + 16 * lane;
        const u32x4 a0 = *(const u32x4*)p, a1 = *(const u32x4*)(p + 8);
        const unsigned aw[8] = {a0.x, a0.y, a0.z, a0.w, a1.x, a1.y, a1.z, a1.w};
        float s1 = 0.f, s2 = 0.f;
#pragma unroll
        for (int w = 0; w < 8; ++w) { const float x0 = bflo(aw[w]), x1 = bfhi(aw[w]); s1 += x0 + x1; s2 += x0 * x0 + x1 * x1; }
        s1 = wave_sum(s1); s2 = wave_sum(s2);
        const float mean = s1 * (1.0f / D), var = fmaxf(s2 * (1.0f / D) - mean * mean, 0.f);
        if (lane == 0) STATS[m] = (f32x2){mean, rsqrtf(var + 1e-5f)};
    }
}
DI void phase_s2(bf16_t* X, const float* AC, int G) {
    const int tid = opaque_tid();
    for (int gid = blockIdx.x * 512 + tid; gid < 64 * 2048; gid += G * 512) {
        const int seq = gid >> 11, e = gid & 2047, d0 = (e & 15) * 8, dir = seq & 1;
        bf16_t* xp = X + (size_t)seq * 64 * 16384 + (size_t)(e >> 4) * 128 + d0;
        const float* ap = AC + (size_t)seq * 64 * 128 + d0;
        float S[8];
#pragma unroll
        for (int i = 0; i < 8; ++i) S[i] = 0.f;
        for (int st = 0; st < 64; st += 4) {
            u32x4 dv[4]; f32x4 a0[4], a1[4];
#pragma unroll
            for (int u = 0; u < 4; ++u) { const int c = dir ? 63 - (st + u) : st + u; dv[u] = *(const u32x4*)(xp + (size_t)c * 16384); a0[u] = *(const f32x4*)(ap + c * 128); a1[u] = *(const f32x4*)(ap + c * 128 + 4); }
#pragma unroll
            for (int u = 0; u < 4; ++u) { const int c = dir ? 63 - (st + u) : st + u;
                *(u32x4*)(xp + (size_t)c * 16384) = (u32x4){pk2(S[0], S[1]), pk2(S[2], S[3]), pk2(S[4], S[5]), pk2(S[6], S[7])};
                S[0] = a0[u].x * S[0] + bflo(dv[u].x); S[1] = a0[u].y * S[1] + bfhi(dv[u].x); S[2] = a0[u].z * S[2] + bflo(dv[u].y); S[3] = a0[u].w * S[3] + bfhi(dv[u].y);
                S[4] = a1[u].x * S[4] + bflo(dv[u].z); S[5] = a1[u].y * S[5] + bfhi(dv[u].z); S[6] = a1[u].z * S[6] + bflo(dv[u].w); S[7] = a1[u].w * S[7] + bfhi(dv[u].w); }
        }
    }
}
struct S3Regs { u32x4 x[8], q[8]; };
DI void s3_load(S3Regs& R, const bf16_t* QH, const bf16_t* X, int it, int dir, int ts, int vt, int lane) {
    const int c = it & 63, h = (it >> 6) & 7, b = it >> 9;
    const bf16_t* xp = X + ((size_t)((b * 8 + h) * 2 + dir) * 64 + c) * 16384 + (size_t)(32 * vt) * 128 + 8 * lane;
    const bf16_t* qp = QH + (size_t)dir * ARR + ((size_t)b * SEQ + c * 64 + 32 * ts + (lane >> 4)) * D + h * 128 + 8 * (lane & 15);
#pragma unroll
    for (int k = 0; k < 8; ++k) { R.x[k] = *(const u32x4*)(xp + 512 * k); R.q[k] = *(const u32x4*)(qp + (size_t)(4 * k) * D); }
}
DI void phase_s3(LAS unsigned char* lds, const bf16_t* QH, const bf16_t* O, const bf16_t* X, const bf16_t* SGA, const float* gw_, bf16_t* YA, int G) {
    const int tid = opaque_tid(), lane = tid & 63, wave = __builtin_amdgcn_readfirstlane(tid >> 6);
    const int r = lane & 31, hh = lane >> 5, ts = wave >> 2, vt = wave & 3;
    LAS bf16_t* XW = (LAS bf16_t*)(lds + wave * 17408);
    LAS bf16_t* QW = XW + 32 * 136;
    LAS float* SS = (LAS float*)(lds + 8 * 17408);
    S3Regs R;
    int it = blockIdx.x;
    if (it < 2048) s3_load(R, QH, X, it, 0, ts, vt, lane);
    __syncthreads();
    for (; it < 2048; it += G) {
        const int c = it & 63, h = (it >> 6) & 7, b = it >> 9;
        const size_t row = (size_t)b * SEQ + c * 64 + 32 * ts + r;
        const size_t ooff = row * D + h * 128 + 32 * vt + 4 * hh;
        u32x2 ef[4], eb[4], es[4];
        f32x16 acc;
#pragma unroll
        for (int i = 0; i < 16; ++i) acc[i] = 0.f;
#pragma unroll
        for (int dir = 0; dir < 2; ++dir) {
#pragma unroll
            for (int k = 0; k < 8; ++k) { const int id = 64 * k + lane; *(LAS u32x4*)(XW + (id >> 4) * 136 + 8 * (id & 15)) = R.x[k]; *(LAS u32x4*)(QW + (id >> 4) * 136 + 8 * (id & 15)) = R.q[k]; }
            asm volatile("" ::: "memory");
            if (dir == 0) { s3_load(R, QH, X, it, 1, ts, vt, lane);
#pragma unroll
                for (int g = 0; g < 4; ++g) { ef[g] = *(const u32x2*)(O + ooff + 8 * g); eb[g] = *(const u32x2*)(O + ARR + ooff + 8 * g); es[g] = *(const u32x2*)(SGA + ooff + 8 * g); } }
            else if (it + G < 2048) s3_load(R, QH, X, it + G, 0, ts, vt, lane);
#pragma unroll
            for (int ks = 0; ks < 8; ++ks) { const bf16x8 a = *(const LAS bf16x8*)(XW + r * 136 + 16 * ks + 8 * hh), bb = *(const LAS bf16x8*)(QW + r * 136 + 16 * ks + 8 * hh); acc = MFMA32(a, bb, acc); }
        }
        float o[16]; float ss = 0.f;
#pragma unroll
        for (int g = 0; g < 4; ++g) { const u32x2 f = ef[g], bk = eb[g];
            o[4 * g] = acc[4 * g] + bflo(f.x) + bflo(bk.x); o[4 * g + 1] = acc[4 * g + 1] + bfhi(f.x) + bfhi(bk.x); o[4 * g + 2] = acc[4 * g + 2] + bflo(f.y) + bflo(bk.y); o[4 * g + 3] = acc[4 * g + 3] + bfhi(f.y) + bfhi(bk.y); }
#pragma unroll
        for (int i = 0; i < 16; ++i) ss += o[i] * o[i];
        ss += __shfl_xor(ss, 32);
        __syncthreads();
        if (hh == 0) SS[(32 * ts + r) * 4 + vt] = ss;
        __syncthreads();
        const f32x4 s4 = *(const LAS f32x4*)(SS + (32 * ts + r) * 4);
        const float rstd = rsqrtf((s4.x + s4.y + s4.z + s4.w) * (1.0f / 128.0f) + 1e-6f);
#pragma unroll
        for (int g = 0; g < 4; ++g) { const u32x2 sg = es[g]; const f32x4 gv = *(const f32x4*)(gw_ + 32 * vt + 8 * g + 4 * hh);
            *(u32x2*)(YA + ooff + 8 * g) = (u32x2){pk2(o[4 * g] * rstd * gv.x * bflo(sg.x), o[4 * g + 1] * rstd * gv.y * bfhi(sg.x)), pk2(o[4 * g + 2] * rstd * gv.z * bflo(sg.y), o[4 * g + 3] * rstd * gv.w * bfhi(sg.y))}; }
    }
}

DI void phase_spatial(LAS unsigned char* lds, const bf16_t* GV, bf16_t* UG, const f32x2* STATS, const float* ln_w, const float* ln_b, const float* w_s, const float* b_s, int G) {
    const int tid = opaque_tid(), lane = tid & 63, wave = __builtin_amdgcn_readfirstlane(tid >> 6);
    const int r = lane & 31, hh = lane >> 5;
    LAS bf16_t* VL = (LAS bf16_t*)(lds);
    LAS bf16_t* WS = (LAS bf16_t*)(lds + 34816);
    for (int it = blockIdx.x; it < 1024; it += G) {
        const int g = it & 7, n = (it >> 3) & 31, b = it >> 8;
        const size_t rowbase = (size_t)b * SEQ + (size_t)n * 128;
        __syncthreads();
        {
            const int s = tid >> 2, cq = tid & 3; const f32x2 st = STATS[rowbase + s];
            const bf16_t* p = GV + (rowbase + s) * D + 128 * g + 32 * cq;
#pragma unroll
            for (int q = 0; q < 4; ++q) { const u32x4 a = *(const u32x4*)(p + 8 * q); const unsigned aw[4] = {a.x, a.y, a.z, a.w};
                const f32x4 w0 = *(const f32x4*)(ln_w + 128 * g + 32 * cq + 8 * q), w1 = *(const f32x4*)(ln_w + 128 * g + 32 * cq + 8 * q + 4);
                const f32x4 c0 = *(const f32x4*)(ln_b + 128 * g + 32 * cq + 8 * q), c1 = *(const f32x4*)(ln_b + 128 * g + 32 * cq + 8 * q + 4);
                const float wv[8] = {w0.x, w0.y, w0.z, w0.w, w1.x, w1.y, w1.z, w1.w}, bv[8] = {c0.x, c0.y, c0.z, c0.w, c1.x, c1.y, c1.z, c1.w};
#pragma unroll
                for (int w = 0; w < 4; ++w) { const float y0 = (bflo(aw[w]) - st.x) * st.y * wv[2 * w] + bv[2 * w], y1 = (bfhi(aw[w]) - st.x) * st.y * wv[2 * w + 1] + bv[2 * w + 1];
                    const unsigned pk = pk2(y0, y1); const int cc = 32 * cq + 8 * q + 2 * w;
                    VL[cc * 136 + s] = (bf16_t)(pk & 0xffffu); VL[(cc + 1) * 136 + s] = (bf16_t)(pk >> 16); } }
            const int t = tid >> 2, sq = tid & 3; const float* wp = w_s + ((size_t)g * 128 + t) * 128 + 32 * sq;
#pragma unroll
            for (int q = 0; q < 4; ++q) { const f32x4 x0 = *(const f32x4*)(wp + 8 * q), x1 = *(const f32x4*)(wp + 8 * q + 4);
                *(LAS u32x4*)(WS + t * 136 + 32 * sq + 8 * q) = (u32x4){pk2(x0.x, x0.y), pk2(x0.z, x0.w), pk2(x1.x, x1.y), pk2(x1.z, x1.w)}; }
        }
        __syncthreads();
        {
            const int cm = wave & 3;
#pragma unroll
            for (int tt = 0; tt < 2; ++tt) {
                const int tn = 2 * (wave >> 2) + tt;
                f32x16 acc;
#pragma unroll
                for (int i = 0; i < 16; ++i) acc[i] = 0.f;
#pragma unroll
                for (int ks = 0; ks < 8; ++ks) { const bf16x8 a = *(const LAS bf16x8*)(VL + (32 * cm + r) * 136 + 16 * ks + 8 * hh), bb = *(const LAS bf16x8*)(WS + (32 * tn + r) * 136 + 16 * ks + 8 * hh); acc = MFMA32(a, bb, acc); }
                const int t = 32 * tn + r; const float bias = b_s[g * 128 + t];
                bf16_t* up = UG + (rowbase + t) * D + 128 * g + 32 * cm + 4 * hh;
#pragma unroll
                for (int q = 0; q < 4; ++q) { const u32x2 uw = *(const u32x2*)(up + 8 * q);
                    *(u32x2*)(up + 8 * q) = (u32x2){pk2(bflo(uw.x) * (acc[4 * q] + bias), bfhi(uw.x) * (acc[4 * q + 1] + bias)), pk2(bflo(uw.y) * (acc[4 * q + 2] + bias), bfhi(uw.y) * (acc[4 * q + 3] + bias))}; }
            }
        }
    }
}

struct Args { const float* in[13]; float* out; unsigned char* ws; int ph_lo, ph_hi; };
constexpr int NPH = 4 * 13 + 1;

__global__ void __launch_bounds__(512, 2) mega(Args a) {
    extern __shared__ __attribute__((aligned(16))) unsigned char shm[];
    LAS unsigned char* lds = (LAS unsigned char*)shm;
    cg::grid_group grid = cg::this_grid();
    const int G = gridDim.x, blk = blockIdx.x;
    unsigned char* ws = a.ws;
    const float* x0 = a.in[0];
    bf16_t* Hb = (bf16_t*)(ws + WS_H); bf16_t* out9 = (bf16_t*)(ws + WS_OUT9);
    bf16_t* Qb = out9, *ZFb = out9 + ARR, *Ib = out9 + 3 * ARR, *SGAb = out9 + 4 * ARR, *UGb = out9 + 5 * ARR, *GVb = out9 + 6 * ARR, *SMAb = out9 + 7 * ARR, *SMBb = out9 + 8 * ARR;
    bf16_t* OFb = (bf16_t*)(ws + WS_OF); bf16_t* Xb = (bf16_t*)(ws + WS_X); float* ACb = (float*)(ws + WS_AC); f32x2* STb = (f32x2*)(ws + WS_ST);
    bf16_t* MGb = Qb;
    volatile LAS unsigned* bst = (volatile LAS unsigned*)(lds + LDS_BYTES - 16);
    if (threadIdx.x < 4) bst[threadIdx.x] = 0u;
    if (blk == 0) for (int i = threadIdx.x; i < XCD_BAR_WORDS; i += 512) ((unsigned*)ws)[i] = 0u;
    __syncthreads();
    XcdBarrier xb; xb.bar = (unsigned*)ws; xb.x = 0; xb.st = bst;
    for (int ph = a.ph_lo; ph < a.ph_hi; ++ph) {
        if (ph == a.ph_lo + 1) { grid.sync(); xb = xcd_barrier_post((unsigned*)ws, bst); }
        else if (ph > a.ph_lo + 1) xcd_barrier(xb);
        if (ph == NPH - 1) { phase_final(a.out, a.in[12], M_ALL, G); continue; }
        const int l = ph / 13, rr = ph % 13;
        const float* xin = (l == 0) ? x0 : a.out;
        if (rr == 0) {
            phase_prep(lds, a.in[2] + (size_t)l * D * NIN, a.in[9] + (size_t)l * D * D, a.in[10] + (size_t)l * D * D, a.in[11] + (size_t)l * D * D, ws, G);
            phase_rms_bf16(xin, a.in[1] + l * D, Hb, M_ALL, G);
            if (blk == 0) {
                float* LBT = (float*)(ws + WS_LBT);
                for (int i = threadIdx.x; i < 2048; i += 512) { const float* lp = a.in[3] + i;
                    const float v0 = lp[0], v1 = lp[2048], v2 = lp[4096], v3 = lp[6144], mx = fmaxf(fmaxf(v0, v1), fmaxf(v2, v3));
                    const float e0 = __expf(v0 - mx), e1 = __expf(v1 - mx), e2 = __expf(v2 - mx), e3 = __expf(v3 - mx);
                    float lb = 0.f; if (l >= 1) lb += e1; if (l >= 2) lb += e2; if (l >= 3) lb += e3;
                    lb = lb / (e0 + e1 + e2 + e3);
                    LBT[(i >> 10) * 2048 + (i & 1023)] = fmaxf(lb, 1e-20f); LBT[(i >> 10) * 2048 + 1024 + (i & 1023)] = 1.0f - lb; }
            }
            continue;
        }
        const int hf = (rr - 1) / 6, k = (rr - 1) % 6;
        bf16_t* Hh = Hb + (size_t)hf * ARR;
        if (k == 0) {
            pg8::Gemm g{Hh, Hh, (const bf16_t*)(ws + WS_WIN), (const bf16_t*)(ws + WS_WIN), D};
            pg8::Order S; S.init(MH, NIN, G, blk, 0);
            EpiInProj E{out9};
            pg8::gemm_phase<EpiInProj>(lds, g, S, E);
        } else if (k == 1) {
            phase_lnstats(GVb, STb, G);
            phase_s1(lds, Qb, ZFb, Ib, OFb, Xb, ACb, (const float*)(ws + WS_LBT), G);
        } else if (k == 2) {
            phase_s2(Xb, ACb, G);
            phase_spatial(lds, GVb, UGb, STb, a.in[5] + l * D, a.in[6] + l * D, a.in[7] + (size_t)l * 8 * 128 * 128, a.in[8] + l * 8 * 128, G);
        } else if (k == 3) {
            phase_s3(lds, ZFb, OFb, Xb, SGAb, a.in[4] + l * 128, Hh, G);
        } else if (k == 4) {
            pg8::Gemm g{Hh, UGb, (const bf16_t*)(ws + WS_WA), (const bf16_t*)(ws + WS_WB), D};
            pg8::Order S; S.init(MH, D, G, blk, 1);
            EpiProjAB E{SMAb, SMBb, MGb};
            pg8::gemm_phase<EpiProjAB>(lds, g, S, E);
        } else {
            pg8::Gemm g{MGb, MGb, (const bf16_t*)(ws + WS_WO), (const bf16_t*)(ws + WS_WO), D};
            pg8::Order S; S.init(MH, D, G, blk, 0);
            EpiResid E{xin + (size_t)hf * ARR, a.out + (size_t)hf * ARR};
            pg8::gemm_phase<EpiResid>(lds, g, S, E);
        }
    }
}


extern "C" void kernel_launch(void* const* d_in, const int* in_sizes, int n_in, void* d_out, int out_size, void* d_ws, size_t ws_size, hipStream_t stream) {
    static int grid = 0;
    if (grid == 0) {
        if (n_in != 13 || ws_size < WS_END) { fprintf(stderr, "kernel_launch: unexpected inputs (n_in %d, ws %zu, need %zu)\n", n_in, ws_size, (size_t)WS_END); grid = -1; return; }
        int dev = 0, cus = 0, per_cu = 0;
        hipGetDevice(&dev); hipDeviceGetAttribute(&cus, hipDeviceAttributeMultiprocessorCount, dev);
        if (hipFuncSetAttribute((const void*)mega, hipFuncAttributeMaxDynamicSharedMemorySize, LDS_BYTES) != hipSuccess) { fprintf(stderr, "kernel_launch: hipFuncSetAttribute failed\n"); grid = -1; return; }
        if (hipOccupancyMaxActiveBlocksPerMultiprocessor(&per_cu, (const void*)mega, 512, LDS_BYTES) != hipSuccess || per_cu < 1) { fprintf(stderr, "kernel_launch: occupancy query gave %d\n", per_cu); per_cu = 1; }
        (void)hipGetLastError();
        grid = cus * 1;
        fprintf(stderr, "kernel_launch: cus %d per_cu %d grid %d\n", cus, per_cu, grid);
    }
    if (grid < 0) return;
    Args a{};
    for (int i = 0; i < 13; ++i) a.in[i] = (const float*)d_in[i];
    a.out = (float*)d_out; a.ws = (unsigned char*)d_ws; a.ph_lo = 0; a.ph_hi = NPH;
    void* args[] = {&a};
    hipError_t e = hipLaunchCooperativeKernel((const void*)mega, dim3(grid), dim3(512), args, LDS_BYTES, stream);
    if (e != hipSuccess) fprintf(stderr, "kernel_launch: cooperative launch failed: %s (grid %d)\n", hipGetErrorString(e), grid);
}
```

```cpp
#include <hip/hip_runtime.h>
#include <hip/hip_cooperative_groups.h>
#include <cstdio>
namespace cg = cooperative_groups;

#define LAS __attribute__((address_space(3)))
#define DI __device__ __forceinline__
typedef unsigned short bf16_t;
typedef short bf16x8 __attribute__((ext_vector_type(8)));
typedef float f32x4 __attribute__((ext_vector_type(4)));
typedef float f32x2 __attribute__((ext_vector_type(2)));
typedef float f32x16 __attribute__((ext_vector_type(16)));
typedef unsigned u32x4 __attribute__((ext_vector_type(4)));
typedef unsigned u32x2 __attribute__((ext_vector_type(2)));
typedef __bf16 bf16v2 __attribute__((ext_vector_type(2)));

constexpr int D = 1024, SEQ = 4096, MH = 16384, M_ALL = 32768, DEPTH = 4, NIN = 10240;
constexpr int LDS_BYTES = 163840;
constexpr float LOG2E = 1.4426950408889634f;
constexpr size_t ARR = (size_t)MH * D;

constexpr size_t WS_WIN = 1ull << 20;
constexpr size_t WS_WA = WS_WIN + (size_t)NIN * D * 2;
constexpr size_t WS_WB = WS_WA + (size_t)D * D * 2;
constexpr size_t WS_WO = WS_WB + (size_t)D * D * 2;
constexpr size_t WS_H = WS_WO + (size_t)D * D * 2;
constexpr size_t WS_OUT9 = WS_H + (size_t)M_ALL * D * 2;
constexpr size_t WS_OF = WS_OUT9 + 9 * ARR * 2;
constexpr size_t WS_X = WS_OF + 2 * ARR * 2;
constexpr size_t WS_AC = WS_X + (size_t)64 * 32 * 16384 * 2;
constexpr size_t WS_ST = WS_AC + (size_t)64 * 32 * 128 * 4;
constexpr size_t WS_LBT = WS_ST + (size_t)MH * 8;
constexpr size_t WS_END = WS_LBT + 4096 * 4;

DI unsigned pk2(float lo, float hi) { f32x2 v = {lo, hi}; bf16v2 r = __builtin_convertvector(v, bf16v2); return __builtin_bit_cast(unsigned, r); }
DI float bflo(unsigned w) { return __uint_as_float(w << 16); }
DI float bfhi(unsigned w) { return __uint_as_float(w & 0xffff0000u); }
DI float fexp2(float x) { return __builtin_amdgcn_exp2f(x); }
DI float frcp(float x) { return __builtin_amdgcn_rcpf(x); }
DI float sigmoidf_(float x) { return frcp(1.0f + fexp2(-x * LOG2E)); }
DI float siluf_(float x) { return x * sigmoidf_(x); }
DI float geluf_(float x) { const float t = x + 0.044715f * x * x * x; return x * frcp(1.0f + fexp2(-2.3022082f * t)); }
DI float wave_sum(float v) {
#pragma unroll
    for (int o = 1; o < 64; o <<= 1) v += __shfl_xor(v, o);
    return v;
}
#define LDS_WAIT() asm volatile("s_waitcnt lgkmcnt(0)" ::: "memory")
template <int CTRL, int ROWMASK, bool BC> DI float dpp_f(float x) { return __int_as_float(__builtin_amdgcn_update_dpp(0, __float_as_int(x), CTRL, ROWMASK, 0xf, BC)); }
DI int opaque_tid() { int t = threadIdx.x; asm volatile("" : "+v"(t)); return t; }


#define XB_TMO      128
#define XB_XCNT(j)  (256  + 64 * (j))
#define XB_XSUB(j)  (1280 + 64 * (j))
#define XB_XGEN(j)  (2304 + 64 * (j))
#define XB_TOP      3328
#define XB_TOPGEN   3392
#define XCD_BAR_WORDS 3456
#define XB_SPIN_CAP (1u << 18)
DI unsigned xb_ld(unsigned* p)              { return __hip_atomic_load(p, __ATOMIC_RELAXED, __HIP_MEMORY_SCOPE_AGENT); }
DI unsigned xb_add(unsigned* p, unsigned v) { return __hip_atomic_fetch_add(p, v, __ATOMIC_RELAXED, __HIP_MEMORY_SCOPE_AGENT); }
DI unsigned xb_xcc_id() { return (unsigned)__builtin_amdgcn_s_getreg((3 << 11) | 20) & 0xFu; }
#define XB_SPIN(cond, bar) do { unsigned _sp = 0; while (cond) { __builtin_amdgcn_s_sleep(1); \
    if ((++_sp & 255u) == 0u) { if (xb_ld(&(bar)[XB_TMO])) break; if (_sp > XB_SPIN_CAP) { atomicAdd(&(bar)[XB_TMO], 1u); break; } } } } while (0)
struct XcdBarrier { unsigned* bar; unsigned x; volatile LAS unsigned* st; };
DI XcdBarrier xcd_barrier_post(unsigned* bar, volatile LAS unsigned* st) {
    XcdBarrier b; b.bar = bar; b.x = xb_xcc_id(); b.st = st;
    if (threadIdx.x == 0) (void)xb_add(&bar[XB_XCNT(b.x)], 1u);
    return b;
}
DI void xcd_barrier_complete(unsigned* bar, unsigned x, unsigned& nloc, unsigned& nx) {
    const unsigned G = gridDim.x * gridDim.y * gridDim.z;
    unsigned sum, cnt, mine, sp = 0u;
    for (;;) {
        sum = 0u; cnt = 0u; mine = 0u;
#pragma unroll
        for (unsigned j = 0; j < 16; ++j) { const unsigned c = xb_ld(&bar[XB_XCNT(j)]); sum += c; cnt += (c > 0u) ? 1u : 0u; mine = (j == x) ? c : mine; }
        if (sum == G) break;
        __builtin_amdgcn_s_sleep(1);
        if ((++sp & 255u) == 0u) { if (xb_ld(&bar[XB_TMO])) break; if (sp > XB_SPIN_CAP) { atomicAdd(&bar[XB_TMO], 1u); break; } }
    }
    nloc = mine > 0u ? mine : 1u; nx = cnt > 0u ? cnt : 1u;
}
DI void xcd_barrier(const XcdBarrier& b) {
    asm volatile("s_waitcnt vmcnt(0)" ::: "memory");
    __syncthreads();
    if (threadIdx.x == 0) {
        unsigned* bar = b.bar;
        __builtin_amdgcn_s_waitcnt(0);
        unsigned nloc = b.st[0], nx = b.st[1];
        if (nloc == 0u) { xcd_barrier_complete(bar, b.x, nloc, nx); b.st[0] = nloc; b.st[1] = nx; }
        const unsigned old = xb_add(&bar[XB_XSUB(b.x)], 1u);
        const unsigned gen = old / nloc;
        if (old + 1u == (gen + 1u) * nloc) {
            __builtin_amdgcn_fence(__ATOMIC_RELEASE, "agent");
            asm volatile("s_waitcnt vmcnt(0)" ::: "memory");
            const unsigned og = xb_add(&bar[XB_TOP], 1u);
            const unsigned tg = og / nx;
            if (og + 1u == (tg + 1u) * nx) xb_add(&bar[XB_TOPGEN], 1u);
            else XB_SPIN(xb_ld(&bar[XB_TOPGEN]) == tg, bar);
            __builtin_amdgcn_fence(__ATOMIC_ACQUIRE, "agent");
            xb_add(&bar[XB_XGEN(b.x)], 1u);
            asm volatile("s_waitcnt vmcnt(0)" ::: "memory");
        } else {
            XB_SPIN(xb_ld(&bar[XB_XGEN(b.x)]) == gen, bar);
            __builtin_amdgcn_fence(__ATOMIC_ACQUIRE, "agent");
            asm volatile("s_waitcnt vmcnt(0)" ::: "memory");
        }
    }
    __syncthreads();
}

namespace pg8 {
constexpr int BM = 256, BK = 64, HALF = 128, HTB = HALF * BK * 2, STAGE_BYTES = 8 * HTB, NXCD = 8, WGM = 8;
DI int lds_byte(int r, int c) { const int st = (r >> 4) * 2 + (c >> 5), rr = r & 15, cc = c & 31, ob = rr * 64 + cc * 2; return st * 1024 + (ob ^ (((ob >> 9) & 1) << 5)); }
DI void stage_rc(int b, int& R, int& C) { const int st = b / 1024, sb = b % 1024, swz = sb ^ (((sb >> 9) & 1) << 5); R = (st >> 1) * 16 + swz / 64; C = (st & 1) * 32 + (swz % 64) / 2; }
DI int perm32(int rho) { const int n = rho >> 4, i = rho & 15; return 8 * (i >> 2) + 4 * n + (i & 3); }

struct Unit { int pm, pn, sel; };
struct Gemm { const bf16_t* A0; const bf16_t* A1; const bf16_t* B0; const bf16_t* B1; int K; };
struct Order {
    int nM, nN, nwg, G, c, dual;
    DI void init(int M, int N, int G_, int c_, int dual_) { nM = M / BM; nN = N / BM; nwg = nM * nN; G = G_; c = c_; dual = dual_; }
    DI bool next(int i, Unit& u) const {
        const int ti = dual ? (i >> 1) : i; u.sel = dual ? (i & 1) : 0;
        const long L = (long)ti * G + c; if (L >= nwg) return false;
        int wgid = (int)L; { const int q = nwg / NXCD, r = nwg % NXCD, xcd = wgid % NXCD, off = wgid / NXCD; wgid = (xcd < r ? xcd * (q + 1) : r * (q + 1) + (xcd - r) * q) + off; }
        const int nig = WGM * nN, gid = wgid / nig, fm = gid * WGM, gsz = (nM - fm) < WGM ? (nM - fm) : WGM;
        u.pm = fm + ((wgid % nig) % gsz); u.pn = (wgid % nig) / gsz; return true;
    }
};

template <class Epi>
DI void gemm_phase(LAS unsigned char* lds, const Gemm g, const Order& S, const Epi& E) {
    const int tid = opaque_tid(), wid = __builtin_amdgcn_readfirstlane(tid >> 6), lane = tid & 63, wr = wid >> 2, wc = wid & 3, fr = lane & 15, fq = lane >> 4;
    const int K = g.K, nt = K / BK;
    unsigned voffA[2], voffB[2];
#pragma unroll
    for (int i = 0; i < 2; ++i) { int R, C; stage_rc(tid * 16 + i * 8192, R, C); const int Rb = Epi::PERM ? ((R & ~31) + perm32(R & 31)) : R;
        voffA[i] = (unsigned)(R * K + C) * 2u; voffB[i] = (unsigned)(Rb * K + C) * 2u; }
    const size_t kstep = (size_t)(BK * 2);
    const size_t hstep = (size_t)HALF * K * 2;
    const size_t tstep = 2 * hstep;
    const unsigned ldsw = (unsigned)wid * 1024u;
    const int aoff = lds_byte(wr * 64 + fr, fq * 8), boff = lds_byte(wc * 32 + fr, fq * 8);
#define PG8_SA(b, h) (((b) * 2 + (h)) * HTB)
#define PG8_SB(b, h) ((4 + (b) * 2 + (h)) * HTB)
#define PG8_STAGE(bufoff, gbase, voff) do { _Pragma("unroll") for (int _i = 0; _i < 2; ++_i) \
        __builtin_amdgcn_global_load_lds((const unsigned*)((const char*)(gbase) + (voff)[_i]), (LAS unsigned*)(lds + (bufoff) + ldsw + _i * 8192), 16, 0, 0); } while (0)
#define PG8_LDA(dst, b, h) do { _Pragma("unroll") for (int m = 0; m < 4; ++m) _Pragma("unroll") for (int k = 0; k < 2; ++k) dst[m][k] = *(const LAS bf16x8*)(lds + PG8_SA(b, h) + aoff + m * 2048 + k * 1024); } while (0)
#define PG8_LDB(dst, b, h) do { _Pragma("unroll") for (int n = 0; n < 2; ++n) _Pragma("unroll") for (int k = 0; k < 2; ++k) dst[n][k] = *(const LAS bf16x8*)(lds + PG8_SB(b, h) + boff + n * 2048 + k * 1024); } while (0)
#define PG8_MMA(ai, bj, At, Bt) do { __builtin_amdgcn_s_setprio(1); _Pragma("unroll") for (int m = 0; m < 4; ++m) _Pragma("unroll") for (int n = 0; n < 2; ++n) _Pragma("unroll") for (int k = 0; k < 2; ++k) \
        acc[ai][bj][m][n] = __builtin_amdgcn_mfma_f32_16x16x32_bf16(Bt[n][k], At[m][k], acc[ai][bj][m][n], 0, 0, 0); __builtin_amdgcn_s_setprio(0); } while (0)
#define PG8_WAIT_V(n) asm volatile("s_waitcnt vmcnt(" #n ")" ::: "memory")
#define PG8_WAIT_L(n) asm volatile("s_waitcnt lgkmcnt(" #n ")" ::: "memory")
#define PG8_BAR __builtin_amdgcn_s_barrier()
#define PG8_SCHED __builtin_amdgcn_sched_barrier(0)
    Unit cur, nxt; int ui = 0;
    if (!S.next(0, cur)) return;
    f32x4 acc[2][2][4][2];
#pragma unroll
    for (int a = 0; a < 2; ++a)
#pragma unroll
        for (int b = 0; b < 2; ++b)
#pragma unroll
            for (int m = 0; m < 4; ++m)
#pragma unroll
                for (int n = 0; n < 2; ++n) acc[a][b][m][n] = (f32x4){0.f, 0.f, 0.f, 0.f};
    bf16x8 At[4][2], B0[2][2], B1[2][2];
    const char* cA = (const char*)(cur.sel ? g.A1 : g.A0) + (size_t)cur.pm * tstep; const char* cB = (const char*)(cur.sel ? g.B1 : g.B0) + (size_t)cur.pn * tstep;
    PG8_STAGE(PG8_SB(0, 0), cB, voffB); PG8_STAGE(PG8_SB(0, 1), cB + hstep, voffB); PG8_STAGE(PG8_SA(0, 0), cA, voffA); PG8_STAGE(PG8_SA(0, 1), cA + hstep, voffA);
    if (wr == 1) PG8_BAR;
    PG8_WAIT_V(2); PG8_BAR;
    PG8_STAGE(PG8_SB(1, 0), cB + kstep, voffB); PG8_STAGE(PG8_SA(1, 0), cA + kstep, voffA); PG8_STAGE(PG8_SB(1, 1), cB + hstep + kstep, voffB);
    PG8_WAIT_V(6); PG8_BAR;
    for (;;) {
        const bool has_next = S.next(ui + 1, nxt);
        const char* nA = has_next ? (const char*)(nxt.sel ? g.A1 : g.A0) + (size_t)nxt.pm * tstep : cA; const char* nB = has_next ? (const char*)(nxt.sel ? g.B1 : g.B0) + (size_t)nxt.pn * tstep : cB;
        for (int t = 0; t < nt; t += 2) {
            const bool last = (t == nt - 2);
            const char* a1 = cA + (size_t)(t + 1) * kstep;
            const char* a2 = last ? nA : cA + (size_t)(t + 2) * kstep; const char* b2 = last ? nB : cB + (size_t)(t + 2) * kstep;
            const char* a3 = a2 + kstep; const char* b3 = b2 + kstep;
            PG8_LDB(B0, 0, 0); PG8_LDB(B1, 0, 1); PG8_SCHED; PG8_LDA(At, 0, 0); PG8_STAGE(PG8_SA(1, 1), a1 + hstep, voffA);
            PG8_WAIT_V(8); PG8_WAIT_L(0); PG8_BAR; PG8_MMA(0, 0, At, B0); PG8_MMA(0, 1, At, B1); PG8_BAR; PG8_SCHED;
            PG8_LDA(At, 0, 1); PG8_STAGE(PG8_SB(0, 0), b2, voffB); PG8_STAGE(PG8_SB(0, 1), b2 + hstep, voffB); PG8_STAGE(PG8_SA(0, 0), a2, voffA);
            PG8_WAIT_V(8); PG8_WAIT_L(0); PG8_BAR; PG8_MMA(1, 0, At, B0); PG8_MMA(1, 1, At, B1); PG8_BAR; PG8_SCHED;
            PG8_LDB(B0, 1, 0); PG8_LDB(B1, 1, 1); PG8_SCHED; PG8_LDA(At, 1, 0); PG8_STAGE(PG8_SA(0, 1), a2 + hstep, voffA);
            PG8_WAIT_V(8); PG8_WAIT_L(0); PG8_BAR; PG8_MMA(0, 0, At, B0); PG8_MMA(0, 1, At, B1); PG8_BAR; PG8_SCHED;
            PG8_LDA(At, 1, 1); PG8_STAGE(PG8_SB(1, 0), b3, voffB); PG8_STAGE(PG8_SB(1, 1), b3 + hstep, voffB); PG8_STAGE(PG8_SA(1, 0), a3, voffA);
            PG8_WAIT_V(8); PG8_WAIT_L(0); PG8_BAR; PG8_MMA(1, 0, At, B0); PG8_MMA(1, 1, At, B1); PG8_BAR; PG8_SCHED;
        }
        if (wr == 0) PG8_BAR;
        E(acc, cur, wr, wc, fr, fq);
        if (!has_next) break;
#pragma unroll
        for (int a = 0; a < 2; ++a)
#pragma unroll
            for (int b = 0; b < 2; ++b)
#pragma unroll
                for (int m = 0; m < 4; ++m)
#pragma unroll
                    for (int n = 0; n < 2; ++n) acc[a][b][m][n] = (f32x4){0.f, 0.f, 0.f, 0.f};
        cur = nxt; cA = nA; cB = nB; ++ui;
        if (wr == 1) PG8_BAR;
    }
    PG8_WAIT_V(0);
    PG8_BAR;
#undef PG8_SA
#undef PG8_SB
#undef PG8_STAGE
#undef PG8_LDA
#undef PG8_LDB
#undef PG8_MMA
#undef PG8_WAIT_V
#undef PG8_WAIT_L
#undef PG8_BAR
#undef PG8_SCHED
}
}

template <int ACT> DI float act_fn(float x) {
    if (ACT == 0) return x;
    if (ACT == 1) return siluf_(x) * 0.08838834764831845f;
    if (ACT == 2) return siluf_(x);
    if (ACT == 3) return geluf_(x);
    return sigmoidf_(x);
}
template <int ACT> DI void store_act(const f32x4 (&acc)[2][2][4][2], bf16_t* base, int row0, int col0) {
#pragma unroll
    for (int ai = 0; ai < 2; ++ai)
#pragma unroll
        for (int m = 0; m < 4; ++m) { bf16_t* rowp = base + (size_t)(row0 + ai * 128 + m * 16) * D + col0;
#pragma unroll
            for (int bj = 0; bj < 2; ++bj) { const f32x4 v0 = acc[ai][bj][m][0], v1 = acc[ai][bj][m][1];
                u32x4 w; w.x = pk2(act_fn<ACT>(v0[0]), act_fn<ACT>(v0[1])); w.y = pk2(act_fn<ACT>(v0[2]), act_fn<ACT>(v0[3]));
                w.z = pk2(act_fn<ACT>(v1[0]), act_fn<ACT>(v1[1])); w.w = pk2(act_fn<ACT>(v1[2]), act_fn<ACT>(v1[3]));
                *(u32x4*)(rowp + bj * 128) = w; } }
}
struct EpiInProj {
    static constexpr bool PERM = true;
    bf16_t* out9;
    DI void operator()(const f32x4 (&acc)[2][2][4][2], const pg8::Unit& u, int wr, int wc, int fr, int fq) const {
        const int pn = u.pn, row0 = u.pm * 256 + wr * 64 + fr, cl = wc * 32 + 8 * fq;
        if (pn >= 20 && pn < 28) {
            bf16_t* base = out9 + 5 * ARR; const int col0 = 128 * (pn - 20) + cl;
#pragma unroll
            for (int ai = 0; ai < 2; ++ai)
#pragma unroll
                for (int m = 0; m < 4; ++m) { bf16_t* rowp = base + (size_t)(row0 + ai * 128 + m * 16) * D + col0;
                    const f32x4 u0 = acc[ai][0][m][0], u1 = acc[ai][0][m][1], g0 = acc[ai][1][m][0], g1 = acc[ai][1][m][1];
                    u32x4 w; w.x = pk2(geluf_(u0[0]) * siluf_(g0[0]), geluf_(u0[1]) * siluf_(g0[1])); w.y = pk2(geluf_(u0[2]) * siluf_(g0[2]), geluf_(u0[3]) * siluf_(g0[3]));
                    w.z = pk2(geluf_(u1[0]) * siluf_(g1[0]), geluf_(u1[1]) * siluf_(g1[1])); w.w = pk2(geluf_(u1[2]) * siluf_(g1[2]), geluf_(u1[3]) * siluf_(g1[3]));
                    *(u32x4*)rowp = w; }
            return;
        }
        int idx, ct;
        if (pn < 20) { idx = pn >> 2; ct = pn & 3; } else if (pn < 32) { idx = 6; ct = pn - 28; } else { idx = 7 + ((pn - 32) >> 2); ct = (pn - 32) & 3; }
        bf16_t* base = out9 + (size_t)idx * ARR; const int col0 = 256 * ct + cl;
        if (idx == 0) store_act<1>(acc, base, row0, col0);
        else if (idx <= 3) store_act<0>(acc, base, row0, col0);
        else if (idx == 4) store_act<2>(acc, base, row0, col0);
        else if (idx == 6) store_act<3>(acc, base, row0, col0);
        else store_act<4>(acc, base, row0, col0);
    }
};
struct EpiProjAB {
    static constexpr bool PERM = true;
    const bf16_t* SMA; const bf16_t* SMB; bf16_t* MG;
    DI void operator()(const f32x4 (&acc)[2][2][4][2], const pg8::Unit& u, int wr, int wc, int fr, int fq) const {
        const int row0 = u.pm * 256 + wr * 64 + fr, col0 = u.pn * 256 + wc * 32 + 8 * fq;
        const bf16_t* gate = u.sel ? SMB : SMA;
#pragma unroll
        for (int ai = 0; ai < 2; ++ai)
#pragma unroll
            for (int m = 0; m < 4; ++m) { const size_t off = (size_t)(row0 + ai * 128 + m * 16) * D + col0;
#pragma unroll
                for (int bj = 0; bj < 2; ++bj) { const f32x4 v0 = acc[ai][bj][m][0], v1 = acc[ai][bj][m][1];
                    const u32x4 gw = *(const u32x4*)(gate + off + bj * 128);
                    float o[8] = {v0[0] * bflo(gw.x), v0[1] * bfhi(gw.x), v0[2] * bflo(gw.y), v0[3] * bfhi(gw.y), v1[0] * bflo(gw.z), v1[1] * bfhi(gw.z), v1[2] * bflo(gw.w), v1[3] * bfhi(gw.w)};
                    if (u.sel) { const u32x4 tw = *(const u32x4*)(MG + off + bj * 128);
                        o[0] += bflo(tw.x); o[1] += bfhi(tw.x); o[2] += bflo(tw.y); o[3] += bfhi(tw.y); o[4] += bflo(tw.z); o[5] += bfhi(tw.z); o[6] += bflo(tw.w); o[7] += bfhi(tw.w); }
                    u32x4 w; w.x = pk2(o[0], o[1]); w.y = pk2(o[2], o[3]); w.z = pk2(o[4], o[5]); w.w = pk2(o[6], o[7]);
                    *(u32x4*)(MG + off + bj * 128) = w; }
                asm volatile("" ::: "memory"); }
    }
};
struct EpiResid {
    static constexpr bool PERM = false;
    const float* xin; float* out;
    DI void operator()(const f32x4 (&acc)[2][2][4][2], const pg8::Unit& u, int wr, int wc, int fr, int fq) const {
        const int row0 = u.pm * 256 + wr * 64 + fr, col0 = u.pn * 256 + wc * 32 + 4 * fq;
#pragma unroll
        for (int ai = 0; ai < 2; ++ai)
#pragma unroll
            for (int m = 0; m < 4; ++m) { const size_t off = (size_t)(row0 + ai * 128 + m * 16) * D + col0;
#pragma unroll
                for (int bj = 0; bj < 2; ++bj)
#pragma unroll
                    for (int n = 0; n < 2; ++n) { const f32x4 xv = *(const f32x4*)(xin + off + bj * 128 + n * 16); *(f32x4*)(out + off + bj * 128 + n * 16) = xv + acc[ai][bj][m][n]; }
                asm volatile("" ::: "memory"); }
    }
};

DI int src_col(int nv) {
    if (nv < 5120) return nv;
    if (nv < 7168) { const int t = (nv - 5120) >> 8, w = (nv - 5120) & 255; return w < 128 ? 5120 + 128 * t + w : 7168 + 128 * t + (w - 128); }
    if (nv < 8192) return 6144 + (nv - 7168);
    return nv;
}
DI void transpose_item(const float* W, int N, bf16_t* WT, int k0, int nsrc0, int nvirt0, LAS float* scr, int lane) {
#pragma unroll 8
    for (int i = 0; i < 32; ++i) { const int kk = 2 * i + (lane >> 5); scr[kk * 33 + (lane & 31)] = W[(size_t)(k0 + kk) * N + nsrc0 + (lane & 31)]; }
    LDS_WAIT();
    const int c = lane & 7;
#pragma unroll
    for (int j = 0; j < 4; ++j) { const int n = (lane >> 3) + 8 * j; const LAS float* s = scr + (8 * c) * 33 + n;
        u32x4 o; o.x = pk2(s[0 * 33], s[1 * 33]); o.y = pk2(s[2 * 33], s[3 * 33]); o.z = pk2(s[4 * 33], s[5 * 33]); o.w = pk2(s[6 * 33], s[7 * 33]);
        *(u32x4*)(WT + (size_t)(nvirt0 + n) * D + k0 + 8 * c) = o; }
    LDS_WAIT();
}
DI void phase_prep(LAS unsigned char* lds, const float* w_in, const float* wa, const float* wb, const float* wo, unsigned char* ws, int G) {
    const int tid_ = opaque_tid(); const int lane = tid_ & 63, wave = __builtin_amdgcn_readfirstlane(tid_ >> 6);
    LAS float* scr = (LAS float*)(lds + wave * 16384);
    const int gw = blockIdx.x * 8 + wave, NGW = G * 8;
    constexpr int I_IN = 16 * 320, I_P = 16 * 32, PER_L = I_IN + 3 * I_P;
    for (int it = gw; it < PER_L; it += NGW) {
        int r = it;
        if (r < I_IN) { const int kb = r / 320, nb = r % 320; transpose_item(w_in, NIN, (bf16_t*)(ws + WS_WIN), 64 * kb, src_col(32 * nb), 32 * nb, scr, lane); continue; }
        r -= I_IN; const int which = r / I_P; r %= I_P; const int kb = r / 32, nb = r % 32;
        const float* W = (which == 0 ? wa : which == 1 ? wb : wo);
        bf16_t* WT = (bf16_t*)(ws + (which == 0 ? WS_WA : which == 1 ? WS_WB : WS_WO));
        transpose_item(W, D, WT, 64 * kb, 32 * nb, 32 * nb, scr, lane);
    }
}
DI void phase_rms_bf16(const float* x, const float* w, bf16_t* h, int nrows, int G) {
    const int tid_ = opaque_tid(); const int lane = tid_ & 63, wave = __builtin_amdgcn_readfirstlane(tid_ >> 6);
    const int gw = blockIdx.x * 8 + wave, NGW = G * 8;
    f32x4 wv[4];
#pragma unroll
    for (int j = 0; j < 4; ++j) wv[j] = ((const f32x4*)w)[lane + 64 * j];
    for (int m = gw; m < nrows; m += NGW) {
        const f32x4* xr = (const f32x4*)(x + (size_t)m * D) + lane; f32x4 v[4]; float s = 0.f;
#pragma unroll
        for (int j = 0; j < 4; ++j) { v[j] = xr[64 * j]; s += (v[j].x * v[j].x + v[j].y * v[j].y) + (v[j].z * v[j].z + v[j].w * v[j].w); }
        const float rstd = rsqrtf(wave_sum(s) * (1.0f / D) + 1e-6f);
        u32x2* o8 = (u32x2*)(h + (size_t)m * D) + lane;
#pragma unroll
        for (int j = 0; j < 4; ++j) { u32x2 o; o.x = pk2(v[j].x * rstd * wv[j].x, v[j].y * rstd * wv[j].y); o.y = pk2(v[j].z * rstd * wv[j].z, v[j].w * rstd * wv[j].w); o8[64 * j] = o; }
    }
}
DI void phase_final(float* x, const float* w, int nrows, int G) {
    const int tid_ = opaque_tid(); const int lane = tid_ & 63, wave = __builtin_amdgcn_readfirstlane(tid_ >> 6);
    const int gw = blockIdx.x * 8 + wave, NGW = G * 8;
    f32x4 wv[4];
#pragma unroll
    for (int j = 0; j < 4; ++j) wv[j] = ((const f32x4*)w)[lane + 64 * j];
    for (int m = gw; m < nrows; m += NGW) {
        f32x4* xr = (f32x4*)(x + (size_t)m * D) + lane; f32x4 v[4]; float s = 0.f;
#pragma unroll
        for (int j = 0; j < 4; ++j) { v[j] = xr[64 * j]; s += (v[j].x * v[j].x + v[j].y * v[j].y) + (v[j].z * v[j].z + v[j].w * v[j].w); }
        const float rstd = rsqrtf(wave_sum(s) * (1.0f / D) + 1e-6f);
#pragma unroll
        for (int j = 0; j < 4; ++j) xr[64 * j] = v[j] * rstd * wv[j];
    }
}
#define MFMA32(a, b, c) __builtin_amdgcn_mfma_f32_32x32x16_bf16((a), (b), (c), 0, 0, 0)
struct S1Regs { u32x4 q0, q1, z0, z1, v0, v1; };
DI size_t s1_rowoff(int it, int sub, int j) {
    const int sc = it & 31, dir = (it >> 5) & 1, h = (it >> 6) & 7, b = it >> 9, p = 64 * sub + j;
    return ((size_t)b * SEQ + sc * 128 + (dir ? 127 - p : p)) * D + h * 128;
}
DI void s1_load(S1Regs& R, const bf16_t* Q, const bf16_t* Z, const bf16_t* Iv, int it, int sub, int tid) {
    const size_t off = s1_rowoff(it, sub, tid >> 3) + 16 * (tid & 7);
    const bf16_t* zp = Z + (size_t)((it >> 5) & 1) * ARR;
    R.q0 = *(const u32x4*)(Q + off); R.q1 = *(const u32x4*)(Q + off + 8);
    R.z0 = *(const u32x4*)(zp + off); R.z1 = *(const u32x4*)(zp + off + 8);
    R.v0 = *(const u32x4*)(Iv + off); R.v1 = *(const u32x4*)(Iv + off + 8);
}
DI void phase_s1(LAS unsigned char* lds, const bf16_t* Q, bf16_t* Z, const bf16_t* Iv, bf16_t* O, bf16_t* X, float* AC, const float* LBT, int G) {
    const int tid = opaque_tid(), lane = tid & 63, wave = __builtin_amdgcn_readfirstlane(tid >> 6);
    const int r = lane & 31, hh = lane >> 5, j8 = tid >> 3, cg8 = tid & 7;
    LAS bf16_t* TQ = (LAS bf16_t*)(lds);
    LAS bf16_t* TV = (LAS bf16_t*)(lds + 17408);
    LAS bf16_t* TZ = (LAS bf16_t*)(lds + 34816);
    LAS bf16_t* QS = (LAS bf16_t*)(lds + 52224);
    LAS bf16_t* KSA = (LAS bf16_t*)(lds + 69632);
    LAS bf16_t* KSB = (LAS bf16_t*)(lds + 87040);
    LAS bf16_t* KHT = (LAS bf16_t*)(lds + 104448);
    LAS bf16_t* VT = (LAS bf16_t*)(lds + 122880);
    LAS float* TA = (LAS float*)(lds + 157696);
    LAS float* AA = TA + 128;
    LAS float* AB = TA + 256;
    LAS bf16_t* PS = TV;
    S1Regs R;
    int it = blockIdx.x;
    if (it < 2048) s1_load(R, Q, Z, Iv, it, 0, tid);
    __syncthreads();
    for (; it < 2048; it += G) {
        const int sc = it & 31, dir = (it >> 5) & 1, h = (it >> 6) & 7, b = it >> 9, seq = (b * 8 + h) * 2 + dir;
        f32x16 DA[2];
#pragma unroll
        for (int sub = 0; sub < 2; ++sub) {
            *(LAS u32x4*)(TQ + j8 * 136 + 16 * cg8) = R.q0; *(LAS u32x4*)(TQ + j8 * 136 + 16 * cg8 + 8) = R.q1;
            *(LAS u32x4*)(TZ + j8 * 136 + 16 * cg8) = R.z0; *(LAS u32x4*)(TZ + j8 * 136 + 16 * cg8 + 8) = R.z1;
            *(LAS u32x4*)(TV + j8 * 136 + 16 * cg8) = R.v0; *(LAS u32x4*)(TV + j8 * 136 + 16 * cg8 + 8) = R.v1;
            __syncthreads();
            {
                const float* lp = LBT + dir * 2048 + h * 128 + 16 * wave;
                const u32x4 z0 = *(const LAS u32x4*)(TZ + lane * 136 + 16 * wave), z1 = *(const LAS u32x4*)(TZ + lane * 136 + 16 * wave + 8);
                const u32x4 q0 = *(const LAS u32x4*)(TQ + lane * 136 + 16 * wave), q1 = *(const LAS u32x4*)(TQ + lane * 136 + 16 * wave + 8);
                const u32x4 v0 = *(const LAS u32x4*)(TV + lane * 136 + 16 * wave), v1 = *(const LAS u32x4*)(TV + lane * 136 + 16 * wave + 8);
                const unsigned zw[8] = {z0.x, z0.y, z0.z, z0.w, z1.x, z1.y, z1.z, z1.w};
                const unsigned qw[8] = {q0.x, q0.y, q0.z, q0.w, q1.x, q1.y, q1.z, q1.w};
                const unsigned vw[8] = {v0.x, v0.y, v0.z, v0.w, v1.x, v1.y, v1.z, v1.w};
                float kk[16], gg[16], lbv[16], omv[16];
#pragma unroll
                for (int i = 0; i < 16; ++i) { lbv[i] = lp[i]; omv[i] = lp[1024 + i]; }
                if (sub == 0) s1_load(R, Q, Z, Iv, it, 1, tid); else if (it + G < 2048) s1_load(R, Q, Z, Iv, it + G, 0, tid);
#pragma unroll
                for (int i = 0; i < 16; ++i) { const unsigned w = zw[i >> 1]; float z = (i & 1) ? bfhi(w) : bflo(w); z = __builtin_amdgcn_fmed3f(z, -30.f, 30.f);
                    const float e = fexp2(-z * LOG2E), sg = frcp(1.0f + e); const float om = omv[i];
                    kk[i] = om * e * sg; gg[i] = __builtin_amdgcn_logf(lbv[i] + om * sg); }
#pragma unroll
                for (int i = 0; i < 16; ++i) {
                    float x = gg[i];
                    x += dpp_f<0x111, 0xf, true>(x); x += dpp_f<0x112, 0xf, true>(x); x += dpp_f<0x114, 0xf, true>(x); x += dpp_f<0x118, 0xf, true>(x);
                    x += dpp_f<0x142, 0xa, false>(x); x += dpp_f<0x143, 0xc, false>(x);
                    gg[i] = x; }
                float aa[16], ta[16];
                if (sub == 1) {
#pragma unroll
                    for (int q4 = 0; q4 < 4; ++q4) { const f32x4 a4 = *(const LAS f32x4*)(AA + 16 * wave + 4 * q4), t4 = *(const LAS f32x4*)(TA + 16 * wave + 4 * q4);
                        aa[4 * q4] = a4.x; aa[4 * q4 + 1] = a4.y; aa[4 * q4 + 2] = a4.z; aa[4 * q4 + 3] = a4.w; ta[4 * q4] = t4.x; ta[4 * q4 + 1] = t4.y; ta[4 * q4 + 2] = t4.z; ta[4 * q4 + 3] = t4.w; }
                }
                unsigned qo[8], ko[8], kh[8], qh[8];
                float a16[16], t16[16], f16_[16];
#pragma unroll
                for (int w = 0; w < 8; ++w) {
                    float qt_[2], kt_[2], kh_[2], qh_[2];
#pragma unroll
                    for (int e2 = 0; e2 < 2; ++e2) { const int i = 2 * w + e2; const float qf = e2 ? bfhi(qw[w]) : bflo(qw[w]);
                        const float Rr = __int_as_float(__builtin_amdgcn_readlane(__float_as_int(gg[i]), 31)), G63 = __int_as_float(__builtin_amdgcn_readlane(__float_as_int(gg[i]), 63));
                        const float dq = gg[i] - Rr;
                        qt_[e2] = qf * fexp2(fminf(dq, 100.f)); kt_[e2] = kk[i] * fexp2(fminf(-dq, 100.f));
                        a16[i] = fexp2(gg[i]); kh_[e2] = kk[i] * fexp2(G63 - gg[i]); t16[i] = gg[i] - Rr;
                        if (sub == 0) { qh_[e2] = qf * a16[i]; } else { qh_[e2] = qf * a16[i] * aa[i]; f16_[i] = fexp2(Rr + ta[i]); } }
                    qo[w] = pk2(qt_[0], qt_[1]); ko[w] = pk2(kt_[0], kt_[1]); kh[w] = pk2(kh_[0], kh_[1]); qh[w] = pk2(qh_[0], qh_[1]);
                }
                LAS bf16_t* KSx = (sub == 0) ? KSA : KSB;
                *(LAS u32x4*)(QS + lane * 136 + 16 * wave) = (u32x4){qo[0], qo[1], qo[2], qo[3]}; *(LAS u32x4*)(QS + lane * 136 + 16 * wave + 8) = (u32x4){qo[4], qo[5], qo[6], qo[7]};
                *(LAS u32x4*)(KSx + lane * 136 + 16 * wave) = (u32x4){ko[0], ko[1], ko[2], ko[3]}; *(LAS u32x4*)(KSx + lane * 136 + 16 * wave + 8) = (u32x4){ko[4], ko[5], ko[6], ko[7]};
                *(LAS u32x4*)(TZ + lane * 136 + 16 * wave) = (u32x4){qh[0], qh[1], qh[2], qh[3]}; *(LAS u32x4*)(TZ + lane * 136 + 16 * wave + 8) = (u32x4){qh[4], qh[5], qh[6], qh[7]};
#pragma unroll
                for (int w = 0; w < 8; ++w) {
                    KHT[(16 * wave + 2 * w) * 72 + lane] = (bf16_t)(kh[w] & 0xffffu); KHT[(16 * wave + 2 * w + 1) * 72 + lane] = (bf16_t)(kh[w] >> 16);
                    VT[(16 * wave + 2 * w) * 136 + 64 * sub + lane] = (bf16_t)(vw[w] & 0xffffu); VT[(16 * wave + 2 * w + 1) * 136 + 64 * sub + lane] = (bf16_t)(vw[w] >> 16);
                }
                if (sub == 0) {
                    if (lane == 63) {
#pragma unroll
                        for (int q4 = 0; q4 < 4; ++q4) { *(LAS f32x4*)(TA + 16 * wave + 4 * q4) = (f32x4){t16[4 * q4], t16[4 * q4 + 1], t16[4 * q4 + 2], t16[4 * q4 + 3]};
                            *(LAS f32x4*)(AA + 16 * wave + 4 * q4) = (f32x4){a16[4 * q4], a16[4 * q4 + 1], a16[4 * q4 + 2], a16[4 * q4 + 3]}; }
                    }
                } else {
                    const u32x4 k0 = *(const LAS u32x4*)(KSA + lane * 136 + 16 * wave), k1 = *(const LAS u32x4*)(KSA + lane * 136 + 16 * wave + 8);
                    const unsigned kw[8] = {k0.x, k0.y, k0.z, k0.w, k1.x, k1.y, k1.z, k1.w}; unsigned kn[8];
#pragma unroll
                    for (int w = 0; w < 8; ++w) kn[w] = pk2(bflo(kw[w]) * f16_[2 * w], bfhi(kw[w]) * f16_[2 * w + 1]);
                    *(LAS u32x4*)(KSA + lane * 136 + 16 * wave) = (u32x4){kn[0], kn[1], kn[2], kn[3]}; *(LAS u32x4*)(KSA + lane * 136 + 16 * wave + 8) = (u32x4){kn[4], kn[5], kn[6], kn[7]};
                    if (lane == 63) { float* ap = AC + ((size_t)seq * 32 + sc) * 128 + 16 * wave;
#pragma unroll
                        for (int q4 = 0; q4 < 4; ++q4) { *(LAS f32x4*)(AB + 16 * wave + 4 * q4) = (f32x4){a16[4 * q4], a16[4 * q4 + 1], a16[4 * q4 + 2], a16[4 * q4 + 3]};
                            *(f32x4*)(ap + 4 * q4) = (f32x4){a16[4 * q4] * aa[4 * q4], a16[4 * q4 + 1] * aa[4 * q4 + 1], a16[4 * q4 + 2] * aa[4 * q4 + 2], a16[4 * q4 + 3] * aa[4 * q4 + 3]}; } }
                }
            }
            __syncthreads();
            {
                LAS bf16_t* KSx = (sub == 0) ? KSA : KSB;
                if (wave < 3) {
                    const int tm = (wave == 2) ? 1 : 0, tn = (wave == 0) ? 0 : 1;
                    f32x16 acc;
#pragma unroll
                    for (int i = 0; i < 16; ++i) acc[i] = 0.f;
#pragma unroll
                    for (int ks = 0; ks < 8; ++ks) { const bf16x8 a = *(const LAS bf16x8*)(KSx + (32 * tm + r) * 136 + 16 * ks + 8 * hh), bb = *(const LAS bf16x8*)(QS + (32 * tn + r) * 136 + 16 * ks + 8 * hh); acc = MFMA32(a, bb, acc); }
                    const int t = 32 * tn + r;
#pragma unroll
                    for (int g = 0; g < 4; ++g) { const int s0 = 32 * tm + 8 * g + 4 * hh;
                        const float p0 = (s0 + 0 <= t) ? acc[4 * g + 0] : 0.f, p1 = (s0 + 1 <= t) ? acc[4 * g + 1] : 0.f, p2 = (s0 + 2 <= t) ? acc[4 * g + 2] : 0.f, p3 = (s0 + 3 <= t) ? acc[4 * g + 3] : 0.f;
                        *(LAS u32x2*)(PS + t * 136 + 64 * sub + s0) = (u32x2){pk2(p0, p1), pk2(p2, p3)}; }
                } else if (sub == 1 && wave < 7) {
                    const int tm = (wave - 3) >> 1, tn = (wave - 3) & 1;
                    f32x16 acc;
#pragma unroll
                    for (int i = 0; i < 16; ++i) acc[i] = 0.f;
#pragma unroll
                    for (int ks = 0; ks < 8; ++ks) { const bf16x8 a = *(const LAS bf16x8*)(KSA + (32 * tm + r) * 136 + 16 * ks + 8 * hh), bb = *(const LAS bf16x8*)(QS + (32 * tn + r) * 136 + 16 * ks + 8 * hh); acc = MFMA32(a, bb, acc); }
                    const int t = 32 * tn + r;
#pragma unroll
                    for (int g = 0; g < 4; ++g) { const int s0 = 32 * tm + 8 * g + 4 * hh;
                        *(LAS u32x2*)(PS + t * 136 + s0) = (u32x2){pk2(acc[4 * g], acc[4 * g + 1]), pk2(acc[4 * g + 2], acc[4 * g + 3])}; }
                }
#pragma unroll
                for (int k = 0; k < 2; ++k) {
                    const int vt = wave >> 1, dt = 2 * (wave & 1) + k;
                    f32x16 acc;
                    if (sub == 0) {
#pragma unroll
                        for (int i = 0; i < 16; ++i) acc[i] = 0.f;
                    } else { const float ab = AB[32 * dt + r];
#pragma unroll
                        for (int i = 0; i < 16; ++i) acc[i] = DA[k][i] * ab; }
#pragma unroll
                    for (int ks = 0; ks < 4; ++ks) { const bf16x8 a = *(const LAS bf16x8*)(VT + (32 * vt + r) * 136 + 64 * sub + 16 * ks + 8 * hh), bb = *(const LAS bf16x8*)(KHT + (32 * dt + r) * 72 + 16 * ks + 8 * hh); acc = MFMA32(a, bb, acc); }
                    if (sub == 0) DA[k] = acc;
                    else { bf16_t* xp = X + ((size_t)seq * 32 + sc) * 16384 + (size_t)(32 * vt + 4 * hh) * 128 + 32 * dt + r;
#pragma unroll
                        for (int i = 0; i < 16; i += 2) { const unsigned p = pk2(acc[i], acc[i + 1]); const int v0 = (i & 3) + 8 * (i >> 2);
                            xp[(size_t)v0 * 128] = (bf16_t)(p & 0xffffu); xp[(size_t)(v0 + 1) * 128] = (bf16_t)(p >> 16); } }
                }
                {
                    bf16_t* zp = Z + (size_t)dir * ARR + s1_rowoff(it, sub, j8) + 16 * cg8;
                    *(u32x4*)zp = *(const LAS u32x4*)(TZ + j8 * 136 + 16 * cg8); *(u32x4*)(zp + 8) = *(const LAS u32x4*)(TZ + j8 * 136 + 16 * cg8 + 8);
                }
            }
            __syncthreads();
            {
                const int vt = wave & 3, tn = wave >> 2;
                f32x16 acc;
#pragma unroll
                for (int i = 0; i < 16; ++i) acc[i] = 0.f;
                if (sub == 1) {
#pragma unroll
                    for (int ks = 0; ks < 4; ++ks) { const bf16x8 a = *(const LAS bf16x8*)(VT + (32 * vt + r) * 136 + 16 * ks + 8 * hh), bb = *(const LAS bf16x8*)(PS + (32 * tn + r) * 136 + 16 * ks + 8 * hh); acc = MFMA32(a, bb, acc); }
                }
#pragma unroll
                for (int ks = 0; ks < 4; ++ks) { if (ks < 2 * (tn + 1)) { const bf16x8 a = *(const LAS bf16x8*)(VT + (32 * vt + r) * 136 + 64 * sub + 16 * ks + 8 * hh), bb = *(const LAS bf16x8*)(PS + (32 * tn + r) * 136 + 64 * sub + 16 * ks + 8 * hh); acc = MFMA32(a, bb, acc); } }
                LAS bf16_t* op = QS + (32 * tn + r) * 136 + 32 * vt + 4 * hh;
#pragma unroll
                for (int g = 0; g < 4; ++g) *(LAS u32x2*)(op + 8 * g) = (u32x2){pk2(acc[4 * g], acc[4 * g + 1]), pk2(acc[4 * g + 2], acc[4 * g + 3])};
            }
            __syncthreads();
            {
                bf16_t* op = O + (size_t)dir * ARR + s1_rowoff(it, sub, j8) + 16 * cg8;
                *(u32x4*)op = *(const LAS u32x4*)(QS + j8 * 136 + 16 * cg8); *(u32x4*)(op + 8) = *(const LAS u32x4*)(QS + j8 * 136 + 16 * cg8 + 8);
            }
        }
    }
}
DI void phase_lnstats(const bf16_t* GV, f32x2* STATS, int G) {
    const int tid_ = opaque_tid(); const int lane = tid_ & 63, wave = __builtin_amdgcn_readfirstlane(tid_ >> 6);
    const int gw = blockIdx.x * 8 + wave, NGW = G * 8;
    for (int m = gw; m < MH; m += NGW) {
        const bf16_t* p = GV + (size_t)m * D + 16 * lane;
        const u32x4 a0 = *(const u32x4*)p, a1 = *(const u32x4*)(p + 8);
        const unsigned aw[8] = {a0.x, a0.y, a0.z, a0.w, a1.x, a1.y, a1.z, a1.w};
        float s1 = 0.f, s2 = 0.f;
#pragma unroll
        for (int w = 0; w < 8; ++w) { const float x0 = bflo(aw[w]), x1 = bfhi(aw[w]); s1 += x0 + x1; s2 += x0 * x0 + x1 * x1; }
        s1 = wave_sum(s1); s2 = wave_sum(s2);
        const float mean = s1 * (1.0f / D), var = fmaxf(s2 * (1.0f / D) - mean * mean, 0.f);
        if (lane == 0) STATS[m] = (f32x2){mean, rsqrtf(var + 1e-5f)};
    }
}
DI void phase_s2(bf16_t* X, const float* AC, int G) {
    const int tid = opaque_tid();
    for (int gid = blockIdx.x * 512 + tid; gid < 64 * 2048; gid += G * 512) {
        const int seq = gid >> 11, e = gid & 2047, d0 = (e & 15) * 8, dir = seq & 1;
        bf16_t* xp = X + (size_t)seq * 32 * 16384 + (size_t)(e >> 4) * 128 + d0;
        const float* ap = AC + (size_t)seq * 32 * 128 + d0;
        float S[8];
#pragma unroll
        for (int i = 0; i < 8; ++i) S[i] = 0.f;
        for (int st = 0; st < 32; st += 4) {
            u32x4 dv[4]; f32x4 a0[4], a1[4];
#pragma unroll
            for (int u = 0; u < 4; ++u) { const int c = dir ? 31 - (st + u) : st + u; dv[u] = *(const u32x4*)(xp + (size_t)c * 16384); a0[u] = *(const f32x4*)(ap + c * 128); a1[u] = *(const f32x4*)(ap + c * 128 + 4); }
#pragma unroll
            for (int u = 0; u < 4; ++u) { const int c = dir ? 31 - (st + u) : st + u;
                *(u32x4*)(xp + (size_t)c * 16384) = (u32x4){pk2(S[0], S[1]), pk2(S[2], S[3]), pk2(S[4], S[5]), pk2(S[6], S[7])};
                S[0] = a0[u].x * S[0] + bflo(dv[u].x); S[1] = a0[u].y * S[1] + bfhi(dv[u].x); S[2] = a0[u].z * S[2] + bflo(dv[u].y); S[3] = a0[u].w * S[3] + bfhi(dv[u].y);
                S[4] = a1[u].x * S[4] + bflo(dv[u].z); S[5] = a1[u].y * S[5] + bfhi(dv[u].z); S[6] = a1[u].z * S[6] + bflo(dv[u].w); S[7] = a1[u].w * S[7] + bfhi(dv[u].w); }
        }
    }
}
struct S3Regs { u32x4 x[8], q[8]; };
DI void s3_load(S3Regs& R, const bf16_t* QH, const bf16_t* X, int it, int dir, int ts, int vt, int lane) {
    const int c = it & 63, h = (it >> 6) & 7, b = it >> 9;
    const bf16_t* xp = X + ((size_t)((b * 8 + h) * 2 + dir) * 32 + (c >> 1)) * 16384 + (size_t)(32 * vt) * 128 + 8 * lane;
    const bf16_t* qp = QH + (size_t)dir * ARR + ((size_t)b * SEQ + c * 64 + 32 * ts + (lane >> 4)) * D + h * 128 + 8 * (lane & 15);
#pragma unroll
    for (int k = 0; k < 8; ++k) { R.x[k] = *(const u32x4*)(xp + 512 * k); R.q[k] = *(const u32x4*)(qp + (size_t)(4 * k) * D); }
}
DI void phase_s3(LAS unsigned char* lds, const bf16_t* QH, const bf16_t* O, const bf16_t* X, const bf16_t* SGA, const float* gw_, bf16_t* YA, int G) {
    const int tid = opaque_tid(), lane = tid & 63, wave = __builtin_amdgcn_readfirstlane(tid >> 6);
    const int r = lane & 31, hh = lane >> 5, ts = wave >> 2, vt = wave & 3;
    LAS bf16_t* XW = (LAS bf16_t*)(lds + wave * 17408);
    LAS bf16_t* QW = XW + 32 * 136;
    LAS float* SS = (LAS float*)(lds + 8 * 17408);
    S3Regs R;
    int it = blockIdx.x;
    if (it < 2048) s3_load(R, QH, X, it, 0, ts, vt, lane);
    __syncthreads();
    for (; it < 2048; it += G) {
        const int c = it & 63, h = (it >> 6) & 7, b = it >> 9;
        const size_t row = (size_t)b * SEQ + c * 64 + 32 * ts + r;
        const size_t ooff = row * D + h * 128 + 32 * vt + 4 * hh;
        u32x2 ef[4], eb[4], es[4];
        f32x16 acc;
#pragma unroll
        for (int i = 0; i < 16; ++i) acc[i] = 0.f;
#pragma unroll
        for (int dir = 0; dir < 2; ++dir) {
#pragma unroll
            for (int k = 0; k < 8; ++k) { const int id = 64 * k + lane; *(LAS u32x4*)(XW + (id >> 4) * 136 + 8 * (id & 15)) = R.x[k]; *(LAS u32x4*)(QW + (id >> 4) * 136 + 8 * (id & 15)) = R.q[k]; }
            asm volatile("" ::: "memory");
            if (dir == 0) { s3_load(R, QH, X, it, 1, ts, vt, lane);
#pragma unroll
                for (int g = 0; g < 4; ++g) { ef[g] = *(const u32x2*)(O + ooff + 8 * g); eb[g] = *(const u32x2*)(O + ARR + ooff + 8 * g); es[g] = *(const u32x2*)(SGA + ooff + 8 * g); } }
            else if (it + G < 2048) s3_load(R, QH, X, it + G, 0, ts, vt, lane);
#pragma unroll
            for (int ks = 0; ks < 8; ++ks) { const bf16x8 a = *(const LAS bf16x8*)(XW + r * 136 + 16 * ks + 8 * hh), bb = *(const LAS bf16x8*)(QW + r * 136 + 16 * ks + 8 * hh); acc = MFMA32(a, bb, acc); }
        }
        float o[16]; float ss = 0.f;
#pragma unroll
        for (int g = 0; g < 4; ++g) { const u32x2 f = ef[g], bk = eb[g];
            o[4 * g] = acc[4 * g] + bflo(f.x) + bflo(bk.x); o[4 * g + 1] = acc[4 * g + 1] + bfhi(f.x) + bfhi(bk.x); o[4 * g + 2] = acc[4 * g + 2] + bflo(f.y) + bflo(bk.y); o[4 * g + 3] = acc[4 * g + 3] + bfhi(f.y) + bfhi(bk.y); }
#pragma unroll
        for (int i = 0; i < 16; ++i) ss += o[i] * o[i];
        ss += __shfl_xor(ss, 32);
        __syncthreads();
        if (hh == 0) SS[(32 * ts + r) * 4 + vt] = ss;
        __syncthreads();
        const f32x4 s4 = *(const LAS f32x4*)(SS + (32 * ts + r) * 4);
        const float rstd = rsqrtf((s4.x + s4.y + s4.z + s4.w) * (1.0f / 128.0f) + 1e-6f);
#pragma unroll
        for (int g = 0; g < 4; ++g) { const u32x2 sg = es[g]; const f32x4 gv = *(const f32x4*)(gw_ + 32 * vt + 8 * g + 4 * hh);
            *(u32x2*)(YA + ooff + 8 * g) = (u32x2){pk2(o[4 * g] * rstd * gv.x * bflo(sg.x), o[4 * g + 1] * rstd * gv.y * bfhi(sg.x)), pk2(o[4 * g + 2] * rstd * gv.z * bflo(sg.y), o[4 * g + 3] * rstd * gv.w * bfhi(sg.y))}; }
    }
}

DI void phase_spatial(LAS unsigned char* lds, const bf16_t* GV, bf16_t* UG, const f32x2* STATS, const float* ln_w, const float* ln_b, const float* w_s, const float* b_s, int G) {
    const int tid = opaque_tid(), lane = tid & 63, wave = __builtin_amdgcn_readfirstlane(tid >> 6);
    const int r = lane & 31, hh = lane >> 5;
    LAS bf16_t* VL = (LAS bf16_t*)(lds);
    LAS bf16_t* WS = (LAS bf16_t*)(lds + 34816);
    for (int it = blockIdx.x; it < 1024; it += G) {
        const int g = it & 7, n = (it >> 3) & 31, b = it >> 8;
        const size_t rowbase = (size_t)b * SEQ + (size_t)n * 128;
        __syncthreads();
        {
            const int s = tid >> 2, cq = tid & 3; const f32x2 st = STATS[rowbase + s];
            const bf16_t* p = GV + (rowbase + s) * D + 128 * g + 32 * cq;
#pragma unroll
            for (int q = 0; q < 4; ++q) { const u32x4 a = *(const u32x4*)(p + 8 * q); const unsigned aw[4] = {a.x, a.y, a.z, a.w};
                const f32x4 w0 = *(const f32x4*)(ln_w + 128 * g + 32 * cq + 8 * q), w1 = *(const f32x4*)(ln_w + 128 * g + 32 * cq + 8 * q + 4);
                const f32x4 c0 = *(const f32x4*)(ln_b + 128 * g + 32 * cq + 8 * q), c1 = *(const f32x4*)(ln_b + 128 * g + 32 * cq + 8 * q + 4);
                const float wv[8] = {w0.x, w0.y, w0.z, w0.w, w1.x, w1.y, w1.z, w1.w}, bv[8] = {c0.x, c0.y, c0.z, c0.w, c1.x, c1.y, c1.z, c1.w};
#pragma unroll
                for (int w = 0; w < 4; ++w) { const float y0 = (bflo(aw[w]) - st.x) * st.y * wv[2 * w] + bv[2 * w], y1 = (bfhi(aw[w]) - st.x) * st.y * wv[2 * w + 1] + bv[2 * w + 1];
                    const unsigned pk = pk2(y0, y1); const int cc = 32 * cq + 8 * q + 2 * w;
                    VL[cc * 136 + s] = (bf16_t)(pk & 0xffffu); VL[(cc + 1) * 136 + s] = (bf16_t)(pk >> 16); } }
            const int t = tid >> 2, sq = tid & 3; const float* wp = w_s + ((size_t)g * 128 + t) * 128 + 32 * sq;
#pragma unroll
            for (int q = 0; q < 4; ++q) { const f32x4 x0 = *(const f32x4*)(wp + 8 * q), x1 = *(const f32x4*)(wp + 8 * q + 4);
                *(LAS u32x4*)(WS + t * 136 + 32 * sq + 8 * q) = (u32x4){pk2(x0.x, x0.y), pk2(x0.z, x0.w), pk2(x1.x, x1.y), pk2(x1.z, x1.w)}; }
        }
        __syncthreads();
        {
            const int cm = wave & 3;
#pragma unroll
            for (int tt = 0; tt < 2; ++tt) {
                const int tn = 2 * (wave >> 2) + tt;
                f32x16 acc;
#pragma unroll
                for (int i = 0; i < 16; ++i) acc[i] = 0.f;
#pragma unroll
                for (int ks = 0; ks < 8; ++ks) { const bf16x8 a = *(const LAS bf16x8*)(VL + (32 * cm + r) * 136 + 16 * ks + 8 * hh), bb = *(const LAS bf16x8*)(WS + (32 * tn + r) * 136 + 16 * ks + 8 * hh); acc = MFMA32(a, bb, acc); }
                const int t = 32 * tn + r; const float bias = b_s[g * 128 + t];
                bf16_t* up = UG + (rowbase + t) * D + 128 * g + 32 * cm + 4 * hh;
#pragma unroll
                for (int q = 0; q < 4; ++q) { const u32x2 uw = *(const u32x2*)(up + 8 * q);
                    *(u32x2*)(up + 8 * q) = (u32x2){pk2(bflo(uw.x) * (acc[4 * q] + bias), bfhi(uw.x) * (acc[4 * q + 1] + bias)), pk2(bflo(uw.y) * (acc[4 * q + 2] + bias), bfhi(uw.y) * (acc[4 * q + 3] + bias))}; }
            }
        }
    }
}

struct Args { const float* in[13]; float* out; unsigned char* ws; int ph_lo, ph_hi; };
constexpr int NPH = 4 * 13 + 1;

__global__ void __launch_bounds__(512, 2) mega(Args a) {
    extern __shared__ __attribute__((aligned(16))) unsigned char shm[];
    LAS unsigned char* lds = (LAS unsigned char*)shm;
    cg::grid_group grid = cg::this_grid();
    const int G = gridDim.x, blk = blockIdx.x;
    unsigned char* ws = a.ws;
    const float* x0 = a.in[0];
    bf16_t* Hb = (bf16_t*)(ws + WS_H); bf16_t* out9 = (bf16_t*)(ws + WS_OUT9);
    bf16_t* Qb = out9, *ZFb = out9 + ARR, *Ib = out9 + 3 * ARR, *SGAb = out9 + 4 * ARR, *UGb = out9 + 5 * ARR, *GVb = out9 + 6 * ARR, *SMAb = out9 + 7 * ARR, *SMBb = out9 + 8 * ARR;
    bf16_t* OFb = (bf16_t*)(ws + WS_OF); bf16_t* Xb = (bf16_t*)(ws + WS_X); float* ACb = (float*)(ws + WS_AC); f32x2* STb = (f32x2*)(ws + WS_ST);
    bf16_t* MGb = Qb;
    volatile LAS unsigned* bst = (volatile LAS unsigned*)(lds + LDS_BYTES - 16);
    if (threadIdx.x < 4) bst[threadIdx.x] = 0u;
    if (blk == 0) for (int i = threadIdx.x; i < XCD_BAR_WORDS; i += 512) ((unsigned*)ws)[i] = 0u;
    __syncthreads();
    XcdBarrier xb; xb.bar = (unsigned*)ws; xb.x = 0; xb.st = bst;
    for (int ph = a.ph_lo; ph < a.ph_hi; ++ph) {
        if (ph == a.ph_lo + 1) { grid.sync(); xb = xcd_barrier_post((unsigned*)ws, bst); }
        else if (ph > a.ph_lo + 1) xcd_barrier(xb);
        if (ph == NPH - 1) { phase_final(a.out, a.in[12], M_ALL, G); continue; }
        const int l = ph / 13, rr = ph % 13;
        const float* xin = (l == 0) ? x0 : a.out;
        if (rr == 0) {
            phase_prep(lds, a.in[2] + (size_t)l * D * NIN, a.in[9] + (size_t)l * D * D, a.in[10] + (size_t)l * D * D, a.in[11] + (size_t)l * D * D, ws, G);
            phase_rms_bf16(xin, a.in[1] + l * D, Hb, M_ALL, G);
            if (blk == 0) {
                float* LBT = (float*)(ws + WS_LBT);
                for (int i = threadIdx.x; i < 2048; i += 512) { const float* lp = a.in[3] + i;
                    const float v0 = lp[0], v1 = lp[2048], v2 = lp[4096], v3 = lp[6144], mx = fmaxf(fmaxf(v0, v1), fmaxf(v2, v3));
                    const float e0 = __expf(v0 - mx), e1 = __expf(v1 - mx), e2 = __expf(v2 - mx), e3 = __expf(v3 - mx);
                    float lb = 0.f; if (l >= 1) lb += e1; if (l >= 2) lb += e2; if (l >= 3) lb += e3;
                    lb = lb / (e0 + e1 + e2 + e3);
                    LBT[(i >> 10) * 2048 + (i & 1023)] = fmaxf(lb, 1e-20f); LBT[(i >> 10) * 2048 + 1024 + (i & 1023)] = 1.0f - lb; }
            }
            continue;
        }
        const int hf = (rr - 1) / 6, k = (rr - 1) % 6;
        bf16_t* Hh = Hb + (size_t)hf * ARR;
        if (k == 0) {
            pg8::Gemm g{Hh, Hh, (const bf16_t*)(ws + WS_WIN), (const bf16_t*)(ws + WS_WIN), D};
            pg8::Order S; S.init(MH, NIN, G, blk, 0);
            EpiInProj E{out9};
            pg8::gemm_phase<EpiInProj>(lds, g, S, E);
        } else if (k == 1) {
            phase_lnstats(GVb, STb, G);
            phase_s1(lds, Qb, ZFb, Ib, OFb, Xb, ACb, (const float*)(ws + WS_LBT), G);
        } else if (k == 2) {
            if (blk & 1) phase_s2(Xb, ACb, G);
            phase_spatial(lds, GVb, UGb, STb, a.in[5] + l * D, a.in[6] + l * D, a.in[7] + (size_t)l * 8 * 128 * 128, a.in[8] + l * 8 * 128, G);
            if (!(blk & 1)) phase_s2(Xb, ACb, G);
        } else if (k == 3) {
            phase_s3(lds, ZFb, OFb, Xb, SGAb, a.in[4] + l * 128, Hh, G);
        } else if (k == 4) {
            pg8::Gemm g{Hh, UGb, (const bf16_t*)(ws + WS_WA), (const bf16_t*)(ws + WS_WB), D};
            pg8::Order S; S.init(MH, D, G, blk, 1);
            EpiProjAB E{SMAb, SMBb, MGb};
            pg8::gemm_phase<EpiProjAB>(lds, g, S, E);
        } else {
            pg8::Gemm g{MGb, MGb, (const bf16_t*)(ws + WS_WO), (const bf16_t*)(ws + WS_WO), D};
            pg8::Order S; S.init(MH, D, G, blk, 0);
            EpiResid E{xin + (size_t)hf * ARR, a.out + (size_t)hf * ARR};
            pg8::gemm_phase<EpiResid>(lds, g, S, E);
        }
    }
}


extern "C" void kernel_launch(void* const* d_in, const int* in_sizes, int n_in, void* d_out, int out_size, void* d_ws, size_t ws_size, hipStream_t stream) {
    static int grid = 0;
    if (grid == 0) {
        if (n_in != 13 || ws_size < WS_END) { fprintf(stderr, "kernel_launch: unexpected inputs (n_in %d, ws %zu, need %zu)\n", n_in, ws_size, (size_t)WS_END); grid = -1; return; }
        int dev = 0, cus = 0, per_cu = 0;
        hipGetDevice(&dev); hipDeviceGetAttribute(&cus, hipDeviceAttributeMultiprocessorCount, dev);
        if (hipFuncSetAttribute((const void*)mega, hipFuncAttributeMaxDynamicSharedMemorySize, LDS_BYTES) != hipSuccess) { fprintf(stderr, "kernel_launch: hipFuncSetAttribute failed\n"); grid = -1; return; }
        if (hipOccupancyMaxActiveBlocksPerMultiprocessor(&per_cu, (const void*)mega, 512, LDS_BYTES) != hipSuccess || per_cu < 1) { fprintf(stderr, "kernel_launch: occupancy query gave %d\n", per_cu); per_cu = 1; }
        (void)hipGetLastError();
        grid = cus * 1;
        fprintf(stderr, "kernel_launch: cus %d per_cu %d grid %d\n", cus, per_cu, grid);
    }
    if (grid < 0) return;
    Args a{};
    for (int i = 0; i < 13; ++i) a.in[i] = (const float*)d_in[i];
    a.out = (float*)d_out; a.ws = (unsigned char*)d_ws; a.ph_lo = 0; a.ph_hi = NPH;
    void* args[] = {&a};
    hipError_t e = hipLaunchCooperativeKernel((const void*)mega, dim3(grid), dim3(512), args, LDS_BYTES, stream);
    if (e != hipSuccess) fprintf(stderr, "kernel_launch: cooperative launch failed: %s (grid %d)\n", hipGetErrorString(e), grid);
}
```

```cpp
#include <hip/hip_runtime.h>
#include <hip/hip_cooperative_groups.h>
#include <cstdio>
namespace cg = cooperative_groups;

#define LAS __attribute__((address_space(3)))
#define DI __device__ __forceinline__
typedef unsigned short bf16_t;
typedef short bf16x8 __attribute__((ext_vector_type(8)));
typedef float f32x4 __attribute__((ext_vector_type(4)));
typedef float f32x2 __attribute__((ext_vector_type(2)));
typedef float f32x16 __attribute__((ext_vector_type(16)));
typedef unsigned u32x4 __attribute__((ext_vector_type(4)));
typedef unsigned u32x2 __attribute__((ext_vector_type(2)));
typedef __bf16 bf16v2 __attribute__((ext_vector_type(2)));

constexpr int D = 1024, SEQ = 4096, MH = 16384, M_ALL = 32768, DEPTH = 4, NIN = 10240;
constexpr int LDS_BYTES = 163840;
constexpr float LOG2E = 1.4426950408889634f;
constexpr size_t ARR = (size_t)MH * D;

constexpr size_t WS_WIN = 1ull << 20;
constexpr size_t WS_WA = WS_WIN + (size_t)NIN * D * 2;
constexpr size_t WS_WB = WS_WA + (size_t)D * D * 2;
constexpr size_t WS_WO = WS_WB + (size_t)D * D * 2;
constexpr size_t WS_H = WS_WO + (size_t)D * D * 2;
constexpr size_t WS_OUT9 = WS_H + (size_t)M_ALL * D * 2;
constexpr size_t WS_G3 = WS_OUT9 + 6 * ARR * 2;
constexpr size_t WS_OF = WS_G3 + 6 * ARR * 2;
constexpr size_t WS_X = WS_OF + 2 * ARR * 2;
constexpr size_t WS_AC = WS_X + (size_t)64 * 32 * 16384 * 2;
constexpr size_t WS_ST = WS_AC + (size_t)64 * 32 * 128 * 4;
constexpr size_t WS_LBT = WS_ST + (size_t)MH * 8;
constexpr size_t WS_END = WS_LBT + 4096 * 4;

DI unsigned pk2(float lo, float hi) { f32x2 v = {lo, hi}; bf16v2 r = __builtin_convertvector(v, bf16v2); return __builtin_bit_cast(unsigned, r); }
DI float bflo(unsigned w) { return __uint_as_float(w << 16); }
DI float bfhi(unsigned w) { return __uint_as_float(w & 0xffff0000u); }
DI float fexp2(float x) { return __builtin_amdgcn_exp2f(x); }
DI float frcp(float x) { return __builtin_amdgcn_rcpf(x); }
DI float sigmoidf_(float x) { return frcp(1.0f + fexp2(-x * LOG2E)); }
DI float siluf_(float x) { return x * sigmoidf_(x); }
DI float geluf_(float x) { const float t = x + 0.044715f * x * x * x; return x * frcp(1.0f + fexp2(-2.3022082f * t)); }
DI float wave_sum(float v) {
#pragma unroll
    for (int o = 1; o < 64; o <<= 1) v += __shfl_xor(v, o);
    return v;
}
#define LDS_WAIT() asm volatile("s_waitcnt lgkmcnt(0)" ::: "memory")
template <int CTRL, int ROWMASK, bool BC> DI float dpp_f(float x) { return __int_as_float(__builtin_amdgcn_update_dpp(0, __float_as_int(x), CTRL, ROWMASK, 0xf, BC)); }
DI int opaque_tid() { int t = threadIdx.x; asm volatile("" : "+v"(t)); return t; }


#define XB_TMO      128
#define XB_XCNT(j)  (256  + 64 * (j))
#define XB_XSUB(j)  (1280 + 64 * (j))
#define XB_XGEN(j)  (2304 + 64 * (j))
#define XB_TOP      3328
#define XB_TOPGEN   3392
#define XCD_BAR_WORDS 3456
#define XB_SPIN_CAP (1u << 18)
DI unsigned xb_ld(unsigned* p)              { return __hip_atomic_load(p, __ATOMIC_RELAXED, __HIP_MEMORY_SCOPE_AGENT); }
DI unsigned xb_add(unsigned* p, unsigned v) { return __hip_atomic_fetch_add(p, v, __ATOMIC_RELAXED, __HIP_MEMORY_SCOPE_AGENT); }
DI unsigned xb_xcc_id() { return (unsigned)__builtin_amdgcn_s_getreg((3 << 11) | 20) & 0xFu; }
#define XB_SPIN(cond, bar) do { unsigned _sp = 0; while (cond) { __builtin_amdgcn_s_sleep(1); \
    if ((++_sp & 255u) == 0u) { if (xb_ld(&(bar)[XB_TMO])) break; if (_sp > XB_SPIN_CAP) { atomicAdd(&(bar)[XB_TMO], 1u); break; } } } } while (0)
struct XcdBarrier { unsigned* bar; unsigned x; volatile LAS unsigned* st; };
DI XcdBarrier xcd_barrier_post(unsigned* bar, volatile LAS unsigned* st) {
    XcdBarrier b; b.bar = bar; b.x = xb_xcc_id(); b.st = st;
    if (threadIdx.x == 0) (void)xb_add(&bar[XB_XCNT(b.x)], 1u);
    return b;
}
DI void xcd_barrier_complete(unsigned* bar, unsigned x, unsigned& nloc, unsigned& nx) {
    const unsigned G = gridDim.x * gridDim.y * gridDim.z;
    unsigned sum, cnt, mine, sp = 0u;
    for (;;) {
        sum = 0u; cnt = 0u; mine = 0u;
#pragma unroll
        for (unsigned j = 0; j < 16; ++j) { const unsigned c = xb_ld(&bar[XB_XCNT(j)]); sum += c; cnt += (c > 0u) ? 1u : 0u; mine = (j == x) ? c : mine; }
        if (sum == G) break;
        __builtin_amdgcn_s_sleep(1);
        if ((++sp & 255u) == 0u) { if (xb_ld(&bar[XB_TMO])) break; if (sp > XB_SPIN_CAP) { atomicAdd(&bar[XB_TMO], 1u); break; } }
    }
    nloc = mine > 0u ? mine : 1u; nx = cnt > 0u ? cnt : 1u;
}
DI void xcd_barrier(const XcdBarrier& b) {
    asm volatile("s_waitcnt vmcnt(0)" ::: "memory");
    __syncthreads();
    if (threadIdx.x == 0) {
        unsigned* bar = b.bar;
        __builtin_amdgcn_s_waitcnt(0);
        unsigned nloc = b.st[0], nx = b.st[1];
        if (nloc == 0u) { xcd_barrier_complete(bar, b.x, nloc, nx); b.st[0] = nloc; b.st[1] = nx; }
        const unsigned old = xb_add(&bar[XB_XSUB(b.x)], 1u);
        const unsigned gen = old / nloc;
        if (old + 1u == (gen + 1u) * nloc) {
            __builtin_amdgcn_fence(__ATOMIC_RELEASE, "agent");
            asm volatile("s_waitcnt vmcnt(0)" ::: "memory");
            const unsigned og = xb_add(&bar[XB_TOP], 1u);
            const unsigned tg = og / nx;
            if (og + 1u == (tg + 1u) * nx) xb_add(&bar[XB_TOPGEN], 1u);
            else XB_SPIN(xb_ld(&bar[XB_TOPGEN]) == tg, bar);
            __builtin_amdgcn_fence(__ATOMIC_ACQUIRE, "agent");
            xb_add(&bar[XB_XGEN(b.x)], 1u);
            asm volatile("s_waitcnt vmcnt(0)" ::: "memory");
        } else {
            XB_SPIN(xb_ld(&bar[XB_XGEN(b.x)]) == gen, bar);
            __builtin_amdgcn_fence(__ATOMIC_ACQUIRE, "agent");
            asm volatile("s_waitcnt vmcnt(0)" ::: "memory");
        }
    }
    __syncthreads();
}

namespace pg8 {
constexpr int BM = 256, BK = 64, HALF = 128, HTB = HALF * BK * 2, STAGE_BYTES = 8 * HTB, NXCD = 8, WGM = 8;
DI int lds_byte(int r, int c) { const int st = (r >> 4) * 2 + (c >> 5), rr = r & 15, cc = c & 31, ob = rr * 64 + cc * 2; return st * 1024 + (ob ^ (((ob >> 9) & 1) << 5)); }
DI void stage_rc(int b, int& R, int& C) { const int st = b / 1024, sb = b % 1024, swz = sb ^ (((sb >> 9) & 1) << 5); R = (st >> 1) * 16 + swz / 64; C = (st & 1) * 32 + (swz % 64) / 2; }
DI int perm32(int rho) { const int n = rho >> 4, i = rho & 15; return 8 * (i >> 2) + 4 * n + (i & 3); }

struct Unit { int pm, pn, sel; };
struct Gemm { const bf16_t* A0; const bf16_t* A1; const bf16_t* B0; const bf16_t* B1; int K; };
struct Order {
    int nM, nN, nwg, G, c, dual;
    DI void init(int M, int N, int G_, int c_, int dual_) { nM = M / BM; nN = N / BM; nwg = nM * nN; G = G_; c = c_; dual = dual_; }
    DI bool next(int i, Unit& u) const {
        const int ti = dual ? (i >> 1) : i; u.sel = dual ? (i & 1) : 0;
        const long L = (long)ti * G + c; if (L >= nwg) return false;
        int wgid = (int)L; { const int q = nwg / NXCD, r = nwg % NXCD, xcd = wgid % NXCD, off = wgid / NXCD; wgid = (xcd < r ? xcd * (q + 1) : r * (q + 1) + (xcd - r) * q) + off; }
        const int nig = WGM * nN, gid = wgid / nig, fm = gid * WGM, gsz = (nM - fm) < WGM ? (nM - fm) : WGM;
        u.pm = fm + ((wgid % nig) % gsz); u.pn = (wgid % nig) / gsz; return true;
    }
};

template <class Epi>
DI void gemm_phase(LAS unsigned char* lds, const Gemm g, const Order& S, const Epi& E) {
    const int tid = opaque_tid(), wid = __builtin_amdgcn_readfirstlane(tid >> 6), lane = tid & 63, wr = wid >> 2, wc = wid & 3, fr = lane & 15, fq = lane >> 4;
    const int K = g.K, nt = K / BK;
    unsigned voffA[2], voffB[2];
#pragma unroll
    for (int i = 0; i < 2; ++i) { int R, C; stage_rc(tid * 16 + i * 8192, R, C); const int Rb = Epi::PERM ? ((R & ~31) + perm32(R & 31)) : R;
        voffA[i] = (unsigned)(R * K + C) * 2u; voffB[i] = (unsigned)(Rb * K + C) * 2u; }
    const size_t kstep = (size_t)(BK * 2);
    const size_t hstep = (size_t)HALF * K * 2;
    const size_t tstep = 2 * hstep;
    const unsigned ldsw = (unsigned)wid * 1024u;
    const int aoff = lds_byte(wr * 64 + fr, fq * 8), boff = lds_byte(wc * 32 + fr, fq * 8);
#define PG8_SA(b, h) (((b) * 2 + (h)) * HTB)
#define PG8_SB(b, h) ((4 + (b) * 2 + (h)) * HTB)
#define PG8_STAGE(bufoff, gbase, voff) do { _Pragma("unroll") for (int _i = 0; _i < 2; ++_i) \
        __builtin_amdgcn_global_load_lds((const unsigned*)((const char*)(gbase) + (voff)[_i]), (LAS unsigned*)(lds + (bufoff) + ldsw + _i * 8192), 16, 0, 0); } while (0)
#define PG8_LDA(dst, b, h) do { _Pragma("unroll") for (int m = 0; m < 4; ++m) _Pragma("unroll") for (int k = 0; k < 2; ++k) dst[m][k] = *(const LAS bf16x8*)(lds + PG8_SA(b, h) + aoff + m * 2048 + k * 1024); } while (0)
#define PG8_LDB(dst, b, h) do { _Pragma("unroll") for (int n = 0; n < 2; ++n) _Pragma("unroll") for (int k = 0; k < 2; ++k) dst[n][k] = *(const LAS bf16x8*)(lds + PG8_SB(b, h) + boff + n * 2048 + k * 1024); } while (0)
#define PG8_MMA(ai, bj, At, Bt) do { __builtin_amdgcn_s_setprio(1); _Pragma("unroll") for (int m = 0; m < 4; ++m) _Pragma("unroll") for (int n = 0; n < 2; ++n) _Pragma("unroll") for (int k = 0; k < 2; ++k) \
        acc[ai][bj][m][n] = __builtin_amdgcn_mfma_f32_16x16x32_bf16(Bt[n][k], At[m][k], acc[ai][bj][m][n], 0, 0, 0); __builtin_amdgcn_s_setprio(0); } while (0)
#define PG8_WAIT_V(n) asm volatile("s_waitcnt vmcnt(" #n ")" ::: "memory")
#define PG8_WAIT_L(n) asm volatile("s_waitcnt lgkmcnt(" #n ")" ::: "memory")
#define PG8_BAR __builtin_amdgcn_s_barrier()
#define PG8_SCHED __builtin_amdgcn_sched_barrier(0)
    Unit cur, nxt; int ui = 0;
    if (!S.next(0, cur)) return;
    f32x4 acc[2][2][4][2];
#pragma unroll
    for (int a = 0; a < 2; ++a)
#pragma unroll
        for (int b = 0; b < 2; ++b)
#pragma unroll
            for (int m = 0; m < 4; ++m)
#pragma unroll
                for (int n = 0; n < 2; ++n) acc[a][b][m][n] = (f32x4){0.f, 0.f, 0.f, 0.f};
    bf16x8 At[4][2], B0[2][2], B1[2][2];
    const char* cA = (const char*)(cur.sel ? g.A1 : g.A0) + (size_t)cur.pm * tstep; const char* cB = (const char*)(cur.sel ? g.B1 : g.B0) + (size_t)cur.pn * tstep;
    PG8_STAGE(PG8_SB(0, 0), cB, voffB); PG8_STAGE(PG8_SB(0, 1), cB + hstep, voffB); PG8_STAGE(PG8_SA(0, 0), cA, voffA); PG8_STAGE(PG8_SA(0, 1), cA + hstep, voffA);
    if (wr == 1) PG8_BAR;
    PG8_WAIT_V(2); PG8_BAR;
    PG8_STAGE(PG8_SB(1, 0), cB + kstep, voffB); PG8_STAGE(PG8_SA(1, 0), cA + kstep, voffA); PG8_STAGE(PG8_SB(1, 1), cB + hstep + kstep, voffB);
    PG8_WAIT_V(6); PG8_BAR;
    for (;;) {
        const bool has_next = S.next(ui + 1, nxt);
        const char* nA = has_next ? (const char*)(nxt.sel ? g.A1 : g.A0) + (size_t)nxt.pm * tstep : cA; const char* nB = has_next ? (const char*)(nxt.sel ? g.B1 : g.B0) + (size_t)nxt.pn * tstep : cB;
        for (int t = 0; t < nt; t += 2) {
            const bool last = (t == nt - 2);
            const char* a1 = cA + (size_t)(t + 1) * kstep;
            const char* a2 = last ? nA : cA + (size_t)(t + 2) * kstep; const char* b2 = last ? nB : cB + (size_t)(t + 2) * kstep;
            const char* a3 = a2 + kstep; const char* b3 = b2 + kstep;
            PG8_LDB(B0, 0, 0); PG8_LDB(B1, 0, 1); PG8_SCHED; PG8_LDA(At, 0, 0); PG8_STAGE(PG8_SA(1, 1), a1 + hstep, voffA);
            PG8_WAIT_V(8); PG8_WAIT_L(0); PG8_BAR; PG8_MMA(0, 0, At, B0); PG8_MMA(0, 1, At, B1); PG8_BAR; PG8_SCHED;
            PG8_LDA(At, 0, 1); PG8_STAGE(PG8_SB(0, 0), b2, voffB); PG8_STAGE(PG8_SB(0, 1), b2 + hstep, voffB); PG8_STAGE(PG8_SA(0, 0), a2, voffA);
            PG8_WAIT_V(8); PG8_WAIT_L(0); PG8_BAR; PG8_MMA(1, 0, At, B0); PG8_MMA(1, 1, At, B1); PG8_BAR; PG8_SCHED;
            PG8_LDB(B0, 1, 0); PG8_LDB(B1, 1, 1); PG8_SCHED; PG8_LDA(At, 1, 0); PG8_STAGE(PG8_SA(0, 1), a2 + hstep, voffA);
            PG8_WAIT_V(8); PG8_WAIT_L(0); PG8_BAR; PG8_MMA(0, 0, At, B0); PG8_MMA(0, 1, At, B1); PG8_BAR; PG8_SCHED;
            PG8_LDA(At, 1, 1); PG8_STAGE(PG8_SB(1, 0), b3, voffB); PG8_STAGE(PG8_SB(1, 1), b3 + hstep, voffB); PG8_STAGE(PG8_SA(1, 0), a3, voffA);
            PG8_WAIT_V(8); PG8_WAIT_L(0); PG8_BAR; PG8_MMA(1, 0, At, B0); PG8_MMA(1, 1, At, B1); PG8_BAR; PG8_SCHED;
        }
        if (wr == 0) PG8_BAR;
        E(acc, cur, wr, wc, fr, fq);
        if (!has_next) break;
#pragma unroll
        for (int a = 0; a < 2; ++a)
#pragma unroll
            for (int b = 0; b < 2; ++b)
#pragma unroll
                for (int m = 0; m < 4; ++m)
#pragma unroll
                    for (int n = 0; n < 2; ++n) acc[a][b][m][n] = (f32x4){0.f, 0.f, 0.f, 0.f};
        cur = nxt; cA = nA; cB = nB; ++ui;
        if (wr == 1) PG8_BAR;
    }
    PG8_WAIT_V(0);
    PG8_BAR;
#undef PG8_SA
#undef PG8_SB
#undef PG8_STAGE
#undef PG8_LDA
#undef PG8_LDB
#undef PG8_MMA
#undef PG8_WAIT_V
#undef PG8_WAIT_L
#undef PG8_BAR
#undef PG8_SCHED
}
}

template <int ACT> DI float act_fn(float x) {
    if (ACT == 0) return x;
    if (ACT == 1) return siluf_(x) * 0.08838834764831845f;
    if (ACT == 2) return siluf_(x);
    if (ACT == 3) return geluf_(x);
    return sigmoidf_(x);
}
template <int ACT> DI void store_act(const f32x4 (&acc)[2][2][4][2], bf16_t* base, int row0, int col0) {
#pragma unroll
    for (int ai = 0; ai < 2; ++ai)
#pragma unroll
        for (int m = 0; m < 4; ++m) { bf16_t* rowp = base + (size_t)(row0 + ai * 128 + m * 16) * D + col0;
#pragma unroll
            for (int bj = 0; bj < 2; ++bj) { const f32x4 v0 = acc[ai][bj][m][0], v1 = acc[ai][bj][m][1];
                u32x4 w; w.x = pk2(act_fn<ACT>(v0[0]), act_fn<ACT>(v0[1])); w.y = pk2(act_fn<ACT>(v0[2]), act_fn<ACT>(v0[3]));
                w.z = pk2(act_fn<ACT>(v1[0]), act_fn<ACT>(v1[1])); w.w = pk2(act_fn<ACT>(v1[2]), act_fn<ACT>(v1[3]));
                *(u32x4*)(rowp + bj * 128) = w; } }
}
struct EpiInProj {
    static constexpr bool PERM = true;
    bf16_t* out9; bf16_t* g3;
    DI void operator()(const f32x4 (&acc)[2][2][4][2], const pg8::Unit& u, int wr, int wc, int fr, int fq) const {
        const int pn = u.pn, row0 = u.pm * 256 + wr * 64 + fr, cl = wc * 32 + 8 * fq;
        if (pn >= 20 && pn < 28) {
            bf16_t* base = g3; const int col0 = 128 * (pn - 20) + cl;
#pragma unroll
            for (int ai = 0; ai < 2; ++ai)
#pragma unroll
                for (int m = 0; m < 4; ++m) { bf16_t* rowp = base + (size_t)(row0 + ai * 128 + m * 16) * D + col0;
                    const f32x4 u0 = acc[ai][0][m][0], u1 = acc[ai][0][m][1], g0 = acc[ai][1][m][0], g1 = acc[ai][1][m][1];
                    u32x4 w; w.x = pk2(geluf_(u0[0]) * siluf_(g0[0]), geluf_(u0[1]) * siluf_(g0[1])); w.y = pk2(geluf_(u0[2]) * siluf_(g0[2]), geluf_(u0[3]) * siluf_(g0[3]));
                    w.z = pk2(geluf_(u1[0]) * siluf_(g1[0]), geluf_(u1[1]) * siluf_(g1[1])); w.w = pk2(geluf_(u1[2]) * siluf_(g1[2]), geluf_(u1[3]) * siluf_(g1[3]));
                    *(u32x4*)rowp = w; }
            return;
        }
        int idx, ct;
        if (pn < 20) { idx = pn >> 2; ct = pn & 3; } else if (pn < 32) { idx = 6; ct = pn - 28; } else { idx = 7 + ((pn - 32) >> 2); ct = (pn - 32) & 3; }
        bf16_t* base = (idx <= 4) ? out9 + (size_t)idx * ARR : (idx == 6 ? out9 + 5 * ARR : g3 + (size_t)(idx - 6) * 2 * ARR); const int col0 = 256 * ct + cl;
        if (idx == 0) store_act<1>(acc, base, row0, col0);
        else if (idx <= 3) store_act<0>(acc, base, row0, col0);
        else if (idx == 4) store_act<2>(acc, base, row0, col0);
        else if (idx == 6) store_act<3>(acc, base, row0, col0);
        else store_act<4>(acc, base, row0, col0);
    }
};
struct EpiProjAB {
    static constexpr bool PERM = true;
    const bf16_t* SMA; const bf16_t* SMB; bf16_t* MG;
    DI void operator()(const f32x4 (&acc)[2][2][4][2], const pg8::Unit& u, int wr, int wc, int fr, int fq) const {
        const int row0 = u.pm * 256 + wr * 64 + fr, col0 = u.pn * 256 + wc * 32 + 8 * fq;
        const bf16_t* gate = u.sel ? SMB : SMA;
#pragma unroll
        for (int ai = 0; ai < 2; ++ai)
#pragma unroll
            for (int m = 0; m < 4; ++m) { const size_t off = (size_t)(row0 + ai * 128 + m * 16) * D + col0;
#pragma unroll
                for (int bj = 0; bj < 2; ++bj) { const f32x4 v0 = acc[ai][bj][m][0], v1 = acc[ai][bj][m][1];
                    const u32x4 gw = *(const u32x4*)(gate + off + bj * 128);
                    float o[8] = {v0[0] * bflo(gw.x), v0[1] * bfhi(gw.x), v0[2] * bflo(gw.y), v0[3] * bfhi(gw.y), v1[0] * bflo(gw.z), v1[1] * bfhi(gw.z), v1[2] * bflo(gw.w), v1[3] * bfhi(gw.w)};
                    if (u.sel) { const u32x4 tw = *(const u32x4*)(MG + off + bj * 128);
                        o[0] += bflo(tw.x); o[1] += bfhi(tw.x); o[2] += bflo(tw.y); o[3] += bfhi(tw.y); o[4] += bflo(tw.z); o[5] += bfhi(tw.z); o[6] += bflo(tw.w); o[7] += bfhi(tw.w); }
                    u32x4 w; w.x = pk2(o[0], o[1]); w.y = pk2(o[2], o[3]); w.z = pk2(o[4], o[5]); w.w = pk2(o[6], o[7]);
                    *(u32x4*)(MG + off + bj * 128) = w; }
                asm volatile("" ::: "memory"); }
    }
};
struct EpiResid {
    static constexpr bool PERM = false;
    const float* xin; float* out;
    DI void operator()(const f32x4 (&acc)[2][2][4][2], const pg8::Unit& u, int wr, int wc, int fr, int fq) const {
        const int row0 = u.pm * 256 + wr * 64 + fr, col0 = u.pn * 256 + wc * 32 + 4 * fq;
#pragma unroll
        for (int ai = 0; ai < 2; ++ai)
#pragma unroll
            for (int m = 0; m < 4; ++m) { const size_t off = (size_t)(row0 + ai * 128 + m * 16) * D + col0;
#pragma unroll
                for (int bj = 0; bj < 2; ++bj)
#pragma unroll
                    for (int n = 0; n < 2; ++n) { const f32x4 xv = *(const f32x4*)(xin + off + bj * 128 + n * 16); *(f32x4*)(out + off + bj * 128 + n * 16) = xv + acc[ai][bj][m][n]; }
                asm volatile("" ::: "memory"); }
    }
};

DI int src_col(int nv) {
    if (nv < 5120) return nv;
    if (nv < 7168) { const int t = (nv - 5120) >> 8, w = (nv - 5120) & 255; return w < 128 ? 5120 + 128 * t + w : 7168 + 128 * t + (w - 128); }
    if (nv < 8192) return 6144 + (nv - 7168);
    return nv;
}
DI void transpose_item(const float* W, int N, bf16_t* WT, int k0, int nsrc0, int nvirt0, LAS float* scr, int lane) {
#pragma unroll 8
    for (int i = 0; i < 32; ++i) { const int kk = 2 * i + (lane >> 5); scr[kk * 33 + (lane & 31)] = W[(size_t)(k0 + kk) * N + nsrc0 + (lane & 31)]; }
    LDS_WAIT();
    const int c = lane & 7;
#pragma unroll
    for (int j = 0; j < 4; ++j) { const int n = (lane >> 3) + 8 * j; const LAS float* s = scr + (8 * c) * 33 + n;
        u32x4 o; o.x = pk2(s[0 * 33], s[1 * 33]); o.y = pk2(s[2 * 33], s[3 * 33]); o.z = pk2(s[4 * 33], s[5 * 33]); o.w = pk2(s[6 * 33], s[7 * 33]);
        *(u32x4*)(WT + (size_t)(nvirt0 + n) * D + k0 + 8 * c) = o; }
    LDS_WAIT();
}
DI void phase_prep(LAS unsigned char* lds, const float* w_in, const float* wa, const float* wb, const float* wo, unsigned char* ws, int G) {
    const int tid_ = opaque_tid(); const int lane = tid_ & 63, wave = __builtin_amdgcn_readfirstlane(tid_ >> 6);
    LAS float* scr = (LAS float*)(lds + wave * 16384);
    const int gw = blockIdx.x * 8 + wave, NGW = G * 8;
    constexpr int I_IN = 16 * 320, I_P = 16 * 32, PER_L = I_IN + 3 * I_P;
    for (int it = gw; it < PER_L; it += NGW) {
        int r = it;
        if (r < I_IN) { const int kb = r / 320, nb = r % 320; transpose_item(w_in, NIN, (bf16_t*)(ws + WS_WIN), 64 * kb, src_col(32 * nb), 32 * nb, scr, lane); continue; }
        r -= I_IN; const int which = r / I_P; r %= I_P; const int kb = r / 32, nb = r % 32;
        const float* W = (which == 0 ? wa : which == 1 ? wb : wo);
        bf16_t* WT = (bf16_t*)(ws + (which == 0 ? WS_WA : which == 1 ? WS_WB : WS_WO));
        transpose_item(W, D, WT, 64 * kb, 32 * nb, 32 * nb, scr, lane);
    }
}
DI void phase_rms_bf16(const float* x, const float* w, bf16_t* h, int nrows, int G) {
    const int tid_ = opaque_tid(); const int lane = tid_ & 63, wave = __builtin_amdgcn_readfirstlane(tid_ >> 6);
    const int gw = blockIdx.x * 8 + wave, NGW = G * 8;
    f32x4 wv[4];
#pragma unroll
    for (int j = 0; j < 4; ++j) wv[j] = ((const f32x4*)w)[lane + 64 * j];
    for (int m = gw; m < nrows; m += NGW) {
        const f32x4* xr = (const f32x4*)(x + (size_t)m * D) + lane; f32x4 v[4]; float s = 0.f;
#pragma unroll
        for (int j = 0; j < 4; ++j) { v[j] = xr[64 * j]; s += (v[j].x * v[j].x + v[j].y * v[j].y) + (v[j].z * v[j].z + v[j].w * v[j].w); }
        const float rstd = rsqrtf(wave_sum(s) * (1.0f / D) + 1e-6f);
        u32x2* o8 = (u32x2*)(h + (size_t)m * D) + lane;
#pragma unroll
        for (int j = 0; j < 4; ++j) { u32x2 o; o.x = pk2(v[j].x * rstd * wv[j].x, v[j].y * rstd * wv[j].y); o.y = pk2(v[j].z * rstd * wv[j].z, v[j].w * rstd * wv[j].w); o8[64 * j] = o; }
    }
}
DI void phase_final(float* x, const float* w, int nrows, int G) {
    const int tid_ = opaque_tid(); const int lane = tid_ & 63, wave = __builtin_amdgcn_readfirstlane(tid_ >> 6);
    const int gw = blockIdx.x * 8 + wave, NGW = G * 8;
    f32x4 wv[4];
#pragma unroll
    for (int j = 0; j < 4; ++j) wv[j] = ((const f32x4*)w)[lane + 64 * j];
    for (int m = gw; m < nrows; m += NGW) {
        f32x4* xr = (f32x4*)(x + (size_t)m * D) + lane; f32x4 v[4]; float s = 0.f;
#pragma unroll
        for (int j = 0; j < 4; ++j) { v[j] = xr[64 * j]; s += (v[j].x * v[j].x + v[j].y * v[j].y) + (v[j].z * v[j].z + v[j].w * v[j].w); }
        const float rstd = rsqrtf(wave_sum(s) * (1.0f / D) + 1e-6f);
#pragma unroll
        for (int j = 0; j < 4; ++j) xr[64 * j] = v[j] * rstd * wv[j];
    }
}
#define MFMA32(a, b, c) __builtin_amdgcn_mfma_f32_32x32x16_bf16((a), (b), (c), 0, 0, 0)
struct S1Regs { u32x4 q0, q1, z0, z1, v0, v1; };
DI size_t s1_rowoff(int it, int sub, int j) {
    const int sc = it & 31, dir = (it >> 5) & 1, h = (it >> 6) & 7, b = it >> 9, p = 64 * sub + j;
    return ((size_t)b * SEQ + sc * 128 + (dir ? 127 - p : p)) * D + h * 128;
}
DI void s1_load(S1Regs& R, const bf16_t* Q, const bf16_t* Z, const bf16_t* Iv, int it, int sub, int tid) {
    const size_t off = s1_rowoff(it, sub, tid >> 3) + 16 * (tid & 7);
    const bf16_t* zp = Z + (size_t)((it >> 5) & 1) * ARR;
    R.q0 = *(const u32x4*)(Q + off); R.q1 = *(const u32x4*)(Q + off + 8);
    R.z0 = *(const u32x4*)(zp + off); R.z1 = *(const u32x4*)(zp + off + 8);
    R.v0 = *(const u32x4*)(Iv + off); R.v1 = *(const u32x4*)(Iv + off + 8);
}
DI void phase_s1(LAS unsigned char* lds, const bf16_t* Q, bf16_t* Z, const bf16_t* Iv, bf16_t* O, bf16_t* X, float* AC, const float* LBT, int G) {
    const int tid = opaque_tid(), lane = tid & 63, wave = __builtin_amdgcn_readfirstlane(tid >> 6);
    const int r = lane & 31, hh = lane >> 5, j8 = tid >> 3, cg8 = tid & 7;
    LAS bf16_t* TQ = (LAS bf16_t*)(lds);
    LAS bf16_t* TV = (LAS bf16_t*)(lds + 17408);
    LAS bf16_t* TZ = (LAS bf16_t*)(lds + 34816);
    LAS bf16_t* QS = (LAS bf16_t*)(lds + 52224);
    LAS bf16_t* KSA = (LAS bf16_t*)(lds + 69632);
    LAS bf16_t* KSB = (LAS bf16_t*)(lds + 87040);
    LAS bf16_t* KHT = (LAS bf16_t*)(lds + 104448);
    LAS bf16_t* VT = (LAS bf16_t*)(lds + 122880);
    LAS float* TA = (LAS float*)(lds + 157696);
    LAS float* AA = TA + 128;
    LAS float* AB = TA + 256;
    LAS bf16_t* PS = TV;
    S1Regs R;
    int it = blockIdx.x;
    if (it < 2048) s1_load(R, Q, Z, Iv, it, 0, tid);
    __syncthreads();
    for (; it < 2048; it += G) {
        const int sc = it & 31, dir = (it >> 5) & 1, h = (it >> 6) & 7, b = it >> 9, seq = (b * 8 + h) * 2 + dir;
        f32x16 DA[2];
#pragma unroll
        for (int sub = 0; sub < 2; ++sub) {
            *(LAS u32x4*)(TQ + j8 * 136 + 16 * cg8) = R.q0; *(LAS u32x4*)(TQ + j8 * 136 + 16 * cg8 + 8) = R.q1;
            *(LAS u32x4*)(TZ + j8 * 136 + 16 * cg8) = R.z0; *(LAS u32x4*)(TZ + j8 * 136 + 16 * cg8 + 8) = R.z1;
            *(LAS u32x4*)(TV + j8 * 136 + 16 * cg8) = R.v0; *(LAS u32x4*)(TV + j8 * 136 + 16 * cg8 + 8) = R.v1;
            __syncthreads();
            {
                const float* lp = LBT + dir * 2048 + h * 128 + 16 * wave;
                const u32x4 z0 = *(const LAS u32x4*)(TZ + lane * 136 + 16 * wave), z1 = *(const LAS u32x4*)(TZ + lane * 136 + 16 * wave + 8);
                const u32x4 q0 = *(const LAS u32x4*)(TQ + lane * 136 + 16 * wave), q1 = *(const LAS u32x4*)(TQ + lane * 136 + 16 * wave + 8);
                const u32x4 v0 = *(const LAS u32x4*)(TV + lane * 136 + 16 * wave), v1 = *(const LAS u32x4*)(TV + lane * 136 + 16 * wave + 8);
                const unsigned zw[8] = {z0.x, z0.y, z0.z, z0.w, z1.x, z1.y, z1.z, z1.w};
                const unsigned qw[8] = {q0.x, q0.y, q0.z, q0.w, q1.x, q1.y, q1.z, q1.w};
                const unsigned vw[8] = {v0.x, v0.y, v0.z, v0.w, v1.x, v1.y, v1.z, v1.w};
                float kk[16], gg[16], lbv[16], omv[16];
#pragma unroll
                for (int i = 0; i < 16; ++i) { lbv[i] = lp[i]; omv[i] = lp[1024 + i]; }
                if (sub == 0) s1_load(R, Q, Z, Iv, it, 1, tid); else if (it + G < 2048) s1_load(R, Q, Z, Iv, it + G, 0, tid);
#pragma unroll
                for (int i = 0; i < 16; ++i) { const unsigned w = zw[i >> 1]; float z = (i & 1) ? bfhi(w) : bflo(w); z = __builtin_amdgcn_fmed3f(z, -30.f, 30.f);
                    const float e = fexp2(-z * LOG2E), sg = frcp(1.0f + e); const float om = omv[i];
                    kk[i] = om * e * sg; gg[i] = __builtin_amdgcn_logf(lbv[i] + om * sg); }
#pragma unroll
                for (int i = 0; i < 16; ++i) {
                    float x = gg[i];
                    x += dpp_f<0x111, 0xf, true>(x); x += dpp_f<0x112, 0xf, true>(x); x += dpp_f<0x114, 0xf, true>(x); x += dpp_f<0x118, 0xf, true>(x);
                    x += dpp_f<0x142, 0xa, false>(x); x += dpp_f<0x143, 0xc, false>(x);
                    gg[i] = x; }
                float aa[16], ta[16];
                if (sub == 1) {
#pragma unroll
                    for (int q4 = 0; q4 < 4; ++q4) { const f32x4 a4 = *(const LAS f32x4*)(AA + 16 * wave + 4 * q4), t4 = *(const LAS f32x4*)(TA + 16 * wave + 4 * q4);
                        aa[4 * q4] = a4.x; aa[4 * q4 + 1] = a4.y; aa[4 * q4 + 2] = a4.z; aa[4 * q4 + 3] = a4.w; ta[4 * q4] = t4.x; ta[4 * q4 + 1] = t4.y; ta[4 * q4 + 2] = t4.z; ta[4 * q4 + 3] = t4.w; }
                }
                unsigned qo[8], ko[8], kh[8], qh[8];
                float a16[16], t16[16], f16_[16];
#pragma unroll
                for (int w = 0; w < 8; ++w) {
                    float qt_[2], kt_[2], kh_[2], qh_[2];
#pragma unroll
                    for (int e2 = 0; e2 < 2; ++e2) { const int i = 2 * w + e2; const float qf = e2 ? bfhi(qw[w]) : bflo(qw[w]);
                        const float Rr = __int_as_float(__builtin_amdgcn_readlane(__float_as_int(gg[i]), 31)), G63 = __int_as_float(__builtin_amdgcn_readlane(__float_as_int(gg[i]), 63));
                        const float dq = gg[i] - Rr;
                        qt_[e2] = qf * fexp2(fminf(dq, 100.f)); kt_[e2] = kk[i] * fexp2(fminf(-dq, 100.f));
                        a16[i] = fexp2(gg[i]); kh_[e2] = kk[i] * fexp2(G63 - gg[i]); t16[i] = gg[i] - Rr;
                        if (sub == 0) { qh_[e2] = qf * a16[i]; } else { qh_[e2] = qf * a16[i] * aa[i]; f16_[i] = fexp2(Rr + ta[i]); } }
                    qo[w] = pk2(qt_[0], qt_[1]); ko[w] = pk2(kt_[0], kt_[1]); kh[w] = pk2(kh_[0], kh_[1]); qh[w] = pk2(qh_[0], qh_[1]);
                }
                LAS bf16_t* KSx = (sub == 0) ? KSA : KSB;
                *(LAS u32x4*)(QS + lane * 136 + 16 * wave) = (u32x4){qo[0], qo[1], qo[2], qo[3]}; *(LAS u32x4*)(QS + lane * 136 + 16 * wave + 8) = (u32x4){qo[4], qo[5], qo[6], qo[7]};
                *(LAS u32x4*)(KSx + lane * 136 + 16 * wave) = (u32x4){ko[0], ko[1], ko[2], ko[3]}; *(LAS u32x4*)(KSx + lane * 136 + 16 * wave + 8) = (u32x4){ko[4], ko[5], ko[6], ko[7]};
                *(LAS u32x4*)(TZ + lane * 136 + 16 * wave) = (u32x4){qh[0], qh[1], qh[2], qh[3]}; *(LAS u32x4*)(TZ + lane * 136 + 16 * wave + 8) = (u32x4){qh[4], qh[5], qh[6], qh[7]};
#pragma unroll
                for (int w = 0; w < 8; ++w) {
                    KHT[(16 * wave + 2 * w) * 72 + lane] = (bf16_t)(kh[w] & 0xffffu); KHT[(16 * wave + 2 * w + 1) * 72 + lane] = (bf16_t)(kh[w] >> 16);
                    VT[(16 * wave + 2 * w) * 136 + 64 * sub + lane] = (bf16_t)(vw[w] & 0xffffu); VT[(16 * wave + 2 * w + 1) * 136 + 64 * sub + lane] = (bf16_t)(vw[w] >> 16);
                }
                if (sub == 0) {
                    if (lane == 63) {
#pragma unroll
                        for (int q4 = 0; q4 < 4; ++q4) { *(LAS f32x4*)(TA + 16 * wave + 4 * q4) = (f32x4){t16[4 * q4], t16[4 * q4 + 1], t16[4 * q4 + 2], t16[4 * q4 + 3]};
                            *(LAS f32x4*)(AA + 16 * wave + 4 * q4) = (f32x4){a16[4 * q4], a16[4 * q4 + 1], a16[4 * q4 + 2], a16[4 * q4 + 3]}; }
                    }
                } else {
                    const u32x4 k0 = *(const LAS u32x4*)(KSA + lane * 136 + 16 * wave), k1 = *(const LAS u32x4*)(KSA + lane * 136 + 16 * wave + 8);
                    const unsigned kw[8] = {k0.x, k0.y, k0.z, k0.w, k1.x, k1.y, k1.z, k1.w}; unsigned kn[8];
#pragma unroll
                    for (int w = 0; w < 8; ++w) kn[w] = pk2(bflo(kw[w]) * f16_[2 * w], bfhi(kw[w]) * f16_[2 * w + 1]);
                    *(LAS u32x4*)(KSA + lane * 136 + 16 * wave) = (u32x4){kn[0], kn[1], kn[2], kn[3]}; *(LAS u32x4*)(KSA + lane * 136 + 16 * wave + 8) = (u32x4){kn[4], kn[5], kn[6], kn[7]};
                    if (lane == 63) { float* ap = AC + ((size_t)seq * 32 + sc) * 128 + 16 * wave;
#pragma unroll
                        for (int q4 = 0; q4 < 4; ++q4) { *(LAS f32x4*)(AB + 16 * wave + 4 * q4) = (f32x4){a16[4 * q4], a16[4 * q4 + 1], a16[4 * q4 + 2], a16[4 * q4 + 3]};
                            *(f32x4*)(ap + 4 * q4) = (f32x4){a16[4 * q4] * aa[4 * q4], a16[4 * q4 + 1] * aa[4 * q4 + 1], a16[4 * q4 + 2] * aa[4 * q4 + 2], a16[4 * q4 + 3] * aa[4 * q4 + 3]}; } }
                }
            }
            __syncthreads();
            {
                LAS bf16_t* KSx = (sub == 0) ? KSA : KSB;
                if (wave < 3) {
                    const int tm = (wave == 2) ? 1 : 0, tn = (wave == 0) ? 0 : 1;
                    f32x16 acc;
#pragma unroll
                    for (int i = 0; i < 16; ++i) acc[i] = 0.f;
#pragma unroll
                    for (int ks = 0; ks < 8; ++ks) { const bf16x8 a = *(const LAS bf16x8*)(KSx + (32 * tm + r) * 136 + 16 * ks + 8 * hh), bb = *(const LAS bf16x8*)(QS + (32 * tn + r) * 136 + 16 * ks + 8 * hh); acc = MFMA32(a, bb, acc); }
                    const int t = 32 * tn + r;
#pragma unroll
                    for (int g = 0; g < 4; ++g) { const int s0 = 32 * tm + 8 * g + 4 * hh;
                        const float p0 = (s0 + 0 <= t) ? acc[4 * g + 0] : 0.f, p1 = (s0 + 1 <= t) ? acc[4 * g + 1] : 0.f, p2 = (s0 + 2 <= t) ? acc[4 * g + 2] : 0.f, p3 = (s0 + 3 <= t) ? acc[4 * g + 3] : 0.f;
                        *(LAS u32x2*)(PS + t * 136 + 64 * sub + s0) = (u32x2){pk2(p0, p1), pk2(p2, p3)}; }
                } else if (sub == 1 && wave < 7) {
                    const int tm = (wave - 3) >> 1, tn = (wave - 3) & 1;
                    f32x16 acc;
#pragma unroll
                    for (int i = 0; i < 16; ++i) acc[i] = 0.f;
#pragma unroll
                    for (int ks = 0; ks < 8; ++ks) { const bf16x8 a = *(const LAS bf16x8*)(KSA + (32 * tm + r) * 136 + 16 * ks + 8 * hh), bb = *(const LAS bf16x8*)(QS + (32 * tn + r) * 136 + 16 * ks + 8 * hh); acc = MFMA32(a, bb, acc); }
                    const int t = 32 * tn + r;
#pragma unroll
                    for (int g = 0; g < 4; ++g) { const int s0 = 32 * tm + 8 * g + 4 * hh;
                        *(LAS u32x2*)(PS + t * 136 + s0) = (u32x2){pk2(acc[4 * g], acc[4 * g + 1]), pk2(acc[4 * g + 2], acc[4 * g + 3])}; }
                }
#pragma unroll
                for (int k = 0; k < 2; ++k) {
                    const int vt = wave >> 1, dt = 2 * (wave & 1) + k;
                    f32x16 acc;
                    if (sub == 0) {
#pragma unroll
                        for (int i = 0; i < 16; ++i) acc[i] = 0.f;
                    } else { const float ab = AB[32 * dt + r];
#pragma unroll
                        for (int i = 0; i < 16; ++i) acc[i] = DA[k][i] * ab; }
#pragma unroll
                    for (int ks = 0; ks < 4; ++ks) { const bf16x8 a = *(const LAS bf16x8*)(VT + (32 * vt + r) * 136 + 64 * sub + 16 * ks + 8 * hh), bb = *(const LAS bf16x8*)(KHT + (32 * dt + r) * 72 + 16 * ks + 8 * hh); acc = MFMA32(a, bb, acc); }
                    if (sub == 0) DA[k] = acc;
                    else { bf16_t* xp = X + ((size_t)seq * 32 + sc) * 16384 + (size_t)(32 * vt + 4 * hh) * 128 + 32 * dt + r;
#pragma unroll
                        for (int i = 0; i < 16; i += 2) { const unsigned p = pk2(acc[i], acc[i + 1]); const int v0 = (i & 3) + 8 * (i >> 2);
                            xp[(size_t)v0 * 128] = (bf16_t)(p & 0xffffu); xp[(size_t)(v0 + 1) * 128] = (bf16_t)(p >> 16); } }
                }
                {
                    bf16_t* zp = Z + (size_t)dir * ARR + s1_rowoff(it, sub, j8) + 16 * cg8;
                    *(u32x4*)zp = *(const LAS u32x4*)(TZ + j8 * 136 + 16 * cg8); *(u32x4*)(zp + 8) = *(const LAS u32x4*)(TZ + j8 * 136 + 16 * cg8 + 8);
                }
            }
            __syncthreads();
            {
                const int vt = wave & 3, tn = wave >> 2;
                f32x16 acc;
#pragma unroll
                for (int i = 0; i < 16; ++i) acc[i] = 0.f;
                if (sub == 1) {
#pragma unroll
                    for (int ks = 0; ks < 4; ++ks) { const bf16x8 a = *(const LAS bf16x8*)(VT + (32 * vt + r) * 136 + 16 * ks + 8 * hh), bb = *(const LAS bf16x8*)(PS + (32 * tn + r) * 136 + 16 * ks + 8 * hh); acc = MFMA32(a, bb, acc); }
                }
#pragma unroll
                for (int ks = 0; ks < 4; ++ks) { if (ks < 2 * (tn + 1)) { const bf16x8 a = *(const LAS bf16x8*)(VT + (32 * vt + r) * 136 + 64 * sub + 16 * ks + 8 * hh), bb = *(const LAS bf16x8*)(PS + (32 * tn + r) * 136 + 64 * sub + 16 * ks + 8 * hh); acc = MFMA32(a, bb, acc); } }
                LAS bf16_t* op = QS + (32 * tn + r) * 136 + 32 * vt + 4 * hh;
#pragma unroll
                for (int g = 0; g < 4; ++g) *(LAS u32x2*)(op + 8 * g) = (u32x2){pk2(acc[4 * g], acc[4 * g + 1]), pk2(acc[4 * g + 2], acc[4 * g + 3])};
            }
            __syncthreads();
            {
                bf16_t* op = O + (size_t)dir * ARR + s1_rowoff(it, sub, j8) + 16 * cg8;
                *(u32x4*)op = *(const LAS u32x4*)(QS + j8 * 136 + 16 * cg8); *(u32x4*)(op + 8) = *(const LAS u32x4*)(QS + j8 * 136 + 16 * cg8 + 8);
            }
        }
    }
}
DI void phase_lnstats(const bf16_t* GV, f32x2* STATS, int G) {
    const int tid_ = opaque_tid(); const int lane = tid_ & 63, wave = __builtin_amdgcn_readfirstlane(tid_ >> 6);
    const int gw = blockIdx.x * 8 + wave, NGW = G * 8;
    for (int m = gw; m < MH; m += NGW) {
        const bf16_t* p = GV + (size_t)m * D + 16 * lane;
        const u32x4 a0 = *(const u32x4*)p, a1 = *(const u32x4*)(p + 8);
        const unsigned aw[8] = {a0.x, a0.y, a0.z, a0.w, a1.x, a1.y, a1.z, a1.w};
        float s1 = 0.f, s2 = 0.f;
#pragma unroll
        for (int w = 0; w < 8; ++w) { const float x0 = bflo(aw[w]), x1 = bfhi(aw[w]); s1 += x0 + x1; s2 += x0 * x0 + x1 * x1; }
        s1 = wave_sum(s1); s2 = wave_sum(s2);
        const float mean = s1 * (1.0f / D), var = fmaxf(s2 * (1.0f / D) - mean * mean, 0.f);
        if (lane == 0) STATS[m] = (f32x2){mean, rsqrtf(var + 1e-5f)};
    }
}
DI void phase_s2(bf16_t* X, const float* AC, int G) {
    const int tid = opaque_tid();
    for (int gid = blockIdx.x * 512 + tid; gid < 64 * 2048; gid += G * 512) {
        const int seq = gid >> 11, e = gid & 2047, d0 = (e & 15) * 8, dir = seq & 1;
        bf16_t* xp = X + (size_t)seq * 32 * 16384 + (size_t)(e >> 4) * 128 + d0;
        const float* ap = AC + (size_t)seq * 32 * 128 + d0;
        float S[8];
#pragma unroll
        for (int i = 0; i < 8; ++i) S[i] = 0.f;
        for (int st = 0; st < 32; st += 4) {
            u32x4 dv[4]; f32x4 a0[4], a1[4];
#pragma unroll
            for (int u = 0; u < 4; ++u) { const int c = dir ? 31 - (st + u) : st + u; dv[u] = *(const u32x4*)(xp + (size_t)c * 16384); a0[u] = *(const f32x4*)(ap + c * 128); a1[u] = *(const f32x4*)(ap + c * 128 + 4); }
#pragma unroll
            for (int u = 0; u < 4; ++u) { const int c = dir ? 31 - (st + u) : st + u;
                *(u32x4*)(xp + (size_t)c * 16384) = (u32x4){pk2(S[0], S[1]), pk2(S[2], S[3]), pk2(S[4], S[5]), pk2(S[6], S[7])};
                S[0] = a0[u].x * S[0] + bflo(dv[u].x); S[1] = a0[u].y * S[1] + bfhi(dv[u].x); S[2] = a0[u].z * S[2] + bflo(dv[u].y); S[3] = a0[u].w * S[3] + bfhi(dv[u].y);
                S[4] = a1[u].x * S[4] + bflo(dv[u].z); S[5] = a1[u].y * S[5] + bfhi(dv[u].z); S[6] = a1[u].z * S[6] + bflo(dv[u].w); S[7] = a1[u].w * S[7] + bfhi(dv[u].w); }
        }
    }
}
struct S3Regs { u32x4 x[8], q[8]; };
DI void s3_load(S3Regs& R, const bf16_t* QH, const bf16_t* X, int it, int dir, int ts, int vt, int lane) {
    const int c = it & 63, h = (it >> 6) & 7, b = it >> 9;
    const bf16_t* xp = X + ((size_t)((b * 8 + h) * 2 + dir) * 32 + (c >> 1)) * 16384 + (size_t)(32 * vt) * 128 + 8 * lane;
    const bf16_t* qp = QH + (size_t)dir * ARR + ((size_t)b * SEQ + c * 64 + 32 * ts + (lane >> 4)) * D + h * 128 + 8 * (lane & 15);
#pragma unroll
    for (int k = 0; k < 8; ++k) { R.x[k] = *(const u32x4*)(xp + 512 * k); R.q[k] = *(const u32x4*)(qp + (size_t)(4 * k) * D); }
}
DI void phase_s3(LAS unsigned char* lds, const bf16_t* QH, const bf16_t* O, const bf16_t* X, const bf16_t* SGA, const float* gw_, bf16_t* YA, int G) {
    const int tid = opaque_tid(), lane = tid & 63, wave = __builtin_amdgcn_readfirstlane(tid >> 6);
    const int r = lane & 31, hh = lane >> 5, ts = wave >> 2, vt = wave & 3;
    LAS bf16_t* XW = (LAS bf16_t*)(lds + wave * 17408);
    LAS bf16_t* QW = XW + 32 * 136;
    LAS float* SS = (LAS float*)(lds + 8 * 17408);
    S3Regs R;
    int it = blockIdx.x;
    if (it < 2048) s3_load(R, QH, X, it, 0, ts, vt, lane);
    __syncthreads();
    for (; it < 2048; it += G) {
        const int c = it & 63, h = (it >> 6) & 7, b = it >> 9;
        const size_t row = (size_t)b * SEQ + c * 64 + 32 * ts + r;
        const size_t ooff = row * D + h * 128 + 32 * vt + 4 * hh;
        u32x2 ef[4], eb[4], es[4];
        f32x16 acc;
#pragma unroll
        for (int i = 0; i < 16; ++i) acc[i] = 0.f;
#pragma unroll
        for (int dir = 0; dir < 2; ++dir) {
#pragma unroll
            for (int k = 0; k < 8; ++k) { const int id = 64 * k + lane; *(LAS u32x4*)(XW + (id >> 4) * 136 + 8 * (id & 15)) = R.x[k]; *(LAS u32x4*)(QW + (id >> 4) * 136 + 8 * (id & 15)) = R.q[k]; }
            asm volatile("" ::: "memory");
            if (dir == 0) { s3_load(R, QH, X, it, 1, ts, vt, lane);
#pragma unroll
                for (int g = 0; g < 4; ++g) { ef[g] = *(const u32x2*)(O + ooff + 8 * g); eb[g] = *(const u32x2*)(O + ARR + ooff + 8 * g); es[g] = *(const u32x2*)(SGA + ooff + 8 * g); } }
            else if (it + G < 2048) s3_load(R, QH, X, it + G, 0, ts, vt, lane);
#pragma unroll
            for (int ks = 0; ks < 8; ++ks) { const bf16x8 a = *(const LAS bf16x8*)(XW + r * 136 + 16 * ks + 8 * hh), bb = *(const LAS bf16x8*)(QW + r * 136 + 16 * ks + 8 * hh); acc = MFMA32(a, bb, acc); }
        }
        float o[16]; float ss = 0.f;
#pragma unroll
        for (int g = 0; g < 4; ++g) { const u32x2 f = ef[g], bk = eb[g];
            o[4 * g] = acc[4 * g] + bflo(f.x) + bflo(bk.x); o[4 * g + 1] = acc[4 * g + 1] + bfhi(f.x) + bfhi(bk.x); o[4 * g + 2] = acc[4 * g + 2] + bflo(f.y) + bflo(bk.y); o[4 * g + 3] = acc[4 * g + 3] + bfhi(f.y) + bfhi(bk.y); }
#pragma unroll
        for (int i = 0; i < 16; ++i) ss += o[i] * o[i];
        ss += __shfl_xor(ss, 32);
        __syncthreads();
        if (hh == 0) SS[(32 * ts + r) * 4 + vt] = ss;
        __syncthreads();
        const f32x4 s4 = *(const LAS f32x4*)(SS + (32 * ts + r) * 4);
        const float rstd = rsqrtf((s4.x + s4.y + s4.z + s4.w) * (1.0f / 128.0f) + 1e-6f);
#pragma unroll
        for (int g = 0; g < 4; ++g) { const u32x2 sg = es[g]; const f32x4 gv = *(const f32x4*)(gw_ + 32 * vt + 8 * g + 4 * hh);
            *(u32x2*)(YA + ooff + 8 * g) = (u32x2){pk2(o[4 * g] * rstd * gv.x * bflo(sg.x), o[4 * g + 1] * rstd * gv.y * bfhi(sg.x)), pk2(o[4 * g + 2] * rstd * gv.z * bflo(sg.y), o[4 * g + 3] * rstd * gv.w * bfhi(sg.y))}; }
    }
}

DI void phase_spatial(LAS unsigned char* lds, const bf16_t* GV, bf16_t* UG, const f32x2* STATS, const float* ln_w, const float* ln_b, const float* w_s, const float* b_s, int G) {
    const int tid = opaque_tid(), lane = tid & 63, wave = __builtin_amdgcn_readfirstlane(tid >> 6);
    const int r = lane & 31, hh = lane >> 5;
    LAS bf16_t* VL = (LAS bf16_t*)(lds);
    LAS bf16_t* WS = (LAS bf16_t*)(lds + 34816);
    for (int it = blockIdx.x; it < 1024; it += G) {
        const int g = it & 7, n = (it >> 3) & 31, b = it >> 8;
        const size_t rowbase = (size_t)b * SEQ + (size_t)n * 128;
        __syncthreads();
        {
            const int s = tid >> 2, cq = tid & 3; const f32x2 st = STATS[rowbase + s];
            const bf16_t* p = GV + (rowbase + s) * D + 128 * g + 32 * cq;
#pragma unroll
            for (int q = 0; q < 4; ++q) { const u32x4 a = *(const u32x4*)(p + 8 * q); const unsigned aw[4] = {a.x, a.y, a.z, a.w};
                const f32x4 w0 = *(const f32x4*)(ln_w + 128 * g + 32 * cq + 8 * q), w1 = *(const f32x4*)(ln_w + 128 * g + 32 * cq + 8 * q + 4);
                const f32x4 c0 = *(const f32x4*)(ln_b + 128 * g + 32 * cq + 8 * q), c1 = *(const f32x4*)(ln_b + 128 * g + 32 * cq + 8 * q + 4);
                const float wv[8] = {w0.x, w0.y, w0.z, w0.w, w1.x, w1.y, w1.z, w1.w}, bv[8] = {c0.x, c0.y, c0.z, c0.w, c1.x, c1.y, c1.z, c1.w};
#pragma unroll
                for (int w = 0; w < 4; ++w) { const float y0 = (bflo(aw[w]) - st.x) * st.y * wv[2 * w] + bv[2 * w], y1 = (bfhi(aw[w]) - st.x) * st.y * wv[2 * w + 1] + bv[2 * w + 1];
                    const unsigned pk = pk2(y0, y1); const int cc = 32 * cq + 8 * q + 2 * w;
                    VL[cc * 136 + s] = (bf16_t)(pk & 0xffffu); VL[(cc + 1) * 136 + s] = (bf16_t)(pk >> 16); } }
            const int t = tid >> 2, sq = tid & 3; const float* wp = w_s + ((size_t)g * 128 + t) * 128 + 32 * sq;
#pragma unroll
            for (int q = 0; q < 4; ++q) { const f32x4 x0 = *(const f32x4*)(wp + 8 * q), x1 = *(const f32x4*)(wp + 8 * q + 4);
                *(LAS u32x4*)(WS + t * 136 + 32 * sq + 8 * q) = (u32x4){pk2(x0.x, x0.y), pk2(x0.z, x0.w), pk2(x1.x, x1.y), pk2(x1.z, x1.w)}; }
        }
        __syncthreads();
        {
            const int cm = wave & 3;
#pragma unroll
            for (int tt = 0; tt < 2; ++tt) {
                const int tn = 2 * (wave >> 2) + tt;
                f32x16 acc;
#pragma unroll
                for (int i = 0; i < 16; ++i) acc[i] = 0.f;
#pragma unroll
                for (int ks = 0; ks < 8; ++ks) { const bf16x8 a = *(const LAS bf16x8*)(VL + (32 * cm + r) * 136 + 16 * ks + 8 * hh), bb = *(const LAS bf16x8*)(WS + (32 * tn + r) * 136 + 16 * ks + 8 * hh); acc = MFMA32(a, bb, acc); }
                const int t = 32 * tn + r; const float bias = b_s[g * 128 + t];
                bf16_t* up = UG + (rowbase + t) * D + 128 * g + 32 * cm + 4 * hh;
#pragma unroll
                for (int q = 0; q < 4; ++q) { const u32x2 uw = *(const u32x2*)(up + 8 * q);
                    *(u32x2*)(up + 8 * q) = (u32x2){pk2(bflo(uw.x) * (acc[4 * q] + bias), bfhi(uw.x) * (acc[4 * q + 1] + bias)), pk2(bflo(uw.y) * (acc[4 * q + 2] + bias), bfhi(uw.y) * (acc[4 * q + 3] + bias))}; }
            }
        }
    }
}

struct Args { const float* in[13]; float* out; unsigned char* ws; int ph_lo, ph_hi; };
constexpr int PPL = 11;
constexpr int NPH = 4 * PPL + 1;

__global__ void __launch_bounds__(512, 2) mega(Args a) {
    extern __shared__ __attribute__((aligned(16))) unsigned char shm[];
    LAS unsigned char* lds = (LAS unsigned char*)shm;
    cg::grid_group grid = cg::this_grid();
    const int G = gridDim.x, blk = blockIdx.x;
    unsigned char* ws = a.ws;
    const float* x0 = a.in[0];
    bf16_t* Hb = (bf16_t*)(ws + WS_H); bf16_t* out9 = (bf16_t*)(ws + WS_OUT9);
    bf16_t* Qb = out9, *ZFb = out9 + ARR, *Ib = out9 + 3 * ARR, *SGAb = out9 + 4 * ARR, *GVb = out9 + 5 * ARR;
    bf16_t* g3 = (bf16_t*)(ws + WS_G3); bf16_t* UGf = g3, *SMAf = g3 + 2 * ARR, *SMBf = g3 + 4 * ARR;
    bf16_t* OFb = (bf16_t*)(ws + WS_OF); bf16_t* Xb = (bf16_t*)(ws + WS_X); float* ACb = (float*)(ws + WS_AC); f32x2* STb = (f32x2*)(ws + WS_ST);
    volatile LAS unsigned* bst = (volatile LAS unsigned*)(lds + LDS_BYTES - 16);
    if (threadIdx.x < 4) bst[threadIdx.x] = 0u;
    if (blk == 0) for (int i = threadIdx.x; i < XCD_BAR_WORDS; i += 512) ((unsigned*)ws)[i] = 0u;
    __syncthreads();
    XcdBarrier xb; xb.bar = (unsigned*)ws; xb.x = 0; xb.st = bst;
    for (int ph = a.ph_lo; ph < a.ph_hi; ++ph) {
        if (ph == a.ph_lo + 1) { grid.sync(); xb = xcd_barrier_post((unsigned*)ws, bst); }
        else if (ph > a.ph_lo + 1) xcd_barrier(xb);
        if (ph == NPH - 1) { phase_final(a.out, a.in[12], M_ALL, G); continue; }
        const int l = ph / PPL, rr = ph % PPL;
        const float* xin = (l == 0) ? x0 : a.out;
        if (rr == 0) {
            phase_prep(lds, a.in[2] + (size_t)l * D * NIN, a.in[9] + (size_t)l * D * D, a.in[10] + (size_t)l * D * D, a.in[11] + (size_t)l * D * D, ws, G);
            phase_rms_bf16(xin, a.in[1] + l * D, Hb, M_ALL, G);
            if (blk == 0) {
                float* LBT = (float*)(ws + WS_LBT);
                for (int i = threadIdx.x; i < 2048; i += 512) { const float* lp = a.in[3] + i;
                    const float v0 = lp[0], v1 = lp[2048], v2 = lp[4096], v3 = lp[6144], mx = fmaxf(fmaxf(v0, v1), fmaxf(v2, v3));
                    const float e0 = __expf(v0 - mx), e1 = __expf(v1 - mx), e2 = __expf(v2 - mx), e3 = __expf(v3 - mx);
                    float lb = 0.f; if (l >= 1) lb += e1; if (l >= 2) lb += e2; if (l >= 3) lb += e3;
                    lb = lb / (e0 + e1 + e2 + e3);
                    LBT[(i >> 10) * 2048 + (i & 1023)] = fmaxf(lb, 1e-20f); LBT[(i >> 10) * 2048 + 1024 + (i & 1023)] = 1.0f - lb; }
            }
            continue;
        }
        const int hf = (rr <= 8) ? (rr - 1) / 4 : 0, k = (rr <= 8) ? (rr - 1) % 4 : rr - 5;
        bf16_t* Hh = Hb + (size_t)hf * ARR;
        bf16_t* UGb = UGf + (size_t)hf * ARR;
        if (k == 0) {
            pg8::Gemm g{Hh, Hh, (const bf16_t*)(ws + WS_WIN), (const bf16_t*)(ws + WS_WIN), D};
            pg8::Order S; S.init(MH, NIN, G, blk, 0);
            EpiInProj E{out9, g3 + (size_t)hf * ARR};
            pg8::gemm_phase<EpiInProj>(lds, g, S, E);
        } else if (k == 1) {
            phase_lnstats(GVb, STb, G);
            phase_s1(lds, Qb, ZFb, Ib, OFb, Xb, ACb, (const float*)(ws + WS_LBT), G);
        } else if (k == 2) {
            if (blk & 1) phase_s2(Xb, ACb, G);
            phase_spatial(lds, GVb, UGb, STb, a.in[5] + l * D, a.in[6] + l * D, a.in[7] + (size_t)l * 8 * 128 * 128, a.in[8] + l * 8 * 128, G);
            if (!(blk & 1)) phase_s2(Xb, ACb, G);
        } else if (k == 3) {
            phase_s3(lds, ZFb, OFb, Xb, SGAb, a.in[4] + l * 128, Hh, G);
        } else if (k == 4) {
            pg8::Gemm g{Hb, UGf, (const bf16_t*)(ws + WS_WA), (const bf16_t*)(ws + WS_WB), D};
            pg8::Order S; S.init(M_ALL, D, G, blk, 1);
            EpiProjAB E{SMAf, SMBf, out9};
            pg8::gemm_phase<EpiProjAB>(lds, g, S, E);
        } else {
            pg8::Gemm g{out9, out9, (const bf16_t*)(ws + WS_WO), (const bf16_t*)(ws + WS_WO), D};
            pg8::Order S; S.init(M_ALL, D, G, blk, 0);
            EpiResid E{xin, a.out};
            pg8::gemm_phase<EpiResid>(lds, g, S, E);
        }
    }
}


extern "C" void kernel_launch(void* const* d_in, const int* in_sizes, int n_in, void* d_out, int out_size, void* d_ws, size_t ws_size, hipStream_t stream) {
    static int grid = 0;
    if (grid == 0) {
        if (n_in != 13 || ws_size < WS_END) { fprintf(stderr, "kernel_launch: unexpected inputs (n_in %d, ws %zu, need %zu)\n", n_in, ws_size, (size_t)WS_END); grid = -1; return; }
        int dev = 0, cus = 0, per_cu = 0;
        hipGetDevice(&dev); hipDeviceGetAttribute(&cus, hipDeviceAttributeMultiprocessorCount, dev);
        if (hipFuncSetAttribute((const void*)mega, hipFuncAttributeMaxDynamicSharedMemorySize, LDS_BYTES) != hipSuccess) { fprintf(stderr, "kernel_launch: hipFuncSetAttribute failed\n"); grid = -1; return; }
        if (hipOccupancyMaxActiveBlocksPerMultiprocessor(&per_cu, (const void*)mega, 512, LDS_BYTES) != hipSuccess || per_cu < 1) { fprintf(stderr, "kernel_launch: occupancy query gave %d\n", per_cu); per_cu = 1; }
        (void)hipGetLastError();
        grid = cus * 1;
        fprintf(stderr, "kernel_launch: cus %d per_cu %d grid %d\n", cus, per_cu, grid);
    }
    if (grid < 0) return;
    Args a{};
    for (int i = 0; i < 13; ++i) a.in[i] = (const float*)d_in[i];
    a.out = (float*)d_out; a.ws = (unsigned char*)d_ws; a.ph_lo = 0; a.ph_hi = NPH;
    void* args[] = {&a};
    hipError_t e = hipLaunchCooperativeKernel((const void*)mega, dim3(grid), dim3(512), args, LDS_BYTES, stream);
    if (e != hipSuccess) fprintf(stderr, "kernel_launch: cooperative launch failed: %s (grid %d)\n", hipGetErrorString(e), grid);
}
```

```cpp
#include <hip/hip_runtime.h>
#include <hip/hip_cooperative_groups.h>
#include <cstdio>
namespace cg = cooperative_groups;

#define LAS __attribute__((address_space(3)))
#define DI __device__ __forceinline__
typedef unsigned short bf16_t;
typedef short bf16x8 __attribute__((ext_vector_type(8)));
typedef float f32x4 __attribute__((ext_vector_type(4)));
typedef float f32x2 __attribute__((ext_vector_type(2)));
typedef float f32x16 __attribute__((ext_vector_type(16)));
typedef unsigned u32x4 __attribute__((ext_vector_type(4)));
typedef unsigned u32x2 __attribute__((ext_vector_type(2)));
typedef __bf16 bf16v2 __attribute__((ext_vector_type(2)));

constexpr int D = 1024, SEQ = 4096, MH = 16384, M_ALL = 32768, DEPTH = 4, NIN = 10240;
constexpr int LDS_BYTES = 163840;
constexpr float LOG2E = 1.4426950408889634f;
constexpr size_t ARR = (size_t)MH * D;

constexpr size_t WS_WIN = 1ull << 20;
constexpr size_t WS_WA = WS_WIN + (size_t)NIN * D * 2;
constexpr size_t WS_WB = WS_WA + (size_t)D * D * 2;
constexpr size_t WS_WO = WS_WB + (size_t)D * D * 2;
constexpr size_t WS_H = WS_WO + (size_t)D * D * 2;
constexpr size_t WS_OUT9 = WS_H + (size_t)M_ALL * D * 2;
constexpr size_t WS_G3 = WS_OUT9 + 6 * ARR * 2;
constexpr size_t WS_OF = WS_G3 + 6 * ARR * 2;
constexpr size_t WS_X = WS_OF + 2 * ARR * 2;
constexpr size_t WS_AC = WS_X + (size_t)64 * 32 * 16384 * 2;
constexpr size_t WS_ST = WS_AC + (size_t)64 * 32 * 128 * 4;
constexpr size_t WS_LBT = WS_ST + (size_t)MH * 8;
constexpr size_t WS_END = WS_LBT + 4096 * 4;

DI unsigned pk2(float lo, float hi) { f32x2 v = {lo, hi}; bf16v2 r = __builtin_convertvector(v, bf16v2); return __builtin_bit_cast(unsigned, r); }
DI float bflo(unsigned w) { return __uint_as_float(w << 16); }
DI float bfhi(unsigned w) { return __uint_as_float(w & 0xffff0000u); }
DI float fexp2(float x) { return __builtin_amdgcn_exp2f(x); }
DI float frcp(float x) { return __builtin_amdgcn_rcpf(x); }
DI float sigmoidf_(float x) { return frcp(1.0f + fexp2(-x * LOG2E)); }
DI float siluf_(float x) { return x * sigmoidf_(x); }
DI float geluf_(float x) { const float t = x + 0.044715f * x * x * x; return x * frcp(1.0f + fexp2(-2.3022082f * t)); }
DI float wave_sum(float v) {
#pragma unroll
    for (int o = 1; o < 64; o <<= 1) v += __shfl_xor(v, o);
    return v;
}
#define LDS_WAIT() asm volatile("s_waitcnt lgkmcnt(0)" ::: "memory")
template <int CTRL, int ROWMASK, bool BC> DI float dpp_f(float x) { return __int_as_float(__builtin_amdgcn_update_dpp(0, __float_as_int(x), CTRL, ROWMASK, 0xf, BC)); }
DI int opaque_tid() { int t = threadIdx.x; asm volatile("" : "+v"(t)); return t; }


#define XB_TMO      128
#define XB_XCNT(j)  (256  + 64 * (j))
#define XB_XSUB(j)  (1280 + 64 * (j))
#define XB_XGEN(j)  (2304 + 64 * (j))
#define XB_TOP      3328
#define XB_TOPGEN   3392
#define XCD_BAR_WORDS 3456
#define XB_SPIN_CAP (1u << 18)
DI unsigned xb_ld(unsigned* p)              { return __hip_atomic_load(p, __ATOMIC_RELAXED, __HIP_MEMORY_SCOPE_AGENT); }
DI unsigned xb_add(unsigned* p, unsigned v) { return __hip_atomic_fetch_add(p, v, __ATOMIC_RELAXED, __HIP_MEMORY_SCOPE_AGENT); }
DI unsigned xb_xcc_id() { return (unsigned)__builtin_amdgcn_s_getreg((3 << 11) | 20) & 0xFu; }
#define XB_SPIN(cond, bar) do { unsigned _sp = 0; while (cond) { __builtin_amdgcn_s_sleep(1); \
    if ((++_sp & 255u) == 0u) { if (xb_ld(&(bar)[XB_TMO])) break; if (_sp > XB_SPIN_CAP) { atomicAdd(&(bar)[XB_TMO], 1u); break; } } } } while (0)
struct XcdBarrier { unsigned* bar; unsigned x; volatile LAS unsigned* st; };
DI XcdBarrier xcd_barrier_post(unsigned* bar, volatile LAS unsigned* st) {
    XcdBarrier b; b.bar = bar; b.x = xb_xcc_id(); b.st = st;
    if (threadIdx.x == 0) (void)xb_add(&bar[XB_XCNT(b.x)], 1u);
    return b;
}
DI void xcd_barrier_complete(unsigned* bar, unsigned x, unsigned& nloc, unsigned& nx) {
    const unsigned G = gridDim.x * gridDim.y * gridDim.z;
    unsigned sum, cnt, mine, sp = 0u;
    for (;;) {
        sum = 0u; cnt = 0u; mine = 0u;
#pragma unroll
        for (unsigned j = 0; j < 16; ++j) { const unsigned c = xb_ld(&bar[XB_XCNT(j)]); sum += c; cnt += (c > 0u) ? 1u : 0u; mine = (j == x) ? c : mine; }
        if (sum == G) break;
        __builtin_amdgcn_s_sleep(1);
        if ((++sp & 255u) == 0u) { if (xb_ld(&bar[XB_TMO])) break; if (sp > XB_SPIN_CAP) { atomicAdd(&bar[XB_TMO], 1u); break; } }
    }
    nloc = mine > 0u ? mine : 1u; nx = cnt > 0u ? cnt : 1u;
}
DI void xcd_barrier(const XcdBarrier& b) {
    asm volatile("s_waitcnt vmcnt(0)" ::: "memory");
    __syncthreads();
    if (threadIdx.x == 0) {
        unsigned* bar = b.bar;
        __builtin_amdgcn_s_waitcnt(0);
        unsigned nloc = b.st[0], nx = b.st[1];
        if (nloc == 0u) { xcd_barrier_complete(bar, b.x, nloc, nx); b.st[0] = nloc; b.st[1] = nx; }
        const unsigned old = xb_add(&bar[XB_XSUB(b.x)], 1u);
        const unsigned gen = old / nloc;
        if (old + 1u == (gen + 1u) * nloc) {
            __builtin_amdgcn_fence(__ATOMIC_RELEASE, "agent");
            asm volatile("s_waitcnt vmcnt(0)" ::: "memory");
            const unsigned og = xb_add(&bar[XB_TOP], 1u);
            const unsigned tg = og / nx;
            if (og + 1u == (tg + 1u) * nx) xb_add(&bar[XB_TOPGEN], 1u);
            else XB_SPIN(xb_ld(&bar[XB_TOPGEN]) == tg, bar);
            __builtin_amdgcn_fence(__ATOMIC_ACQUIRE, "agent");
            xb_add(&bar[XB_XGEN(b.x)], 1u);
            asm volatile("s_waitcnt vmcnt(0)" ::: "memory");
        } else {
            XB_SPIN(xb_ld(&bar[XB_XGEN(b.x)]) == gen, bar);
            __builtin_amdgcn_fence(__ATOMIC_ACQUIRE, "agent");
            asm volatile("s_waitcnt vmcnt(0)" ::: "memory");
        }
    }
    __syncthreads();
}

namespace pg8 {
constexpr int BM = 256, BK = 64, HALF = 128, HTB = HALF * BK * 2, STAGE_BYTES = 8 * HTB, NXCD = 8, WGM = 8;
DI int lds_byte(int r, int c) { const int st = (r >> 4) * 2 + (c >> 5), rr = r & 15, cc = c & 31, ob = rr * 64 + cc * 2; return st * 1024 + (ob ^ (((ob >> 9) & 1) << 5)); }
DI void stage_rc(int b, int& R, int& C) { const int st = b / 1024, sb = b % 1024, swz = sb ^ (((sb >> 9) & 1) << 5); R = (st >> 1) * 16 + swz / 64; C = (st & 1) * 32 + (swz % 64) / 2; }
DI int perm32(int rho) { const int n = rho >> 4, i = rho & 15; return 8 * (i >> 2) + 4 * n + (i & 3); }

struct Unit { int pm, pn, sel; };
struct Gemm { const bf16_t* A0; const bf16_t* A1; const bf16_t* B0; const bf16_t* B1; int K; };
struct Order {
    int nM, nN, nwg, G, c, dual;
    DI void init(int M, int N, int G_, int c_, int dual_) { nM = M / BM; nN = N / BM; nwg = nM * nN; G = G_; c = c_; dual = dual_; }
    DI bool next(int i, Unit& u) const {
        const int ti = dual ? (i >> 1) : i; u.sel = dual ? (i & 1) : 0;
        const long L = (long)ti * G + c; if (L >= nwg) return false;
        int wgid = (int)L; { const int q = nwg / NXCD, r = nwg % NXCD, xcd = wgid % NXCD, off = wgid / NXCD; wgid = (xcd < r ? xcd * (q + 1) : r * (q + 1) + (xcd - r) * q) + off; }
        const int nig = WGM * nN, gid = wgid / nig, fm = gid * WGM, gsz = (nM - fm) < WGM ? (nM - fm) : WGM;
        u.pm = fm + ((wgid % nig) % gsz); u.pn = (wgid % nig) / gsz; return true;
    }
};

template <class Epi>
DI void gemm_phase(LAS unsigned char* lds, const Gemm g, const Order& S, const Epi& E) {
    const int tid = opaque_tid(), wid = __builtin_amdgcn_readfirstlane(tid >> 6), lane = tid & 63, wr = wid >> 2, wc = wid & 3, fr = lane & 15, fq = lane >> 4;
    const int K = g.K, nt = K / BK;
    unsigned voffA[2], voffB[2];
#pragma unroll
    for (int i = 0; i < 2; ++i) { int R, C; stage_rc(tid * 16 + i * 8192, R, C); const int Rb = Epi::PERM ? ((R & ~31) + perm32(R & 31)) : R;
        voffA[i] = (unsigned)(R * K + C) * 2u; voffB[i] = (unsigned)(Rb * K + C) * 2u; }
    const size_t kstep = (size_t)(BK * 2);
    const size_t hstep = (size_t)HALF * K * 2;
    const size_t tstep = 2 * hstep;
    const unsigned ldsw = (unsigned)wid * 1024u;
    const int aoff = lds_byte(wr * 64 + fr, fq * 8), boff = lds_byte(wc * 32 + fr, fq * 8);
#define PG8_SA(b, h) (((b) * 2 + (h)) * HTB)
#define PG8_SB(b, h) ((4 + (b) * 2 + (h)) * HTB)
#define PG8_STAGE(bufoff, gbase, voff) do { _Pragma("unroll") for (int _i = 0; _i < 2; ++_i) \
        __builtin_amdgcn_global_load_lds((const unsigned*)((const char*)(gbase) + (voff)[_i]), (LAS unsigned*)(lds + (bufoff) + ldsw + _i * 8192), 16, 0, 0); } while (0)
#define PG8_LDA(dst, b, h) do { _Pragma("unroll") for (int m = 0; m < 4; ++m) _Pragma("unroll") for (int k = 0; k < 2; ++k) dst[m][k] = *(const LAS bf16x8*)(lds + PG8_SA(b, h) + aoff + m * 2048 + k * 1024); } while (0)
#define PG8_LDB(dst, b, h) do { _Pragma("unroll") for (int n = 0; n < 2; ++n) _Pragma("unroll") for (int k = 0; k < 2; ++k) dst[n][k] = *(const LAS bf16x8*)(lds + PG8_SB(b, h) + boff + n * 2048 + k * 1024); } while (0)
#define PG8_MMA(ai, bj, At, Bt) do { __builtin_amdgcn_s_setprio(1); _Pragma("unroll") for (int m = 0; m < 4; ++m) _Pragma("unroll") for (int n = 0; n < 2; ++n) _Pragma("unroll") for (int k = 0; k < 2; ++k) \
        acc[ai][bj][m][n] = __builtin_amdgcn_mfma_f32_16x16x32_bf16(Bt[n][k], At[m][k], acc[ai][bj][m][n], 0, 0, 0); __builtin_amdgcn_s_setprio(0); } while (0)
#define PG8_WAIT_V(n) asm volatile("s_waitcnt vmcnt(" #n ")" ::: "memory")
#define PG8_WAIT_L(n) asm volatile("s_waitcnt lgkmcnt(" #n ")" ::: "memory")
#define PG8_BAR __builtin_amdgcn_s_barrier()
#define PG8_SCHED __builtin_amdgcn_sched_barrier(0)
    Unit cur, nxt; int ui = 0;
    if (!S.next(0, cur)) return;
    f32x4 acc[2][2][4][2];
#pragma unroll
    for (int a = 0; a < 2; ++a)
#pragma unroll
        for (int b = 0; b < 2; ++b)
#pragma unroll
            for (int m = 0; m < 4; ++m)
#pragma unroll
                for (int n = 0; n < 2; ++n) acc[a][b][m][n] = (f32x4){0.f, 0.f, 0.f, 0.f};
    bf16x8 At[4][2], B0[2][2], B1[2][2];
    const char* cA = (const char*)(cur.sel ? g.A1 : g.A0) + (size_t)cur.pm * tstep; const char* cB = (const char*)(cur.sel ? g.B1 : g.B0) + (size_t)cur.pn * tstep;
    PG8_STAGE(PG8_SB(0, 0), cB, voffB); PG8_STAGE(PG8_SB(0, 1), cB + hstep, voffB); PG8_STAGE(PG8_SA(0, 0), cA, voffA); PG8_STAGE(PG8_SA(0, 1), cA + hstep, voffA);
    if (wr == 1) PG8_BAR;
    PG8_WAIT_V(2); PG8_BAR;
    PG8_STAGE(PG8_SB(1, 0), cB + kstep, voffB); PG8_STAGE(PG8_SA(1, 0), cA + kstep, voffA); PG8_STAGE(PG8_SB(1, 1), cB + hstep + kstep, voffB);
    PG8_WAIT_V(6); PG8_BAR;
    for (;;) {
        const bool has_next = S.next(ui + 1, nxt);
        const char* nA = has_next ? (const char*)(nxt.sel ? g.A1 : g.A0) + (size_t)nxt.pm * tstep : cA; const char* nB = has_next ? (const char*)(nxt.sel ? g.B1 : g.B0) + (size_t)nxt.pn * tstep : cB;
        for (int t = 0; t < nt; t += 2) {
            const bool last = (t == nt - 2);
            const char* a1 = cA + (size_t)(t + 1) * kstep;
            const char* a2 = last ? nA : cA + (size_t)(t + 2) * kstep; const char* b2 = last ? nB : cB + (size_t)(t + 2) * kstep;
            const char* a3 = a2 + kstep; const char* b3 = b2 + kstep;
            PG8_LDB(B0, 0, 0); PG8_LDB(B1, 0, 1); PG8_SCHED; PG8_LDA(At, 0, 0); PG8_STAGE(PG8_SA(1, 1), a1 + hstep, voffA);
            PG8_WAIT_V(8); PG8_WAIT_L(0); PG8_BAR; PG8_MMA(0, 0, At, B0); PG8_MMA(0, 1, At, B1); PG8_BAR; PG8_SCHED;
            PG8_LDA(At, 0, 1); PG8_STAGE(PG8_SB(0, 0), b2, voffB); PG8_STAGE(PG8_SB(0, 1), b2 + hstep, voffB); PG8_STAGE(PG8_SA(0, 0), a2, voffA);
            PG8_WAIT_V(8); PG8_WAIT_L(0); PG8_BAR; PG8_MMA(1, 0, At, B0); PG8_MMA(1, 1, At, B1); PG8_BAR; PG8_SCHED;
            PG8_LDB(B0, 1, 0); PG8_LDB(B1, 1, 1); PG8_SCHED; PG8_LDA(At, 1, 0); PG8_STAGE(PG8_SA(0, 1), a2 + hstep, voffA);
            PG8_WAIT_V(8); PG8_WAIT_L(0); PG8_BAR; PG8_MMA(0, 0, At, B0); PG8_MMA(0, 1, At, B1); PG8_BAR; PG8_SCHED;
            PG8_LDA(At, 1, 1); PG8_STAGE(PG8_SB(1, 0), b3, voffB); PG8_STAGE(PG8_SB(1, 1), b3 + hstep, voffB); PG8_STAGE(PG8_SA(1, 0), a3, voffA);
            PG8_WAIT_V(8); PG8_WAIT_L(0); PG8_BAR; PG8_MMA(1, 0, At, B0); PG8_MMA(1, 1, At, B1); PG8_BAR; PG8_SCHED;
        }
        if (wr == 0) PG8_BAR;
        E(acc, cur, wr, wc, fr, fq);
        if (!has_next) break;
#pragma unroll
        for (int a = 0; a < 2; ++a)
#pragma unroll
            for (int b = 0; b < 2; ++b)
#pragma unroll
                for (int m = 0; m < 4; ++m)
#pragma unroll
                    for (int n = 0; n < 2; ++n) acc[a][b][m][n] = (f32x4){0.f, 0.f, 0.f, 0.f};
        cur = nxt; cA = nA; cB = nB; ++ui;
        if (wr == 1) PG8_BAR;
    }
    PG8_WAIT_V(0);
    PG8_BAR;
#undef PG8_SA
#undef PG8_SB
#undef PG8_STAGE
#undef PG8_LDA
#undef PG8_LDB
#undef PG8_MMA
#undef PG8_WAIT_V
#undef PG8_WAIT_L
#undef PG8_BAR
#undef PG8_SCHED
}
}

template <int ACT> DI float act_fn(float x) {
    if (ACT == 0) return x;
    if (ACT == 1) return siluf_(x) * 0.08838834764831845f;
    if (ACT == 2) return siluf_(x);
    if (ACT == 3) return geluf_(x);
    return sigmoidf_(x);
}
template <int ACT> DI void store_act(const f32x4 (&acc)[2][2][4][2], bf16_t* base, int row0, int col0) {
#pragma unroll
    for (int ai = 0; ai < 2; ++ai)
#pragma unroll
        for (int m = 0; m < 4; ++m) { bf16_t* rowp = base + (size_t)(row0 + ai * 128 + m * 16) * D + col0;
#pragma unroll
            for (int bj = 0; bj < 2; ++bj) { const f32x4 v0 = acc[ai][bj][m][0], v1 = acc[ai][bj][m][1];
                u32x4 w; w.x = pk2(act_fn<ACT>(v0[0]), act_fn<ACT>(v0[1])); w.y = pk2(act_fn<ACT>(v0[2]), act_fn<ACT>(v0[3]));
                w.z = pk2(act_fn<ACT>(v1[0]), act_fn<ACT>(v1[1])); w.w = pk2(act_fn<ACT>(v1[2]), act_fn<ACT>(v1[3]));
                *(u32x4*)(rowp + bj * 128) = w; } }
}
struct EpiInProj {
    static constexpr bool PERM = true;
    bf16_t* out9; bf16_t* g3;
    DI void operator()(const f32x4 (&acc)[2][2][4][2], const pg8::Unit& u, int wr, int wc, int fr, int fq) const {
        const int pn = u.pn, row0 = u.pm * 256 + wr * 64 + fr, cl = wc * 32 + 8 * fq;
        if (pn >= 20 && pn < 28) {
            bf16_t* base = g3; const int col0 = 128 * (pn - 20) + cl;
#pragma unroll
            for (int ai = 0; ai < 2; ++ai)
#pragma unroll
                for (int m = 0; m < 4; ++m) { bf16_t* rowp = base + (size_t)(row0 + ai * 128 + m * 16) * D + col0;
                    const f32x4 u0 = acc[ai][0][m][0], u1 = acc[ai][0][m][1], g0 = acc[ai][1][m][0], g1 = acc[ai][1][m][1];
                    u32x4 w; w.x = pk2(geluf_(u0[0]) * siluf_(g0[0]), geluf_(u0[1]) * siluf_(g0[1])); w.y = pk2(geluf_(u0[2]) * siluf_(g0[2]), geluf_(u0[3]) * siluf_(g0[3]));
                    w.z = pk2(geluf_(u1[0]) * siluf_(g1[0]), geluf_(u1[1]) * siluf_(g1[1])); w.w = pk2(geluf_(u1[2]) * siluf_(g1[2]), geluf_(u1[3]) * siluf_(g1[3]));
                    *(u32x4*)rowp = w; }
            return;
        }
        int idx, ct;
        if (pn < 20) { idx = pn >> 2; ct = pn & 3; } else if (pn < 32) { idx = 6; ct = pn - 28; } else { idx = 7 + ((pn - 32) >> 2); ct = (pn - 32) & 3; }
        bf16_t* base = (idx <= 4) ? out9 + (size_t)idx * ARR : (idx == 6 ? out9 + 5 * ARR : g3 + (size_t)(idx - 6) * 2 * ARR); const int col0 = 256 * ct + cl;
        if (idx == 0) store_act<1>(acc, base, row0, col0);
        else if (idx <= 3) store_act<0>(acc, base, row0, col0);
        else if (idx == 4) store_act<0>(acc, base, row0, col0);
        else if (idx == 6) store_act<3>(acc, base, row0, col0);
        else store_act<4>(acc, base, row0, col0);
    }
};
struct EpiProjAB {
    static constexpr bool PERM = true;
    const bf16_t* SMA; const bf16_t* SMB; bf16_t* MG;
    DI void operator()(const f32x4 (&acc)[2][2][4][2], const pg8::Unit& u, int wr, int wc, int fr, int fq) const {
        const int row0 = u.pm * 256 + wr * 64 + fr, col0 = u.pn * 256 + wc * 32 + 8 * fq;
        const bf16_t* gate = u.sel ? SMB : SMA;
#pragma unroll
        for (int ai = 0; ai < 2; ++ai)
#pragma unroll
            for (int m = 0; m < 4; ++m) { const size_t off = (size_t)(row0 + ai * 128 + m * 16) * D + col0;
#pragma unroll
                for (int bj = 0; bj < 2; ++bj) { const f32x4 v0 = acc[ai][bj][m][0], v1 = acc[ai][bj][m][1];
                    const u32x4 gw = *(const u32x4*)(gate + off + bj * 128);
                    float o[8] = {v0[0] * bflo(gw.x), v0[1] * bfhi(gw.x), v0[2] * bflo(gw.y), v0[3] * bfhi(gw.y), v1[0] * bflo(gw.z), v1[1] * bfhi(gw.z), v1[2] * bflo(gw.w), v1[3] * bfhi(gw.w)};
                    if (u.sel) { const u32x4 tw = *(const u32x4*)(MG + off + bj * 128);
                        o[0] += bflo(tw.x); o[1] += bfhi(tw.x); o[2] += bflo(tw.y); o[3] += bfhi(tw.y); o[4] += bflo(tw.z); o[5] += bfhi(tw.z); o[6] += bflo(tw.w); o[7] += bfhi(tw.w); }
                    u32x4 w; w.x = pk2(o[0], o[1]); w.y = pk2(o[2], o[3]); w.z = pk2(o[4], o[5]); w.w = pk2(o[6], o[7]);
                    *(u32x4*)(MG + off + bj * 128) = w; }
                asm volatile("" ::: "memory"); }
    }
};
struct EpiResid {
    static constexpr bool PERM = false;
    const float* xin; float* out;
    DI void operator()(const f32x4 (&acc)[2][2][4][2], const pg8::Unit& u, int wr, int wc, int fr, int fq) const {
        const int row0 = u.pm * 256 + wr * 64 + fr, col0 = u.pn * 256 + wc * 32 + 4 * fq;
#pragma unroll
        for (int ai = 0; ai < 2; ++ai)
#pragma unroll
            for (int m = 0; m < 4; ++m) { const size_t off = (size_t)(row0 + ai * 128 + m * 16) * D + col0;
#pragma unroll
                for (int bj = 0; bj < 2; ++bj)
#pragma unroll
                    for (int n = 0; n < 2; ++n) { const f32x4 xv = *(const f32x4*)(xin + off + bj * 128 + n * 16); *(f32x4*)(out + off + bj * 128 + n * 16) = xv + acc[ai][bj][m][n]; }
                asm volatile("" ::: "memory"); }
    }
};

DI int src_col(int nv) {
    if (nv < 5120) return nv;
    if (nv < 7168) { const int t = (nv - 5120) >> 8, w = (nv - 5120) & 255; return w < 128 ? 5120 + 128 * t + w : 7168 + 128 * t + (w - 128); }
    if (nv < 8192) return 6144 + (nv - 7168);
    return nv;
}
DI void transpose_item(const float* W, int N, bf16_t* WT, int k0, int nsrc0, int nvirt0, LAS float* scr, int lane) {
#pragma unroll 8
    for (int i = 0; i < 32; ++i) { const int kk = 2 * i + (lane >> 5); scr[kk * 33 + (lane & 31)] = W[(size_t)(k0 + kk) * N + nsrc0 + (lane & 31)]; }
    LDS_WAIT();
    const int c = lane & 7;
#pragma unroll
    for (int j = 0; j < 4; ++j) { const int n = (lane >> 3) + 8 * j; const LAS float* s = scr + (8 * c) * 33 + n;
        u32x4 o; o.x = pk2(s[0 * 33], s[1 * 33]); o.y = pk2(s[2 * 33], s[3 * 33]); o.z = pk2(s[4 * 33], s[5 * 33]); o.w = pk2(s[6 * 33], s[7 * 33]);
        *(u32x4*)(WT + (size_t)(nvirt0 + n) * D + k0 + 8 * c) = o; }
    LDS_WAIT();
}
DI void phase_prep(LAS unsigned char* lds, const float* w_in, const float* wa, const float* wb, const float* wo, unsigned char* ws, int G) {
    const int tid_ = opaque_tid(); const int lane = tid_ & 63, wave = __builtin_amdgcn_readfirstlane(tid_ >> 6);
    LAS float* scr = (LAS float*)(lds + wave * 16384);
    const int gw = blockIdx.x * 8 + wave, NGW = G * 8;
    constexpr int I_IN = 16 * 320, I_P = 16 * 32, PER_L = I_IN + 3 * I_P;
    for (int it = gw; it < PER_L; it += NGW) {
        int r = it;
        if (r < I_IN) { const int kb = r / 320, nb = r % 320; transpose_item(w_in, NIN, (bf16_t*)(ws + WS_WIN), 64 * kb, src_col(32 * nb), 32 * nb, scr, lane); continue; }
        r -= I_IN; const int which = r / I_P; r %= I_P; const int kb = r / 32, nb = r % 32;
        const float* W = (which == 0 ? wa : which == 1 ? wb : wo);
        bf16_t* WT = (bf16_t*)(ws + (which == 0 ? WS_WA : which == 1 ? WS_WB : WS_WO));
        transpose_item(W, D, WT, 64 * kb, 32 * nb, 32 * nb, scr, lane);
    }
}
DI void phase_rms_bf16(const float* x, const float* w, bf16_t* h, int nrows, int G) {
    const int tid_ = opaque_tid(); const int lane = tid_ & 63, wave = __builtin_amdgcn_readfirstlane(tid_ >> 6);
    const int gw = blockIdx.x * 8 + wave, NGW = G * 8;
    f32x4 wv[4];
#pragma unroll
    for (int j = 0; j < 4; ++j) wv[j] = ((const f32x4*)w)[lane + 64 * j];
    for (int m = gw; m < nrows; m += NGW) {
        const f32x4* xr = (const f32x4*)(x + (size_t)m * D) + lane; f32x4 v[4]; float s = 0.f;
#pragma unroll
        for (int j = 0; j < 4; ++j) { v[j] = xr[64 * j]; s += (v[j].x * v[j].x + v[j].y * v[j].y) + (v[j].z * v[j].z + v[j].w * v[j].w); }
        const float rstd = rsqrtf(wave_sum(s) * (1.0f / D) + 1e-6f);
        u32x2* o8 = (u32x2*)(h + (size_t)m * D) + lane;
#pragma unroll
        for (int j = 0; j < 4; ++j) { u32x2 o; o.x = pk2(v[j].x * rstd * wv[j].x, v[j].y * rstd * wv[j].y); o.y = pk2(v[j].z * rstd * wv[j].z, v[j].w * rstd * wv[j].w); o8[64 * j] = o; }
    }
}
DI void phase_final(float* x, const float* w, int nrows, int G) {
    const int tid_ = opaque_tid(); const int lane = tid_ & 63, wave = __builtin_amdgcn_readfirstlane(tid_ >> 6);
    const int gw = blockIdx.x * 8 + wave, NGW = G * 8;
    f32x4 wv[4];
#pragma unroll
    for (int j = 0; j < 4; ++j) wv[j] = ((const f32x4*)w)[lane + 64 * j];
    for (int m = gw; m < nrows; m += NGW) {
        f32x4* xr = (f32x4*)(x + (size_t)m * D) + lane; f32x4 v[4]; float s = 0.f;
#pragma unroll
        for (int j = 0; j < 4; ++j) { v[j] = xr[64 * j]; s += (v[j].x * v[j].x + v[j].y * v[j].y) + (v[j].z * v[j].z + v[j].w * v[j].w); }
        const float rstd = rsqrtf(wave_sum(s) * (1.0f / D) + 1e-6f);
#pragma unroll
        for (int j = 0; j < 4; ++j) xr[64 * j] = v[j] * rstd * wv[j];
    }
}
#define MFMA32(a, b, c) __builtin_amdgcn_mfma_f32_32x32x16_bf16((a), (b), (c), 0, 0, 0)
struct S1Regs { u32x4 q0, q1, z0, z1, v0, v1; };
DI size_t s1_rowoff(int it, int sub, int j) {
    const int sc = it & 31, dir = (it >> 5) & 1, h = (it >> 6) & 7, b = it >> 9, p = 64 * sub + j;
    return ((size_t)b * SEQ + sc * 128 + (dir ? 127 - p : p)) * D + h * 128;
}
DI void s1_load(S1Regs& R, const bf16_t* Q, const bf16_t* Z, const bf16_t* Iv, int it, int sub, int tid) {
    const size_t off = s1_rowoff(it, sub, tid >> 3) + 16 * (tid & 7);
    const bf16_t* zp = Z + (size_t)((it >> 5) & 1) * ARR;
    R.q0 = *(const u32x4*)(Q + off); R.q1 = *(const u32x4*)(Q + off + 8);
    R.z0 = *(const u32x4*)(zp + off); R.z1 = *(const u32x4*)(zp + off + 8);
    R.v0 = *(const u32x4*)(Iv + off); R.v1 = *(const u32x4*)(Iv + off + 8);
}
DI void phase_s1(LAS unsigned char* lds, const bf16_t* Q, bf16_t* Z, const bf16_t* Iv, bf16_t* O, bf16_t* X, float* AC, const float* LBT, int G) {
    const int tid = opaque_tid(), lane = tid & 63, wave = __builtin_amdgcn_readfirstlane(tid >> 6);
    const int r = lane & 31, hh = lane >> 5, j8 = tid >> 3, cg8 = tid & 7;
    LAS bf16_t* TQ = (LAS bf16_t*)(lds);
    LAS bf16_t* TV = (LAS bf16_t*)(lds + 17408);
    LAS bf16_t* TZ = (LAS bf16_t*)(lds + 34816);
    LAS bf16_t* QS = (LAS bf16_t*)(lds + 52224);
    LAS bf16_t* KSA = (LAS bf16_t*)(lds + 69632);
    LAS bf16_t* KSB = (LAS bf16_t*)(lds + 87040);
    LAS bf16_t* KHT = (LAS bf16_t*)(lds + 104448);
    LAS bf16_t* VT = (LAS bf16_t*)(lds + 122880);
    LAS float* TA = (LAS float*)(lds + 157696);
    LAS float* AA = TA + 128;
    LAS float* AB = TA + 256;
    LAS bf16_t* PS = TV;
    S1Regs R;
    int it = blockIdx.x;
    if (it < 2048) s1_load(R, Q, Z, Iv, it, 0, tid);
    __syncthreads();
    for (; it < 2048; it += G) {
        const int sc = it & 31, dir = (it >> 5) & 1, h = (it >> 6) & 7, b = it >> 9, seq = (b * 8 + h) * 2 + dir;
        f32x16 DA[2];
#pragma unroll
        for (int sub = 0; sub < 2; ++sub) {
            *(LAS u32x4*)(TQ + j8 * 136 + 16 * cg8) = R.q0; *(LAS u32x4*)(TQ + j8 * 136 + 16 * cg8 + 8) = R.q1;
            *(LAS u32x4*)(TZ + j8 * 136 + 16 * cg8) = R.z0; *(LAS u32x4*)(TZ + j8 * 136 + 16 * cg8 + 8) = R.z1;
            *(LAS u32x4*)(TV + j8 * 136 + 16 * cg8) = R.v0; *(LAS u32x4*)(TV + j8 * 136 + 16 * cg8 + 8) = R.v1;
            __syncthreads();
            {
                const float* lp = LBT + dir * 2048 + h * 128 + 16 * wave;
                const u32x4 z0 = *(const LAS u32x4*)(TZ + lane * 136 + 16 * wave), z1 = *(const LAS u32x4*)(TZ + lane * 136 + 16 * wave + 8);
                const u32x4 q0 = *(const LAS u32x4*)(TQ + lane * 136 + 16 * wave), q1 = *(const LAS u32x4*)(TQ + lane * 136 + 16 * wave + 8);
                const u32x4 v0 = *(const LAS u32x4*)(TV + lane * 136 + 16 * wave), v1 = *(const LAS u32x4*)(TV + lane * 136 + 16 * wave + 8);
                const unsigned zw[8] = {z0.x, z0.y, z0.z, z0.w, z1.x, z1.y, z1.z, z1.w};
                const unsigned qw[8] = {q0.x, q0.y, q0.z, q0.w, q1.x, q1.y, q1.z, q1.w};
                const unsigned vw[8] = {v0.x, v0.y, v0.z, v0.w, v1.x, v1.y, v1.z, v1.w};
                float kk[16], gg[16], lbv[16], omv[16];
#pragma unroll
                for (int i = 0; i < 16; ++i) { lbv[i] = lp[i]; omv[i] = lp[1024 + i]; }
                if (sub == 0) s1_load(R, Q, Z, Iv, it, 1, tid); else if (it + G < 2048) s1_load(R, Q, Z, Iv, it + G, 0, tid);
#pragma unroll
                for (int i = 0; i < 16; ++i) { const unsigned w = zw[i >> 1]; float z = (i & 1) ? bfhi(w) : bflo(w); z = __builtin_amdgcn_fmed3f(z, -30.f, 30.f);
                    const float e = fexp2(-z * LOG2E), sg = frcp(1.0f + e); const float om = omv[i];
                    kk[i] = om * e * sg; gg[i] = __builtin_amdgcn_logf(lbv[i] + om * sg); }
#pragma unroll
                for (int i = 0; i < 16; ++i) {
                    float x = gg[i];
                    x += dpp_f<0x111, 0xf, true>(x); x += dpp_f<0x112, 0xf, true>(x); x += dpp_f<0x114, 0xf, true>(x); x += dpp_f<0x118, 0xf, true>(x);
                    x += dpp_f<0x142, 0xa, false>(x); x += dpp_f<0x143, 0xc, false>(x);
                    gg[i] = x; }
                float aa[16], ta[16];
                if (sub == 1) {
#pragma unroll
                    for (int q4 = 0; q4 < 4; ++q4) { const f32x4 a4 = *(const LAS f32x4*)(AA + 16 * wave + 4 * q4), t4 = *(const LAS f32x4*)(TA + 16 * wave + 4 * q4);
                        aa[4 * q4] = a4.x; aa[4 * q4 + 1] = a4.y; aa[4 * q4 + 2] = a4.z; aa[4 * q4 + 3] = a4.w; ta[4 * q4] = t4.x; ta[4 * q4 + 1] = t4.y; ta[4 * q4 + 2] = t4.z; ta[4 * q4 + 3] = t4.w; }
                }
                unsigned qo[8], ko[8], kh[8], qh[8];
                float a16[16], t16[16], f16_[16];
#pragma unroll
                for (int w = 0; w < 8; ++w) {
                    float qt_[2], kt_[2], kh_[2], qh_[2];
#pragma unroll
                    for (int e2 = 0; e2 < 2; ++e2) { const int i = 2 * w + e2; const float qf = e2 ? bfhi(qw[w]) : bflo(qw[w]);
                        const float Rr = __int_as_float(__builtin_amdgcn_readlane(__float_as_int(gg[i]), 31)), G63 = __int_as_float(__builtin_amdgcn_readlane(__float_as_int(gg[i]), 63));
                        const float dq = gg[i] - Rr;
                        qt_[e2] = qf * fexp2(fminf(dq, 100.f)); kt_[e2] = kk[i] * fexp2(fminf(-dq, 100.f));
                        a16[i] = fexp2(gg[i]); kh_[e2] = kk[i] * fexp2(G63 - gg[i]); t16[i] = gg[i] - Rr;
                        if (sub == 0) { qh_[e2] = qf * a16[i]; } else { qh_[e2] = qf * a16[i] * aa[i]; f16_[i] = fexp2(Rr + ta[i]); } }
                    qo[w] = pk2(qt_[0], qt_[1]); ko[w] = pk2(kt_[0], kt_[1]); kh[w] = pk2(kh_[0], kh_[1]); qh[w] = pk2(qh_[0], qh_[1]);
                }
                LAS bf16_t* KSx = (sub == 0) ? KSA : KSB;
                *(LAS u32x4*)(QS + lane * 136 + 16 * wave) = (u32x4){qo[0], qo[1], qo[2], qo[3]}; *(LAS u32x4*)(QS + lane * 136 + 16 * wave + 8) = (u32x4){qo[4], qo[5], qo[6], qo[7]};
                *(LAS u32x4*)(KSx + lane * 136 + 16 * wave) = (u32x4){ko[0], ko[1], ko[2], ko[3]}; *(LAS u32x4*)(KSx + lane * 136 + 16 * wave + 8) = (u32x4){ko[4], ko[5], ko[6], ko[7]};
                *(LAS u32x4*)(TZ + lane * 136 + 16 * wave) = (u32x4){qh[0], qh[1], qh[2], qh[3]}; *(LAS u32x4*)(TZ + lane * 136 + 16 * wave + 8) = (u32x4){qh[4], qh[5], qh[6], qh[7]};
#pragma unroll
                for (int w = 0; w < 8; ++w) {
                    KHT[(16 * wave + 2 * w) * 72 + lane] = (bf16_t)(kh[w] & 0xffffu); KHT[(16 * wave + 2 * w + 1) * 72 + lane] = (bf16_t)(kh[w] >> 16);
                    VT[(16 * wave + 2 * w) * 136 + 64 * sub + lane] = (bf16_t)(vw[w] & 0xffffu); VT[(16 * wave + 2 * w + 1) * 136 + 64 * sub + lane] = (bf16_t)(vw[w] >> 16);
                }
                if (sub == 0) {
                    if (lane == 63) {
#pragma unroll
                        for (int q4 = 0; q4 < 4; ++q4) { *(LAS f32x4*)(TA + 16 * wave + 4 * q4) = (f32x4){t16[4 * q4], t16[4 * q4 + 1], t16[4 * q4 + 2], t16[4 * q4 + 3]};
                            *(LAS f32x4*)(AA + 16 * wave + 4 * q4) = (f32x4){a16[4 * q4], a16[4 * q4 + 1], a16[4 * q4 + 2], a16[4 * q4 + 3]}; }
                    }
                } else {
                    const u32x4 k0 = *(const LAS u32x4*)(KSA + lane * 136 + 16 * wave), k1 = *(const LAS u32x4*)(KSA + lane * 136 + 16 * wave + 8);
                    const unsigned kw[8] = {k0.x, k0.y, k0.z, k0.w, k1.x, k1.y, k1.z, k1.w}; unsigned kn[8];
#pragma unroll
                    for (int w = 0; w < 8; ++w) kn[w] = pk2(bflo(kw[w]) * f16_[2 * w], bfhi(kw[w]) * f16_[2 * w + 1]);
                    *(LAS u32x4*)(KSA + lane * 136 + 16 * wave) = (u32x4){kn[0], kn[1], kn[2], kn[3]}; *(LAS u32x4*)(KSA + lane * 136 + 16 * wave + 8) = (u32x4){kn[4], kn[5], kn[6], kn[7]};
                    if (lane == 63) { float* ap = AC + ((size_t)seq * 32 + sc) * 128 + 16 * wave;
#pragma unroll
                        for (int q4 = 0; q4 < 4; ++q4) { *(LAS f32x4*)(AB + 16 * wave + 4 * q4) = (f32x4){a16[4 * q4], a16[4 * q4 + 1], a16[4 * q4 + 2], a16[4 * q4 + 3]};
                            *(f32x4*)(ap + 4 * q4) = (f32x4){a16[4 * q4] * aa[4 * q4], a16[4 * q4 + 1] * aa[4 * q4 + 1], a16[4 * q4 + 2] * aa[4 * q4 + 2], a16[4 * q4 + 3] * aa[4 * q4 + 3]}; } }
                }
            }
            __syncthreads();
            {
                LAS bf16_t* KSx = (sub == 0) ? KSA : KSB;
                if (wave < 3) {
                    const int tm = (wave == 2) ? 1 : 0, tn = (wave == 0) ? 0 : 1;
                    f32x16 acc;
#pragma unroll
                    for (int i = 0; i < 16; ++i) acc[i] = 0.f;
#pragma unroll
                    for (int ks = 0; ks < 8; ++ks) { const bf16x8 a = *(const LAS bf16x8*)(KSx + (32 * tm + r) * 136 + 16 * ks + 8 * hh), bb = *(const LAS bf16x8*)(QS + (32 * tn + r) * 136 + 16 * ks + 8 * hh); acc = MFMA32(a, bb, acc); }
                    const int t = 32 * tn + r;
#pragma unroll
                    for (int g = 0; g < 4; ++g) { const int s0 = 32 * tm + 8 * g + 4 * hh;
                        const float p0 = (s0 + 0 <= t) ? acc[4 * g + 0] : 0.f, p1 = (s0 + 1 <= t) ? acc[4 * g + 1] : 0.f, p2 = (s0 + 2 <= t) ? acc[4 * g + 2] : 0.f, p3 = (s0 + 3 <= t) ? acc[4 * g + 3] : 0.f;
                        *(LAS u32x2*)(PS + t * 136 + 64 * sub + s0) = (u32x2){pk2(p0, p1), pk2(p2, p3)}; }
                } else if (sub == 1 && wave < 7) {
                    const int tm = (wave - 3) >> 1, tn = (wave - 3) & 1;
                    f32x16 acc;
#pragma unroll
                    for (int i = 0; i < 16; ++i) acc[i] = 0.f;
#pragma unroll
                    for (int ks = 0; ks < 8; ++ks) { const bf16x8 a = *(const LAS bf16x8*)(KSA + (32 * tm + r) * 136 + 16 * ks + 8 * hh), bb = *(const LAS bf16x8*)(QS + (32 * tn + r) * 136 + 16 * ks + 8 * hh); acc = MFMA32(a, bb, acc); }
                    const int t = 32 * tn + r;
#pragma unroll
                    for (int g = 0; g < 4; ++g) { const int s0 = 32 * tm + 8 * g + 4 * hh;
                        *(LAS u32x2*)(PS + t * 136 + s0) = (u32x2){pk2(acc[4 * g], acc[4 * g + 1]), pk2(acc[4 * g + 2], acc[4 * g + 3])}; }
                }
#pragma unroll
                for (int k = 0; k < 2; ++k) {
                    const int vt = wave >> 1, dt = 2 * (wave & 1) + k;
                    f32x16 acc;
                    if (sub == 0) {
#pragma unroll
                        for (int i = 0; i < 16; ++i) acc[i] = 0.f;
                    } else { const float ab = AB[32 * dt + r];
#pragma unroll
                        for (int i = 0; i < 16; ++i) acc[i] = DA[k][i] * ab; }
#pragma unroll
                    for (int ks = 0; ks < 4; ++ks) { const bf16x8 a = *(const LAS bf16x8*)(VT + (32 * vt + r) * 136 + 64 * sub + 16 * ks + 8 * hh), bb = *(const LAS bf16x8*)(KHT + (32 * dt + r) * 72 + 16 * ks + 8 * hh); acc = MFMA32(a, bb, acc); }
                    if (sub == 0) DA[k] = acc;
                    else { bf16_t* xp = X + ((size_t)seq * 32 + sc) * 16384 + (size_t)(32 * vt + 4 * hh) * 128 + 32 * dt + r;
#pragma unroll
                        for (int i = 0; i < 16; i += 2) { const unsigned p = pk2(acc[i], acc[i + 1]); const int v0 = (i & 3) + 8 * (i >> 2);
                            xp[(size_t)v0 * 128] = (bf16_t)(p & 0xffffu); xp[(size_t)(v0 + 1) * 128] = (bf16_t)(p >> 16); } }
                }
                {
                    bf16_t* zp = Z + (size_t)dir * ARR + s1_rowoff(it, sub, j8) + 16 * cg8;
                    *(u32x4*)zp = *(const LAS u32x4*)(TZ + j8 * 136 + 16 * cg8); *(u32x4*)(zp + 8) = *(const LAS u32x4*)(TZ + j8 * 136 + 16 * cg8 + 8);
                }
            }
            __syncthreads();
            {
                const int vt = wave & 3, tn = wave >> 2;
                f32x16 acc;
#pragma unroll
                for (int i = 0; i < 16; ++i) acc[i] = 0.f;
                if (sub == 1) {
#pragma unroll
                    for (int ks = 0; ks < 4; ++ks) { const bf16x8 a = *(const LAS bf16x8*)(VT + (32 * vt + r) * 136 + 16 * ks + 8 * hh), bb = *(const LAS bf16x8*)(PS + (32 * tn + r) * 136 + 16 * ks + 8 * hh); acc = MFMA32(a, bb, acc); }
                }
#pragma unroll
                for (int ks = 0; ks < 4; ++ks) { if (ks < 2 * (tn + 1)) { const bf16x8 a = *(const LAS bf16x8*)(VT + (32 * vt + r) * 136 + 64 * sub + 16 * ks + 8 * hh), bb = *(const LAS bf16x8*)(PS + (32 * tn + r) * 136 + 64 * sub + 16 * ks + 8 * hh); acc = MFMA32(a, bb, acc); } }
                LAS bf16_t* op = QS + (32 * tn + r) * 136 + 32 * vt + 4 * hh;
#pragma unroll
                for (int g = 0; g < 4; ++g) *(LAS u32x2*)(op + 8 * g) = (u32x2){pk2(acc[4 * g], acc[4 * g + 1]), pk2(acc[4 * g + 2], acc[4 * g + 3])};
            }
            __syncthreads();
            {
                bf16_t* op = O + (size_t)dir * ARR + s1_rowoff(it, sub, j8) + 16 * cg8;
                *(u32x4*)op = *(const LAS u32x4*)(QS + j8 * 136 + 16 * cg8); *(u32x4*)(op + 8) = *(const LAS u32x4*)(QS + j8 * 136 + 16 * cg8 + 8);
            }
        }
    }
}
DI void phase_lnstats(const bf16_t* GV, f32x2* STATS, int G) {
    const int tid_ = opaque_tid(); const int lane = tid_ & 63, wave = __builtin_amdgcn_readfirstlane(tid_ >> 6);
    const int gw = blockIdx.x * 8 + wave, NGW = G * 8;
    for (int m = gw; m < MH; m += NGW) {
        const bf16_t* p = GV + (size_t)m * D + 16 * lane;
        const u32x4 a0 = *(const u32x4*)p, a1 = *(const u32x4*)(p + 8);
        const unsigned aw[8] = {a0.x, a0.y, a0.z, a0.w, a1.x, a1.y, a1.z, a1.w};
        float s1 = 0.f, s2 = 0.f;
#pragma unroll
        for (int w = 0; w < 8; ++w) { const float x0 = bflo(aw[w]), x1 = bfhi(aw[w]); s1 += x0 + x1; s2 += x0 * x0 + x1 * x1; }
        s1 = wave_sum(s1); s2 = wave_sum(s2);
        const float mean = s1 * (1.0f / D), var = fmaxf(s2 * (1.0f / D) - mean * mean, 0.f);
        if (lane == 0) STATS[m] = (f32x2){mean, rsqrtf(var + 1e-5f)};
    }
}
DI void phase_s2(bf16_t* X, const float* AC, int G) {
    const int tid = opaque_tid();
    for (int gid = blockIdx.x * 512 + tid; gid < 64 * 2048; gid += G * 512) {
        const int seq = gid >> 11, e = gid & 2047, d0 = (e & 15) * 8, dir = seq & 1;
        bf16_t* xp = X + (size_t)seq * 32 * 16384 + (size_t)(e >> 4) * 128 + d0;
        const float* ap = AC + (size_t)seq * 32 * 128 + d0;
        float S[8];
#pragma unroll
        for (int i = 0; i < 8; ++i) S[i] = 0.f;
        for (int st = 0; st < 32; st += 4) {
            u32x4 dv[4]; f32x4 a0[4], a1[4];
#pragma unroll
            for (int u = 0; u < 4; ++u) { const int c = dir ? 31 - (st + u) : st + u; dv[u] = *(const u32x4*)(xp + (size_t)c * 16384); a0[u] = *(const f32x4*)(ap + c * 128); a1[u] = *(const f32x4*)(ap + c * 128 + 4); }
#pragma unroll
            for (int u = 0; u < 4; ++u) { const int c = dir ? 31 - (st + u) : st + u;
                *(u32x4*)(xp + (size_t)c * 16384) = (u32x4){pk2(S[0], S[1]), pk2(S[2], S[3]), pk2(S[4], S[5]), pk2(S[6], S[7])};
                S[0] = a0[u].x * S[0] + bflo(dv[u].x); S[1] = a0[u].y * S[1] + bfhi(dv[u].x); S[2] = a0[u].z * S[2] + bflo(dv[u].y); S[3] = a0[u].w * S[3] + bfhi(dv[u].y);
                S[4] = a1[u].x * S[4] + bflo(dv[u].z); S[5] = a1[u].y * S[5] + bfhi(dv[u].z); S[6] = a1[u].z * S[6] + bflo(dv[u].w); S[7] = a1[u].w * S[7] + bfhi(dv[u].w); }
        }
    }
}
struct S3Regs { u32x4 x[8], q[8]; };
DI void s3_load(S3Regs& R, const bf16_t* QH, const bf16_t* X, int it, int dir, int ts, int vt, int lane) {
    const int c = it & 63, h = (it >> 6) & 7, b = it >> 9;
    const bf16_t* xp = X + ((size_t)((b * 8 + h) * 2 + dir) * 32 + (c >> 1)) * 16384 + (size_t)(32 * vt) * 128 + 8 * lane;
    const bf16_t* qp = QH + (size_t)dir * ARR + ((size_t)b * SEQ + c * 64 + 32 * ts + (lane >> 4)) * D + h * 128 + 8 * (lane & 15);
#pragma unroll
    for (int k = 0; k < 8; ++k) { R.x[k] = *(const u32x4*)(xp + 512 * k); R.q[k] = *(const u32x4*)(qp + (size_t)(4 * k) * D); }
}
DI void phase_s3(LAS unsigned char* lds, const bf16_t* QH, const bf16_t* O, const bf16_t* X, const bf16_t* SGA, const float* gw_, bf16_t* YA, int G) {
    const int tid = opaque_tid(), lane = tid & 63, wave = __builtin_amdgcn_readfirstlane(tid >> 6);
    const int r = lane & 31, hh = lane >> 5, ts = wave >> 2, vt = wave & 3;
    LAS bf16_t* XW = (LAS bf16_t*)(lds + wave * 17408);
    LAS bf16_t* QW = XW + 32 * 136;
    LAS float* SS0 = (LAS float*)(lds + 8 * 17408);
    S3Regs R;
    int it = blockIdx.x;
    if (it < 2048) s3_load(R, QH, X, it, 0, ts, vt, lane);
    __syncthreads();
    for (int par = 0; it < 2048; it += G, par ^= 1) {
        const int c = it & 63, h = (it >> 6) & 7, b = it >> 9;
        const size_t row = (size_t)b * SEQ + c * 64 + 32 * ts + r;
        LAS float* SS = SS0 + par * 256;
        const size_t ooff = row * D + h * 128 + 32 * vt + 4 * hh;
        u32x2 ef[4], eb[4], es[4];
        f32x16 acc;
#pragma unroll
        for (int i = 0; i < 16; ++i) acc[i] = 0.f;
#pragma unroll
        for (int dir = 0; dir < 2; ++dir) {
#pragma unroll
            for (int k = 0; k < 8; ++k) { const int id = 64 * k + lane; *(LAS u32x4*)(XW + (id >> 4) * 136 + 8 * (id & 15)) = R.x[k]; *(LAS u32x4*)(QW + (id >> 4) * 136 + 8 * (id & 15)) = R.q[k]; }
            asm volatile("" ::: "memory");
            if (dir == 0) { s3_load(R, QH, X, it, 1, ts, vt, lane);
#pragma unroll
                for (int g = 0; g < 4; ++g) { ef[g] = *(const u32x2*)(O + ooff + 8 * g); eb[g] = *(const u32x2*)(O + ARR + ooff + 8 * g); es[g] = *(const u32x2*)(SGA + ooff + 8 * g); } }
            else if (it + G < 2048) s3_load(R, QH, X, it + G, 0, ts, vt, lane);
#pragma unroll
            for (int ks = 0; ks < 8; ++ks) { const bf16x8 a = *(const LAS bf16x8*)(XW + r * 136 + 16 * ks + 8 * hh), bb = *(const LAS bf16x8*)(QW + r * 136 + 16 * ks + 8 * hh); acc = MFMA32(a, bb, acc); }
        }
        float o[16]; float ss = 0.f;
#pragma unroll
        for (int g = 0; g < 4; ++g) { const u32x2 f = ef[g], bk = eb[g];
            o[4 * g] = acc[4 * g] + bflo(f.x) + bflo(bk.x); o[4 * g + 1] = acc[4 * g + 1] + bfhi(f.x) + bfhi(bk.x); o[4 * g + 2] = acc[4 * g + 2] + bflo(f.y) + bflo(bk.y); o[4 * g + 3] = acc[4 * g + 3] + bfhi(f.y) + bfhi(bk.y); }
#pragma unroll
        for (int i = 0; i < 16; ++i) ss += o[i] * o[i];
        ss += __shfl_xor(ss, 32);
        if (hh == 0) SS[(32 * ts + r) * 4 + vt] = ss;
        __syncthreads();
        const f32x4 s4 = *(const LAS f32x4*)(SS + (32 * ts + r) * 4);
        const float rstd = rsqrtf((s4.x + s4.y + s4.z + s4.w) * (1.0f / 128.0f) + 1e-6f);
#pragma unroll
        for (int g = 0; g < 4; ++g) { const u32x2 sg = es[g]; const f32x4 gv = *(const f32x4*)(gw_ + 32 * vt + 8 * g + 4 * hh);
            *(u32x2*)(YA + ooff + 8 * g) = (u32x2){pk2(o[4 * g] * rstd * gv.x * siluf_(bflo(sg.x)), o[4 * g + 1] * rstd * gv.y * siluf_(bfhi(sg.x))), pk2(o[4 * g + 2] * rstd * gv.z * siluf_(bflo(sg.y)), o[4 * g + 3] * rstd * gv.w * siluf_(bfhi(sg.y)))}; }
    }
}

DI void phase_spatial(LAS unsigned char* lds, const bf16_t* GV, bf16_t* UG, const f32x2* STATS, const float* ln_w, const float* ln_b, const float* w_s, const float* b_s, int G) {
    const int tid = opaque_tid(), lane = tid & 63, wave = __builtin_amdgcn_readfirstlane(tid >> 6);
    const int r = lane & 31, hh = lane >> 5;
    LAS bf16_t* VL = (LAS bf16_t*)(lds);
    LAS bf16_t* WS = (LAS bf16_t*)(lds + 34816);
    int g_last = -1;
    for (int it = blockIdx.x; it < 1024; it += G) {
        const int g = it & 7, n = (it >> 3) & 31, b = it >> 8;
        const size_t rowbase = (size_t)b * SEQ + (size_t)n * 128;
        __syncthreads();
        {
            const int s = tid >> 2, cq = tid & 3; const f32x2 st = STATS[rowbase + s];
            const bf16_t* p = GV + (rowbase + s) * D + 128 * g + 32 * cq;
#pragma unroll
            for (int q = 0; q < 4; ++q) { const u32x4 a = *(const u32x4*)(p + 8 * q); const unsigned aw[4] = {a.x, a.y, a.z, a.w};
                const f32x4 w0 = *(const f32x4*)(ln_w + 128 * g + 32 * cq + 8 * q), w1 = *(const f32x4*)(ln_w + 128 * g + 32 * cq + 8 * q + 4);
                const f32x4 c0 = *(const f32x4*)(ln_b + 128 * g + 32 * cq + 8 * q), c1 = *(const f32x4*)(ln_b + 128 * g + 32 * cq + 8 * q + 4);
                const float wv[8] = {w0.x, w0.y, w0.z, w0.w, w1.x, w1.y, w1.z, w1.w}, bv[8] = {c0.x, c0.y, c0.z, c0.w, c1.x, c1.y, c1.z, c1.w};
#pragma unroll
                for (int w = 0; w < 4; ++w) { const float y0 = (bflo(aw[w]) - st.x) * st.y * wv[2 * w] + bv[2 * w], y1 = (bfhi(aw[w]) - st.x) * st.y * wv[2 * w + 1] + bv[2 * w + 1];
                    const unsigned pk = pk2(y0, y1); const int cc = 32 * cq + 8 * q + 2 * w;
                    VL[cc * 136 + s] = (bf16_t)(pk & 0xffffu); VL[(cc + 1) * 136 + s] = (bf16_t)(pk >> 16); } }
            if (g != g_last) {
                const int t = tid >> 2, sq = tid & 3; const float* wp = w_s + ((size_t)g * 128 + t) * 128 + 32 * sq;
#pragma unroll
                for (int q = 0; q < 4; ++q) { const f32x4 x0 = *(const f32x4*)(wp + 8 * q), x1 = *(const f32x4*)(wp + 8 * q + 4);
                    *(LAS u32x4*)(WS + t * 136 + 32 * sq + 8 * q) = (u32x4){pk2(x0.x, x0.y), pk2(x0.z, x0.w), pk2(x1.x, x1.y), pk2(x1.z, x1.w)}; }
                g_last = g; }
        }
        __syncthreads();
        {
            const int cm = wave & 3;
#pragma unroll
            for (int tt = 0; tt < 2; ++tt) {
                const int tn = 2 * (wave >> 2) + tt;
                f32x16 acc;
#pragma unroll
                for (int i = 0; i < 16; ++i) acc[i] = 0.f;
#pragma unroll
                for (int ks = 0; ks < 8; ++ks) { const bf16x8 a = *(const LAS bf16x8*)(VL + (32 * cm + r) * 136 + 16 * ks + 8 * hh), bb = *(const LAS bf16x8*)(WS + (32 * tn + r) * 136 + 16 * ks + 8 * hh); acc = MFMA32(a, bb, acc); }
                const int t = 32 * tn + r; const float bias = b_s[g * 128 + t];
                bf16_t* up = UG + (rowbase + t) * D + 128 * g + 32 * cm + 4 * hh;
#pragma unroll
                for (int q = 0; q < 4; ++q) { const u32x2 uw = *(const u32x2*)(up + 8 * q);
                    *(u32x2*)(up + 8 * q) = (u32x2){pk2(bflo(uw.x) * (acc[4 * q] + bias), bfhi(uw.x) * (acc[4 * q + 1] + bias)), pk2(bflo(uw.y) * (acc[4 * q + 2] + bias), bfhi(uw.y) * (acc[4 * q + 3] + bias))}; }
            }
        }
    }
}

struct Args { const float* in[13]; float* out; unsigned char* ws; int ph_lo, ph_hi; };
constexpr int PPL = 11;
constexpr int NPH = 4 * PPL + 1;

__global__ void __launch_bounds__(512, 2) mega(Args a) {
    extern __shared__ __attribute__((aligned(16))) unsigned char shm[];
    LAS unsigned char* lds = (LAS unsigned char*)shm;
    cg::grid_group grid = cg::this_grid();
    const int G = gridDim.x, blk = blockIdx.x;
    unsigned char* ws = a.ws;
    const float* x0 = a.in[0];
    bf16_t* Hb = (bf16_t*)(ws + WS_H); bf16_t* out9 = (bf16_t*)(ws + WS_OUT9);
    bf16_t* Qb = out9, *ZFb = out9 + ARR, *Ib = out9 + 3 * ARR, *SGAb = out9 + 4 * ARR, *GVb = out9 + 5 * ARR;
    bf16_t* g3 = (bf16_t*)(ws + WS_G3); bf16_t* UGf = g3, *SMAf = g3 + 2 * ARR, *SMBf = g3 + 4 * ARR;
    bf16_t* OFb = (bf16_t*)(ws + WS_OF); bf16_t* Xb = (bf16_t*)(ws + WS_X); float* ACb = (float*)(ws + WS_AC); f32x2* STb = (f32x2*)(ws + WS_ST);
    volatile LAS unsigned* bst = (volatile LAS unsigned*)(lds + LDS_BYTES - 16);
    if (threadIdx.x < 4) bst[threadIdx.x] = 0u;
    if (blk == 0) for (int i = threadIdx.x; i < XCD_BAR_WORDS; i += 512) ((unsigned*)ws)[i] = 0u;
    __syncthreads();
    XcdBarrier xb; xb.bar = (unsigned*)ws; xb.x = 0; xb.st = bst;
    for (int ph = a.ph_lo; ph < a.ph_hi; ++ph) {
        if (ph == a.ph_lo + 1) { grid.sync(); xb = xcd_barrier_post((unsigned*)ws, bst); }
        else if (ph > a.ph_lo + 1) xcd_barrier(xb);
        if (ph == NPH - 1) { phase_final(a.out, a.in[12], M_ALL, G); continue; }
        const int l = ph / PPL, rr = ph % PPL;
        const float* xin = (l == 0) ? x0 : a.out;
        if (rr == 0) {
            phase_prep(lds, a.in[2] + (size_t)l * D * NIN, a.in[9] + (size_t)l * D * D, a.in[10] + (size_t)l * D * D, a.in[11] + (size_t)l * D * D, ws, G);
            phase_rms_bf16(xin, a.in[1] + l * D, Hb, M_ALL, G);
            if (blk == 0) {
                float* LBT = (float*)(ws + WS_LBT);
                for (int i = threadIdx.x; i < 2048; i += 512) { const float* lp = a.in[3] + i;
                    const float v0 = lp[0], v1 = lp[2048], v2 = lp[4096], v3 = lp[6144], mx = fmaxf(fmaxf(v0, v1), fmaxf(v2, v3));
                    const float e0 = __expf(v0 - mx), e1 = __expf(v1 - mx), e2 = __expf(v2 - mx), e3 = __expf(v3 - mx);
                    float lb = 0.f; if (l >= 1) lb += e1; if (l >= 2) lb += e2; if (l >= 3) lb += e3;
                    lb = lb / (e0 + e1 + e2 + e3);
                    LBT[(i >> 10) * 2048 + (i & 1023)] = fmaxf(lb, 1e-20f); LBT[(i >> 10) * 2048 + 1024 + (i & 1023)] = 1.0f - lb; }
            }
            continue;
        }
        const int hf = (rr <= 8) ? (rr - 1) / 4 : 0, k = (rr <= 8) ? (rr - 1) % 4 : rr - 5;
        bf16_t* Hh = Hb + (size_t)hf * ARR;
        bf16_t* UGb = UGf + (size_t)hf * ARR;
        if (k == 0) {
            pg8::Gemm g{Hh, Hh, (const bf16_t*)(ws + WS_WIN), (const bf16_t*)(ws + WS_WIN), D};
            pg8::Order S; S.init(MH, NIN, G, blk, 0);
            EpiInProj E{out9, g3 + (size_t)hf * ARR};
            pg8::gemm_phase<EpiInProj>(lds, g, S, E);
        } else if (k == 1) {
            phase_lnstats(GVb, STb, G);
            phase_s1(lds, Qb, ZFb, Ib, OFb, Xb, ACb, (const float*)(ws + WS_LBT), G);
        } else if (k == 2) {
            if (blk & 1) phase_s2(Xb, ACb, G);
            phase_spatial(lds, GVb, UGb, STb, a.in[5] + l * D, a.in[6] + l * D, a.in[7] + (size_t)l * 8 * 128 * 128, a.in[8] + l * 8 * 128, G);
            if (!(blk & 1)) phase_s2(Xb, ACb, G);
        } else if (k == 3) {
            phase_s3(lds, ZFb, OFb, Xb, SGAb, a.in[4] + l * 128, Hh, G);
        } else if (k == 4) {
            pg8::Gemm g{Hb, UGf, (const bf16_t*)(ws + WS_WA), (const bf16_t*)(ws + WS_WB), D};
            pg8::Order S; S.init(M_ALL, D, G, blk, 1);
            EpiProjAB E{SMAf, SMBf, out9};
            pg8::gemm_phase<EpiProjAB>(lds, g, S, E);
        } else {
            pg8::Gemm g{out9, out9, (const bf16_t*)(ws + WS_WO), (const bf16_t*)(ws + WS_WO), D};
            pg8::Order S; S.init(M_ALL, D, G, blk, 0);
            EpiResid E{xin, a.out};
            pg8::gemm_phase<EpiResid>(lds, g, S, E);
        }
    }
}


extern "C" void kernel_launch(void* const* d_in, const int* in_sizes, int n_in, void* d_out, int out_size, void* d_ws, size_t ws_size, hipStream_t stream) {
    static int grid = 0;
    if (grid == 0) {
        if (n_in != 13 || ws_size < WS_END) { fprintf(stderr, "kernel_launch: unexpected inputs (n_in %d, ws %zu, need %zu)\n", n_in, ws_size, (size_t)WS_END); grid = -1; return; }
        int dev = 0, cus = 0, per_cu = 0;
        hipGetDevice(&dev); hipDeviceGetAttribute(&cus, hipDeviceAttributeMultiprocessorCount, dev);
        if (hipFuncSetAttribute((const void*)mega, hipFuncAttributeMaxDynamicSharedMemorySize, LDS_BYTES) != hipSuccess) { fprintf(stderr, "kernel_launch: hipFuncSetAttribute failed\n"); grid = -1; return; }
        if (hipOccupancyMaxActiveBlocksPerMultiprocessor(&per_cu, (const void*)mega, 512, LDS_BYTES) != hipSuccess || per_cu < 1) { fprintf(stderr, "kernel_launch: occupancy query gave %d\n", per_cu); per_cu = 1; }
        (void)hipGetLastError();
        grid = cus * 1;
        fprintf(stderr, "kernel_launch: cus %d per_cu %d grid %d\n", cus, per_cu, grid);
    }
    if (grid < 0) return;
    Args a{};
    for (int i = 0; i < 13; ++i) a.in[i] = (const float*)d_in[i];
    a.out = (float*)d_out; a.ws = (unsigned char*)d_ws; a.ph_lo = 0; a.ph_hi = NPH;
    void* args[] = {&a};
    hipError_t e = hipLaunchCooperativeKernel((const void*)mega, dim3(grid), dim3(512), args, LDS_BYTES, stream);
    if (e != hipSuccess) fprintf(stderr, "kernel_launch: cooperative launch failed: %s (grid %d)\n", hipGetErrorString(e), grid);
}
```

```cpp
#include <hip/hip_runtime.h>
#include <hip/hip_cooperative_groups.h>
#include <cstdio>
namespace cg = cooperative_groups;

#define LAS __attribute__((address_space(3)))
#define DI __device__ __forceinline__
typedef unsigned short bf16_t;
typedef short bf16x8 __attribute__((ext_vector_type(8)));
typedef float f32x4 __attribute__((ext_vector_type(4)));
typedef float f32x2 __attribute__((ext_vector_type(2)));
typedef float f32x16 __attribute__((ext_vector_type(16)));
typedef unsigned u32x4 __attribute__((ext_vector_type(4)));
typedef unsigned u32x2 __attribute__((ext_vector_type(2)));
typedef __bf16 bf16v2 __attribute__((ext_vector_type(2)));

constexpr int D = 1024, SEQ = 4096, MH = 16384, M_ALL = 32768, DEPTH = 4, NIN = 10240;
constexpr int LDS_BYTES = 163840;
constexpr float LOG2E = 1.4426950408889634f;
constexpr size_t ARR = (size_t)MH * D;

constexpr size_t WS_WIN = 1ull << 20;
constexpr size_t WS_WA = WS_WIN + (size_t)NIN * D * 2;
constexpr size_t WS_WB = WS_WA + (size_t)D * D * 2;
constexpr size_t WS_WO = WS_WB + (size_t)D * D * 2;
constexpr size_t WS_H = WS_WO + (size_t)D * D * 2;
constexpr size_t WS_OUT9 = WS_H + (size_t)M_ALL * D * 2;
constexpr size_t WS_G3 = WS_OUT9 + 6 * ARR * 2;
constexpr size_t WS_OF = WS_G3 + 6 * ARR * 2;
constexpr size_t WS_X = WS_OF + 2 * ARR * 2;
constexpr size_t WS_AC = WS_X + (size_t)64 * 32 * 16384 * 2;
constexpr size_t WS_ST = WS_AC + (size_t)64 * 32 * 128 * 4;
constexpr size_t WS_LBT = WS_ST + (size_t)MH * 8;
constexpr size_t WS_END = WS_LBT + 4096 * 4;

DI unsigned pk2(float lo, float hi) { f32x2 v = {lo, hi}; bf16v2 r = __builtin_convertvector(v, bf16v2); return __builtin_bit_cast(unsigned, r); }
DI float bflo(unsigned w) { return __uint_as_float(w << 16); }
DI float bfhi(unsigned w) { return __uint_as_float(w & 0xffff0000u); }
DI float fexp2(float x) { return __builtin_amdgcn_exp2f(x); }
DI float frcp(float x) { return __builtin_amdgcn_rcpf(x); }
DI float sigmoidf_(float x) { return frcp(1.0f + fexp2(-x * LOG2E)); }
DI float siluf_(float x) { return x * sigmoidf_(x); }
DI float geluf_(float x) { const float t = x + 0.044715f * x * x * x; return x * frcp(1.0f + fexp2(-2.3022082f * t)); }
DI float wave_sum(float v) {
#pragma unroll
    for (int o = 1; o < 64; o <<= 1) v += __shfl_xor(v, o);
    return v;
}
#define LDS_WAIT() asm volatile("s_waitcnt lgkmcnt(0)" ::: "memory")
template <int CTRL, int ROWMASK, bool BC> DI float dpp_f(float x) { return __int_as_float(__builtin_amdgcn_update_dpp(0, __float_as_int(x), CTRL, ROWMASK, 0xf, BC)); }
DI int opaque_tid() { int t = threadIdx.x; asm volatile("" : "+v"(t)); return t; }


#define XB_TMO      128
#define XB_XCNT(j)  (256  + 64 * (j))
#define XB_XSUB(j)  (1280 + 64 * (j))
#define XB_XGEN(j)  (2304 + 64 * (j))
#define XB_TOP      3328
#define XB_TOPGEN   3392
#define XCD_BAR_WORDS 3456
#define XB_SPIN_CAP (1u << 22)
DI unsigned xb_ld(unsigned* p)              { return __hip_atomic_load(p, __ATOMIC_RELAXED, __HIP_MEMORY_SCOPE_AGENT); }
DI unsigned xb_add(unsigned* p, unsigned v) { return __hip_atomic_fetch_add(p, v, __ATOMIC_RELAXED, __HIP_MEMORY_SCOPE_AGENT); }
DI unsigned xb_xcc_id() { return (unsigned)__builtin_amdgcn_s_getreg((3 << 11) | 20) & 0xFu; }
#define XB_SPIN(cond, bar) do { unsigned _sp = 0; while (cond) { __builtin_amdgcn_s_sleep(1); \
    if ((++_sp & 255u) == 0u) { if (xb_ld(&(bar)[XB_TMO])) break; if (_sp > XB_SPIN_CAP) { atomicAdd(&(bar)[XB_TMO], 1u); break; } } } } while (0)
struct XcdBarrier { unsigned* bar; unsigned x; volatile LAS unsigned* st; };
DI XcdBarrier xcd_barrier_post(unsigned* bar, volatile LAS unsigned* st) {
    XcdBarrier b; b.bar = bar; b.x = xb_xcc_id(); b.st = st;
    if (threadIdx.x == 0) (void)xb_add(&bar[XB_XCNT(b.x)], 1u);
    return b;
}
DI void xcd_barrier_complete(unsigned* bar, unsigned x, unsigned& nloc, unsigned& nx) {
    const unsigned G = gridDim.x * gridDim.y * gridDim.z;
    unsigned sum, cnt, mine, sp = 0u;
    for (;;) {
        sum = 0u; cnt = 0u; mine = 0u;
#pragma unroll
        for (unsigned j = 0; j < 16; ++j) { const unsigned c = xb_ld(&bar[XB_XCNT(j)]); sum += c; cnt += (c > 0u) ? 1u : 0u; mine = (j == x) ? c : mine; }
        if (sum == G) break;
        __builtin_amdgcn_s_sleep(1);
        if ((++sp & 255u) == 0u) { if (xb_ld(&bar[XB_TMO])) break; if (sp > XB_SPIN_CAP) { atomicAdd(&bar[XB_TMO], 1u); break; } }
    }
    nloc = mine > 0u ? mine : 1u; nx = cnt > 0u ? cnt : 1u;
}
DI void xcd_barrier(const XcdBarrier& b) {
    asm volatile("s_waitcnt vmcnt(0)" ::: "memory");
    __syncthreads();
    if (threadIdx.x == 0) {
        unsigned* bar = b.bar;
        __builtin_amdgcn_s_waitcnt(0);
        unsigned nloc = b.st[0], nx = b.st[1];
        if (nloc == 0u) { xcd_barrier_complete(bar, b.x, nloc, nx); b.st[0] = nloc; b.st[1] = nx; }
        const unsigned old = xb_add(&bar[XB_XSUB(b.x)], 1u);
        const unsigned gen = old / nloc;
        if (old + 1u == (gen + 1u) * nloc) {
            __builtin_amdgcn_fence(__ATOMIC_RELEASE, "agent");
            asm volatile("s_waitcnt vmcnt(0)" ::: "memory");
            const unsigned og = xb_add(&bar[XB_TOP], 1u);
            const unsigned tg = og / nx;
            if (og + 1u == (tg + 1u) * nx) xb_add(&bar[XB_TOPGEN], 1u);
            else XB_SPIN(xb_ld(&bar[XB_TOPGEN]) == tg, bar);
            __builtin_amdgcn_fence(__ATOMIC_ACQUIRE, "agent");
            xb_add(&bar[XB_XGEN(b.x)], 1u);
            asm volatile("s_waitcnt vmcnt(0)" ::: "memory");
        } else {
            XB_SPIN(xb_ld(&bar[XB_XGEN(b.x)]) == gen, bar);
            __builtin_amdgcn_fence(__ATOMIC_ACQUIRE, "agent");
            asm volatile("s_waitcnt vmcnt(0)" ::: "memory");
        }
    }
    __syncthreads();
}

namespace pg8 {
constexpr int BM = 256, BK = 64, HALF = 128, HTB = HALF * BK * 2, STAGE_BYTES = 8 * HTB, NXCD = 8, WGM = 8;
DI int lds_byte(int r, int c) { const int st = (r >> 4) * 2 + (c >> 5), rr = r & 15, cc = c & 31, ob = rr * 64 + cc * 2; return st * 1024 + (ob ^ (((ob >> 9) & 1) << 5)); }
DI void stage_rc(int b, int& R, int& C) { const int st = b / 1024, sb = b % 1024, swz = sb ^ (((sb >> 9) & 1) << 5); R = (st >> 1) * 16 + swz / 64; C = (st & 1) * 32 + (swz % 64) / 2; }
DI int perm32(int rho) { const int n = rho >> 4, i = rho & 15; return 8 * (i >> 2) + 4 * n + (i & 3); }

struct Unit { int pm, pn, sel; };
struct Gemm { const bf16_t* A0; const bf16_t* A1; const bf16_t* B0; const bf16_t* B1; int K; };
struct Order {
    int nM, nN, nwg, G, c, dual;
    DI void init(int M, int N, int G_, int c_, int dual_) { nM = M / BM; nN = N / BM; nwg = nM * nN; G = G_; c = c_; dual = dual_; }
    DI bool next(int i, Unit& u) const {
        const int ti = dual ? (i >> 1) : i; u.sel = dual ? (i & 1) : 0;
        const long L = (long)ti * G + c; if (L >= nwg) return false;
        int wgid = (int)L; { const int q = nwg / NXCD, r = nwg % NXCD, xcd = wgid % NXCD, off = wgid / NXCD; wgid = (xcd < r ? xcd * (q + 1) : r * (q + 1) + (xcd - r) * q) + off; }
        const int nig = WGM * nN, gid = wgid / nig, fm = gid * WGM, gsz = (nM - fm) < WGM ? (nM - fm) : WGM;
        u.pm = fm + ((wgid % nig) % gsz); u.pn = (wgid % nig) / gsz; return true;
    }
};

template <class Epi>
DI void gemm_phase(LAS unsigned char* lds, const Gemm g, const Order& S, const Epi& E) {
    const int tid = opaque_tid(), wid = __builtin_amdgcn_readfirstlane(tid >> 6), lane = tid & 63, wr = wid >> 2, wc = wid & 3, fr = lane & 15, fq = lane >> 4;
    const int K = g.K, nt = K / BK;
    unsigned voffA[2], voffB[2];
#pragma unroll
    for (int i = 0; i < 2; ++i) { int R, C; stage_rc(tid * 16 + i * 8192, R, C); const int Rb = Epi::PERM ? ((R & ~31) + perm32(R & 31)) : R;
        voffA[i] = (unsigned)(R * K + C) * 2u; voffB[i] = (unsigned)(Rb * K + C) * 2u; }
    const size_t kstep = (size_t)(BK * 2);
    const size_t hstep = (size_t)HALF * K * 2;
    const size_t tstep = 2 * hstep;
    const unsigned ldsw = (unsigned)wid * 1024u;
    const int aoff = lds_byte(wr * 64 + fr, fq * 8), boff = lds_byte(wc * 32 + fr, fq * 8);
#define PG8_SA(b, h) (((b) * 2 + (h)) * HTB)
#define PG8_SB(b, h) ((4 + (b) * 2 + (h)) * HTB)
#define PG8_STAGE(bufoff, gbase, voff) do { _Pragma("unroll") for (int _i = 0; _i < 2; ++_i) \
        __builtin_amdgcn_global_load_lds((const unsigned*)((const char*)(gbase) + (voff)[_i]), (LAS unsigned*)(lds + (bufoff) + ldsw + _i * 8192), 16, 0, 0); } while (0)
#define PG8_LDA(dst, b, h) do { _Pragma("unroll") for (int m = 0; m < 4; ++m) _Pragma("unroll") for (int k = 0; k < 2; ++k) dst[m][k] = *(const LAS bf16x8*)(lds + PG8_SA(b, h) + aoff + m * 2048 + k * 1024); } while (0)
#define PG8_LDB(dst, b, h) do { _Pragma("unroll") for (int n = 0; n < 2; ++n) _Pragma("unroll") for (int k = 0; k < 2; ++k) dst[n][k] = *(const LAS bf16x8*)(lds + PG8_SB(b, h) + boff + n * 2048 + k * 1024); } while (0)
#define PG8_MMA(ai, bj, At, Bt) do { __builtin_amdgcn_s_setprio(1); _Pragma("unroll") for (int m = 0; m < 4; ++m) _Pragma("unroll") for (int n = 0; n < 2; ++n) _Pragma("unroll") for (int k = 0; k < 2; ++k) \
        acc[ai][bj][m][n] = __builtin_amdgcn_mfma_f32_16x16x32_bf16(Bt[n][k], At[m][k], acc[ai][bj][m][n], 0, 0, 0); __builtin_amdgcn_s_setprio(0); } while (0)
#define PG8_WAIT_V(n) asm volatile("s_waitcnt vmcnt(" #n ")" ::: "memory")
#define PG8_WAIT_L(n) asm volatile("s_waitcnt lgkmcnt(" #n ")" ::: "memory")
#define PG8_BAR __builtin_amdgcn_s_barrier()
#define PG8_SCHED __builtin_amdgcn_sched_barrier(0)
    Unit cur, nxt; int ui = 0;
    if (!S.next(0, cur)) return;
    f32x4 acc[2][2][4][2];
#pragma unroll
    for (int a = 0; a < 2; ++a)
#pragma unroll
        for (int b = 0; b < 2; ++b)
#pragma unroll
            for (int m = 0; m < 4; ++m)
#pragma unroll
                for (int n = 0; n < 2; ++n) acc[a][b][m][n] = (f32x4){0.f, 0.f, 0.f, 0.f};
    bf16x8 At[4][2], B0[2][2], B1[2][2];
    const char* cA = (const char*)(cur.sel ? g.A1 : g.A0) + (size_t)cur.pm * tstep; const char* cB = (const char*)(cur.sel ? g.B1 : g.B0) + (size_t)cur.pn * tstep;
    PG8_STAGE(PG8_SB(0, 0), cB, voffB); PG8_STAGE(PG8_SB(0, 1), cB + hstep, voffB); PG8_STAGE(PG8_SA(0, 0), cA, voffA); PG8_STAGE(PG8_SA(0, 1), cA + hstep, voffA);
    if (wr == 1) PG8_BAR;
    PG8_WAIT_V(2); PG8_BAR;
    PG8_STAGE(PG8_SB(1, 0), cB + kstep, voffB); PG8_STAGE(PG8_SA(1, 0), cA + kstep, voffA); PG8_STAGE(PG8_SB(1, 1), cB + hstep + kstep, voffB);
    PG8_WAIT_V(6); PG8_BAR;
    for (;;) {
        const bool has_next = S.next(ui + 1, nxt);
        const char* nA = has_next ? (const char*)(nxt.sel ? g.A1 : g.A0) + (size_t)nxt.pm * tstep : cA; const char* nB = has_next ? (const char*)(nxt.sel ? g.B1 : g.B0) + (size_t)nxt.pn * tstep : cB;
        for (int t = 0; t < nt; t += 2) {
            const bool last = (t == nt - 2);
            const char* a1 = cA + (size_t)(t + 1) * kstep;
            const char* a2 = last ? nA : cA + (size_t)(t + 2) * kstep; const char* b2 = last ? nB : cB + (size_t)(t + 2) * kstep;
            const char* a3 = a2 + kstep; const char* b3 = b2 + kstep;
            PG8_LDB(B0, 0, 0); PG8_LDB(B1, 0, 1); PG8_SCHED; PG8_LDA(At, 0, 0); PG8_STAGE(PG8_SA(1, 1), a1 + hstep, voffA);
            PG8_WAIT_V(8); PG8_WAIT_L(0); PG8_BAR; PG8_MMA(0, 0, At, B0); PG8_MMA(0, 1, At, B1); PG8_BAR; PG8_SCHED;
            PG8_LDA(At, 0, 1); PG8_STAGE(PG8_SB(0, 0), b2, voffB); PG8_STAGE(PG8_SB(0, 1), b2 + hstep, voffB); PG8_STAGE(PG8_SA(0, 0), a2, voffA);
            PG8_WAIT_V(8); PG8_WAIT_L(0); PG8_BAR; PG8_MMA(1, 0, At, B0); PG8_MMA(1, 1, At, B1); PG8_BAR; PG8_SCHED;
            PG8_LDB(B0, 1, 0); PG8_LDB(B1, 1, 1); PG8_SCHED; PG8_LDA(At, 1, 0); PG8_STAGE(PG8_SA(0, 1), a2 + hstep, voffA);
            PG8_WAIT_V(8); PG8_WAIT_L(0); PG8_BAR; PG8_MMA(0, 0, At, B0); PG8_MMA(0, 1, At, B1); PG8_BAR; PG8_SCHED;
            PG8_LDA(At, 1, 1); PG8_STAGE(PG8_SB(1, 0), b3, voffB); PG8_STAGE(PG8_SB(1, 1), b3 + hstep, voffB); PG8_STAGE(PG8_SA(1, 0), a3, voffA);
            PG8_WAIT_V(8); PG8_WAIT_L(0); PG8_BAR; PG8_MMA(1, 0, At, B0); PG8_MMA(1, 1, At, B1); PG8_BAR; PG8_SCHED;
        }
        if (wr == 0) PG8_BAR;
        E(acc, cur, wr, wc, fr, fq);
        if (!has_next) break;
#pragma unroll
        for (int a = 0; a < 2; ++a)
#pragma unroll
            for (int b = 0; b < 2; ++b)
#pragma unroll
                for (int m = 0; m < 4; ++m)
#pragma unroll
                    for (int n = 0; n < 2; ++n) acc[a][b][m][n] = (f32x4){0.f, 0.f, 0.f, 0.f};
        cur = nxt; cA = nA; cB = nB; ++ui;
        if (wr == 1) PG8_BAR;
    }
    PG8_WAIT_V(0);
    PG8_BAR;
#undef PG8_SA
#undef PG8_SB
#undef PG8_STAGE
#undef PG8_LDA
#undef PG8_LDB
#undef PG8_MMA
#undef PG8_WAIT_V
#undef PG8_WAIT_L
#undef PG8_BAR
#undef PG8_SCHED
}
}

template <int ACT> DI float act_fn(float x) {
    if (ACT == 0) return x;
    if (ACT == 1) return siluf_(x) * 0.08838834764831845f;
    if (ACT == 2) return siluf_(x);
    if (ACT == 3) return geluf_(x);
    return sigmoidf_(x);
}
template <int ACT> DI void store_act(const f32x4 (&acc)[2][2][4][2], bf16_t* base, int row0, int col0) {
#pragma unroll
    for (int ai = 0; ai < 2; ++ai)
#pragma unroll
        for (int m = 0; m < 4; ++m) { bf16_t* rowp = base + (size_t)(row0 + ai * 128 + m * 16) * D + col0;
#pragma unroll
            for (int bj = 0; bj < 2; ++bj) { const f32x4 v0 = acc[ai][bj][m][0], v1 = acc[ai][bj][m][1];
                u32x4 w; w.x = pk2(act_fn<ACT>(v0[0]), act_fn<ACT>(v0[1])); w.y = pk2(act_fn<ACT>(v0[2]), act_fn<ACT>(v0[3]));
                w.z = pk2(act_fn<ACT>(v1[0]), act_fn<ACT>(v1[1])); w.w = pk2(act_fn<ACT>(v1[2]), act_fn<ACT>(v1[3]));
                *(u32x4*)(rowp + bj * 128) = w; } }
}
struct EpiInProj {
    static constexpr bool PERM = true;
    bf16_t* out9; bf16_t* g3;
    DI void operator()(const f32x4 (&acc)[2][2][4][2], const pg8::Unit& u, int wr, int wc, int fr, int fq) const {
        const int pn = u.pn, row0 = u.pm * 256 + wr * 64 + fr, cl = wc * 32 + 8 * fq;
        if (pn >= 20 && pn < 28) {
            bf16_t* base = g3; const int col0 = 128 * (pn - 20) + cl;
#pragma unroll
            for (int ai = 0; ai < 2; ++ai)
#pragma unroll
                for (int m = 0; m < 4; ++m) { bf16_t* rowp = base + (size_t)(row0 + ai * 128 + m * 16) * D + col0;
                    const f32x4 u0 = acc[ai][0][m][0], u1 = acc[ai][0][m][1], g0 = acc[ai][1][m][0], g1 = acc[ai][1][m][1];
                    u32x4 w; w.x = pk2(geluf_(u0[0]) * siluf_(g0[0]), geluf_(u0[1]) * siluf_(g0[1])); w.y = pk2(geluf_(u0[2]) * siluf_(g0[2]), geluf_(u0[3]) * siluf_(g0[3]));
                    w.z = pk2(geluf_(u1[0]) * siluf_(g1[0]), geluf_(u1[1]) * siluf_(g1[1])); w.w = pk2(geluf_(u1[2]) * siluf_(g1[2]), geluf_(u1[3]) * siluf_(g1[3]));
                    *(u32x4*)rowp = w; }
            return;
        }
        int idx, ct;
        if (pn < 20) { idx = pn >> 2; ct = pn & 3; } else if (pn < 32) { idx = 6; ct = pn - 28; } else { idx = 7 + ((pn - 32) >> 2); ct = (pn - 32) & 3; }
        bf16_t* base = (idx <= 4) ? out9 + (size_t)idx * ARR : (idx == 6 ? out9 + 5 * ARR : g3 + (size_t)(idx - 6) * 2 * ARR); const int col0 = 256 * ct + cl;
        if (idx == 0) store_act<1>(acc, base, row0, col0);
        else if (idx <= 3) store_act<0>(acc, base, row0, col0);
        else if (idx == 4) store_act<0>(acc, base, row0, col0);
        else if (idx == 6) store_act<3>(acc, base, row0, col0);
        else store_act<4>(acc, base, row0, col0);
    }
};
struct EpiProjAB {
    static constexpr bool PERM = true;
    const bf16_t* SMA; const bf16_t* SMB; bf16_t* MG;
    DI void operator()(const f32x4 (&acc)[2][2][4][2], const pg8::Unit& u, int wr, int wc, int fr, int fq) const {
        const int row0 = u.pm * 256 + wr * 64 + fr, col0 = u.pn * 256 + wc * 32 + 8 * fq;
        const bf16_t* gate = u.sel ? SMB : SMA;
#pragma unroll
        for (int ai = 0; ai < 2; ++ai)
#pragma unroll
            for (int m = 0; m < 4; ++m) { const size_t off = (size_t)(row0 + ai * 128 + m * 16) * D + col0;
#pragma unroll
                for (int bj = 0; bj < 2; ++bj) { const f32x4 v0 = acc[ai][bj][m][0], v1 = acc[ai][bj][m][1];
                    const u32x4 gw = *(const u32x4*)(gate + off + bj * 128);
                    float o[8] = {v0[0] * bflo(gw.x), v0[1] * bfhi(gw.x), v0[2] * bflo(gw.y), v0[3] * bfhi(gw.y), v1[0] * bflo(gw.z), v1[1] * bfhi(gw.z), v1[2] * bflo(gw.w), v1[3] * bfhi(gw.w)};
                    if (u.sel) { const u32x4 tw = *(const u32x4*)(MG + off + bj * 128);
                        o[0] += bflo(tw.x); o[1] += bfhi(tw.x); o[2] += bflo(tw.y); o[3] += bfhi(tw.y); o[4] += bflo(tw.z); o[5] += bfhi(tw.z); o[6] += bflo(tw.w); o[7] += bfhi(tw.w); }
                    u32x4 w; w.x = pk2(o[0], o[1]); w.y = pk2(o[2], o[3]); w.z = pk2(o[4], o[5]); w.w = pk2(o[6], o[7]);
                    *(u32x4*)(MG + off + bj * 128) = w; }
                asm volatile("" ::: "memory"); }
    }
};
struct EpiResid {
    static constexpr bool PERM = false;
    const float* xin; float* out;
    DI void operator()(const f32x4 (&acc)[2][2][4][2], const pg8::Unit& u, int wr, int wc, int fr, int fq) const {
        const int row0 = u.pm * 256 + wr * 64 + fr, col0 = u.pn * 256 + wc * 32 + 4 * fq;
#pragma unroll
        for (int ai = 0; ai < 2; ++ai)
#pragma unroll
            for (int m = 0; m < 4; ++m) { const size_t off = (size_t)(row0 + ai * 128 + m * 16) * D + col0;
#pragma unroll
                for (int bj = 0; bj < 2; ++bj)
#pragma unroll
                    for (int n = 0; n < 2; ++n) { const f32x4 xv = *(const f32x4*)(xin + off + bj * 128 + n * 16); *(f32x4*)(out + off + bj * 128 + n * 16) = xv + acc[ai][bj][m][n]; }
                asm volatile("" ::: "memory"); }
    }
};

DI int src_col(int nv) {
    if (nv < 5120) return nv;
    if (nv < 7168) { const int t = (nv - 5120) >> 8, w = (nv - 5120) & 255; return w < 128 ? 5120 + 128 * t + w : 7168 + 128 * t + (w - 128); }
    if (nv < 8192) return 6144 + (nv - 7168);
    return nv;
}
DI void transpose_item(const float* W, int N, bf16_t* WT, int k0, int nsrc0, int nvirt0, LAS float* scr, int lane) {
#pragma unroll 8
    for (int i = 0; i < 32; ++i) { const int kk = 2 * i + (lane >> 5); scr[kk * 33 + (lane & 31)] = W[(size_t)(k0 + kk) * N + nsrc0 + (lane & 31)]; }
    LDS_WAIT();
    const int c = lane & 7;
#pragma unroll
    for (int j = 0; j < 4; ++j) { const int n = (lane >> 3) + 8 * j; const LAS float* s = scr + (8 * c) * 33 + n;
        u32x4 o; o.x = pk2(s[0 * 33], s[1 * 33]); o.y = pk2(s[2 * 33], s[3 * 33]); o.z = pk2(s[4 * 33], s[5 * 33]); o.w = pk2(s[6 * 33], s[7 * 33]);
        *(u32x4*)(WT + (size_t)(nvirt0 + n) * D + k0 + 8 * c) = o; }
    LDS_WAIT();
}
DI void phase_prep(LAS unsigned char* lds, const float* w_in, const float* wa, const float* wb, const float* wo, unsigned char* ws, int G) {
    const int tid_ = opaque_tid(); const int lane = tid_ & 63, wave = __builtin_amdgcn_readfirstlane(tid_ >> 6);
    LAS float* scr = (LAS float*)(lds + wave * 16384);
    const int gw = blockIdx.x * 8 + wave, NGW = G * 8;
    constexpr int I_IN = 16 * 320, I_P = 16 * 32, PER_L = I_IN + 3 * I_P;
    for (int it = gw; it < PER_L; it += NGW) {
        int r = it;
        if (r < I_IN) { const int kb = r / 320, nb = r % 320; transpose_item(w_in, NIN, (bf16_t*)(ws + WS_WIN), 64 * kb, src_col(32 * nb), 32 * nb, scr, lane); continue; }
        r -= I_IN; const int which = r / I_P; r %= I_P; const int kb = r / 32, nb = r % 32;
        const float* W = (which == 0 ? wa : which == 1 ? wb : wo);
        bf16_t* WT = (bf16_t*)(ws + (which == 0 ? WS_WA : which == 1 ? WS_WB : WS_WO));
        transpose_item(W, D, WT, 64 * kb, 32 * nb, 32 * nb, scr, lane);
    }
}
DI void phase_rms_bf16(const float* x, const float* w, bf16_t* h, int nrows, int G) {
    const int tid_ = opaque_tid(); const int lane = tid_ & 63, wave = __builtin_amdgcn_readfirstlane(tid_ >> 6);
    const int gw = blockIdx.x * 8 + wave, NGW = G * 8;
    f32x4 wv[4];
#pragma unroll
    for (int j = 0; j < 4; ++j) wv[j] = ((const f32x4*)w)[lane + 64 * j];
    for (int m = gw; m < nrows; m += NGW) {
        const f32x4* xr = (const f32x4*)(x + (size_t)m * D) + lane; f32x4 v[4]; float s = 0.f;
#pragma unroll
        for (int j = 0; j < 4; ++j) { v[j] = xr[64 * j]; s += (v[j].x * v[j].x + v[j].y * v[j].y) + (v[j].z * v[j].z + v[j].w * v[j].w); }
        const float rstd = rsqrtf(wave_sum(s) * (1.0f / D) + 1e-6f);
        u32x2* o8 = (u32x2*)(h + (size_t)m * D) + lane;
#pragma unroll
        for (int j = 0; j < 4; ++j) { u32x2 o; o.x = pk2(v[j].x * rstd * wv[j].x, v[j].y * rstd * wv[j].y); o.y = pk2(v[j].z * rstd * wv[j].z, v[j].w * rstd * wv[j].w); o8[64 * j] = o; }
    }
}
DI void phase_final(float* x, const float* w, int nrows, int G) {
    const int tid_ = opaque_tid(); const int lane = tid_ & 63, wave = __builtin_amdgcn_readfirstlane(tid_ >> 6);
    const int gw = blockIdx.x * 8 + wave, NGW = G * 8;
    f32x4 wv[4];
#pragma unroll
    for (int j = 0; j < 4; ++j) wv[j] = ((const f32x4*)w)[lane + 64 * j];
    for (int m = gw; m < nrows; m += NGW) {
        f32x4* xr = (f32x4*)(x + (size_t)m * D) + lane; f32x4 v[4]; float s = 0.f;
#pragma unroll
        for (int j = 0; j < 4; ++j) { v[j] = xr[64 * j]; s += (v[j].x * v[j].x + v[j].y * v[j].y) + (v[j].z * v[j].z + v[j].w * v[j].w); }
        const float rstd = rsqrtf(wave_sum(s) * (1.0f / D) + 1e-6f);
#pragma unroll
        for (int j = 0; j < 4; ++j) xr[64 * j] = v[j] * rstd * wv[j];
    }
}
#define MFMA32(a, b, c) __builtin_amdgcn_mfma_f32_32x32x16_bf16((a), (b), (c), 0, 0, 0)
struct S1Regs { u32x4 q0, q1, z0, z1, v0, v1; };
DI size_t s1_rowoff(int it, int sub, int j) {
    const int sc = it & 31, dir = (it >> 5) & 1, h = (it >> 6) & 7, b = it >> 9, p = 64 * sub + j;
    return ((size_t)b * SEQ + sc * 128 + (dir ? 127 - p : p)) * D + h * 128;
}
DI void s1_load(S1Regs& R, const bf16_t* Q, const bf16_t* Z, const bf16_t* Iv, int it, int sub, int tid) {
    const size_t off = s1_rowoff(it, sub, tid >> 3) + 16 * (tid & 7);
    const bf16_t* zp = Z + (size_t)((it >> 5) & 1) * ARR;
    R.q0 = *(const u32x4*)(Q + off); R.q1 = *(const u32x4*)(Q + off + 8);
    R.z0 = *(const u32x4*)(zp + off); R.z1 = *(const u32x4*)(zp + off + 8);
    R.v0 = *(const u32x4*)(Iv + off); R.v1 = *(const u32x4*)(Iv + off + 8);
}
DI void phase_s1(LAS unsigned char* lds, const bf16_t* Q, bf16_t* Z, const bf16_t* Iv, bf16_t* O, bf16_t* X, float* AC, const float* LBT, int G) {
    const int tid = opaque_tid(), lane = tid & 63, wave = __builtin_amdgcn_readfirstlane(tid >> 6);
    const int r = lane & 31, hh = lane >> 5, j8 = tid >> 3, cg8 = tid & 7;
    LAS bf16_t* TQ = (LAS bf16_t*)(lds);
    LAS bf16_t* TV = (LAS bf16_t*)(lds + 17408);
    LAS bf16_t* TZ = (LAS bf16_t*)(lds + 34816);
    LAS bf16_t* QS = (LAS bf16_t*)(lds + 52224);
    LAS bf16_t* KSA = (LAS bf16_t*)(lds + 69632);
    LAS bf16_t* KSB = (LAS bf16_t*)(lds + 87040);
    LAS bf16_t* KHT = (LAS bf16_t*)(lds + 104448);
    LAS bf16_t* VT = (LAS bf16_t*)(lds + 122880);
    LAS float* TA = (LAS float*)(lds + 157696);
    LAS float* AA = TA + 128;
    LAS float* AB = TA + 256;
    LAS bf16_t* PS = TV;
    S1Regs R;
    int it = blockIdx.x;
    if (it < 2048) s1_load(R, Q, Z, Iv, it, 0, tid);
    __syncthreads();
    for (; it < 2048; it += G) {
        const int sc = it & 31, dir = (it >> 5) & 1, h = (it >> 6) & 7, b = it >> 9, seq = (b * 8 + h) * 2 + dir;
        f32x16 DA[2];
        float lbv[16], omv[16];
        { const float* lp = LBT + dir * 2048 + h * 128 + 16 * wave;
#pragma unroll
          for (int i = 0; i < 16; ++i) { lbv[i] = lp[i]; omv[i] = lp[1024 + i]; } }
#pragma unroll
        for (int sub = 0; sub < 2; ++sub) {
            *(LAS u32x4*)(TQ + j8 * 136 + 16 * cg8) = R.q0; *(LAS u32x4*)(TQ + j8 * 136 + 16 * cg8 + 8) = R.q1;
            *(LAS u32x4*)(TZ + j8 * 136 + 16 * cg8) = R.z0; *(LAS u32x4*)(TZ + j8 * 136 + 16 * cg8 + 8) = R.z1;
            *(LAS u32x4*)(TV + j8 * 136 + 16 * cg8) = R.v0; *(LAS u32x4*)(TV + j8 * 136 + 16 * cg8 + 8) = R.v1;
            __syncthreads();
            {
                const u32x4 z0 = *(const LAS u32x4*)(TZ + lane * 136 + 16 * wave), z1 = *(const LAS u32x4*)(TZ + lane * 136 + 16 * wave + 8);
                const u32x4 q0 = *(const LAS u32x4*)(TQ + lane * 136 + 16 * wave), q1 = *(const LAS u32x4*)(TQ + lane * 136 + 16 * wave + 8);
                const u32x4 v0 = *(const LAS u32x4*)(TV + lane * 136 + 16 * wave), v1 = *(const LAS u32x4*)(TV + lane * 136 + 16 * wave + 8);
                const unsigned zw[8] = {z0.x, z0.y, z0.z, z0.w, z1.x, z1.y, z1.z, z1.w};
                const unsigned qw[8] = {q0.x, q0.y, q0.z, q0.w, q1.x, q1.y, q1.z, q1.w};
                const unsigned vw[8] = {v0.x, v0.y, v0.z, v0.w, v1.x, v1.y, v1.z, v1.w};
                float kk[16], gg[16];
                if (sub == 0) s1_load(R, Q, Z, Iv, it, 1, tid); else if (it + G < 2048) s1_load(R, Q, Z, Iv, it + G, 0, tid);
#pragma unroll
                for (int i = 0; i < 16; ++i) { const unsigned w = zw[i >> 1]; float z = (i & 1) ? bfhi(w) : bflo(w); z = __builtin_amdgcn_fmed3f(z, -30.f, 30.f);
                    const float e = fexp2(-z * LOG2E), sg = frcp(1.0f + e); const float om = omv[i];
                    kk[i] = om * e * sg; gg[i] = __builtin_amdgcn_logf(lbv[i] + om * sg); }
#pragma unroll
                for (int i = 0; i < 16; ++i) {
                    float x = gg[i];
                    x += dpp_f<0x111, 0xf, true>(x); x += dpp_f<0x112, 0xf, true>(x); x += dpp_f<0x114, 0xf, true>(x); x += dpp_f<0x118, 0xf, true>(x);
                    x += dpp_f<0x142, 0xa, false>(x); x += dpp_f<0x143, 0xc, false>(x);
                    gg[i] = x; }
                float aa[16], ta[16];
                if (sub == 1) {
#pragma unroll
                    for (int q4 = 0; q4 < 4; ++q4) { const f32x4 a4 = *(const LAS f32x4*)(AA + 16 * wave + 4 * q4), t4 = *(const LAS f32x4*)(TA + 16 * wave + 4 * q4);
                        aa[4 * q4] = a4.x; aa[4 * q4 + 1] = a4.y; aa[4 * q4 + 2] = a4.z; aa[4 * q4 + 3] = a4.w; ta[4 * q4] = t4.x; ta[4 * q4 + 1] = t4.y; ta[4 * q4 + 2] = t4.z; ta[4 * q4 + 3] = t4.w; }
                }
                unsigned qo[8], ko[8], kh[8], qh[8];
                float a16[16], t16[16], f16_[16];
#pragma unroll
                for (int w = 0; w < 8; ++w) {
                    float qt_[2], kt_[2], kh_[2], qh_[2];
#pragma unroll
                    for (int e2 = 0; e2 < 2; ++e2) { const int i = 2 * w + e2; const float qf = e2 ? bfhi(qw[w]) : bflo(qw[w]);
                        const float Rr = __int_as_float(__builtin_amdgcn_readlane(__float_as_int(gg[i]), 31)), G63 = __int_as_float(__builtin_amdgcn_readlane(__float_as_int(gg[i]), 63));
                        const float dq = gg[i] - Rr;
                        qt_[e2] = qf * fexp2(fminf(dq, 100.f)); kt_[e2] = kk[i] * fexp2(fminf(-dq, 100.f));
                        a16[i] = fexp2(gg[i]); kh_[e2] = kk[i] * fexp2(G63 - gg[i]); t16[i] = gg[i] - Rr;
                        if (sub == 0) { qh_[e2] = qf * a16[i]; } else { qh_[e2] = qf * a16[i] * aa[i]; f16_[i] = fexp2(Rr + ta[i]); } }
                    qo[w] = pk2(qt_[0], qt_[1]); ko[w] = pk2(kt_[0], kt_[1]); kh[w] = pk2(kh_[0], kh_[1]); qh[w] = pk2(qh_[0], qh_[1]);
                }
                LAS bf16_t* KSx = (sub == 0) ? KSA : KSB;
                *(LAS u32x4*)(QS + lane * 136 + 16 * wave) = (u32x4){qo[0], qo[1], qo[2], qo[3]}; *(LAS u32x4*)(QS + lane * 136 + 16 * wave + 8) = (u32x4){qo[4], qo[5], qo[6], qo[7]};
                *(LAS u32x4*)(KSx + lane * 136 + 16 * wave) = (u32x4){ko[0], ko[1], ko[2], ko[3]}; *(LAS u32x4*)(KSx + lane * 136 + 16 * wave + 8) = (u32x4){ko[4], ko[5], ko[6], ko[7]};
                *(LAS u32x4*)(TZ + lane * 136 + 16 * wave) = (u32x4){qh[0], qh[1], qh[2], qh[3]}; *(LAS u32x4*)(TZ + lane * 136 + 16 * wave + 8) = (u32x4){qh[4], qh[5], qh[6], qh[7]};
#pragma unroll
                for (int w = 0; w < 8; ++w) {
                    KHT[(16 * wave + 2 * w) * 72 + lane] = (bf16_t)(kh[w] & 0xffffu); KHT[(16 * wave + 2 * w + 1) * 72 + lane] = (bf16_t)(kh[w] >> 16);
                    VT[(16 * wave + 2 * w) * 136 + 64 * sub + lane] = (bf16_t)(vw[w] & 0xffffu); VT[(16 * wave + 2 * w + 1) * 136 + 64 * sub + lane] = (bf16_t)(vw[w] >> 16);
                }
                if (sub == 0) {
                    if (lane == 63) {
#pragma unroll
                        for (int q4 = 0; q4 < 4; ++q4) { *(LAS f32x4*)(TA + 16 * wave + 4 * q4) = (f32x4){t16[4 * q4], t16[4 * q4 + 1], t16[4 * q4 + 2], t16[4 * q4 + 3]};
                            *(LAS f32x4*)(AA + 16 * wave + 4 * q4) = (f32x4){a16[4 * q4], a16[4 * q4 + 1], a16[4 * q4 + 2], a16[4 * q4 + 3]}; }
                    }
                } else {
                    const u32x4 k0 = *(const LAS u32x4*)(KSA + lane * 136 + 16 * wave), k1 = *(const LAS u32x4*)(KSA + lane * 136 + 16 * wave + 8);
                    const unsigned kw[8] = {k0.x, k0.y, k0.z, k0.w, k1.x, k1.y, k1.z, k1.w}; unsigned kn[8];
#pragma unroll
                    for (int w = 0; w < 8; ++w) kn[w] = pk2(bflo(kw[w]) * f16_[2 * w], bfhi(kw[w]) * f16_[2 * w + 1]);
                    *(LAS u32x4*)(KSA + lane * 136 + 16 * wave) = (u32x4){kn[0], kn[1], kn[2], kn[3]}; *(LAS u32x4*)(KSA + lane * 136 + 16 * wave + 8) = (u32x4){kn[4], kn[5], kn[6], kn[7]};
                    if (lane == 63) { float* ap = AC + ((size_t)seq * 32 + sc) * 128 + 16 * wave;
#pragma unroll
                        for (int q4 = 0; q4 < 4; ++q4) { *(LAS f32x4*)(AB + 16 * wave + 4 * q4) = (f32x4){a16[4 * q4], a16[4 * q4 + 1], a16[4 * q4 + 2], a16[4 * q4 + 3]};
                            *(f32x4*)(ap + 4 * q4) = (f32x4){a16[4 * q4] * aa[4 * q4], a16[4 * q4 + 1] * aa[4 * q4 + 1], a16[4 * q4 + 2] * aa[4 * q4 + 2], a16[4 * q4 + 3] * aa[4 * q4 + 3]}; } }
                }
            }
            __syncthreads();
            {
                LAS bf16_t* KSx = (sub == 0) ? KSA : KSB;
                if (wave < 3) {
                    const int tm = (wave == 2) ? 1 : 0, tn = (wave == 0) ? 0 : 1;
                    f32x16 acc;
#pragma unroll
                    for (int i = 0; i < 16; ++i) acc[i] = 0.f;
#pragma unroll
                    for (int ks = 0; ks < 8; ++ks) { const bf16x8 a = *(const LAS bf16x8*)(KSx + (32 * tm + r) * 136 + 16 * ks + 8 * hh), bb = *(const LAS bf16x8*)(QS + (32 * tn + r) * 136 + 16 * ks + 8 * hh); acc = MFMA32(a, bb, acc); }
                    const int t = 32 * tn + r;
#pragma unroll
                    for (int g = 0; g < 4; ++g) { const int s0 = 32 * tm + 8 * g + 4 * hh;
                        const float p0 = (s0 + 0 <= t) ? acc[4 * g + 0] : 0.f, p1 = (s0 + 1 <= t) ? acc[4 * g + 1] : 0.f, p2 = (s0 + 2 <= t) ? acc[4 * g + 2] : 0.f, p3 = (s0 + 3 <= t) ? acc[4 * g + 3] : 0.f;
                        *(LAS u32x2*)(PS + t * 136 + 64 * sub + s0) = (u32x2){pk2(p0, p1), pk2(p2, p3)}; }
                } else if (sub == 1 && wave < 7) {
                    const int tm = (wave - 3) >> 1, tn = (wave - 3) & 1;
                    f32x16 acc;
#pragma unroll
                    for (int i = 0; i < 16; ++i) acc[i] = 0.f;
#pragma unroll
                    for (int ks = 0; ks < 8; ++ks) { const bf16x8 a = *(const LAS bf16x8*)(KSA + (32 * tm + r) * 136 + 16 * ks + 8 * hh), bb = *(const LAS bf16x8*)(QS + (32 * tn + r) * 136 + 16 * ks + 8 * hh); acc = MFMA32(a, bb, acc); }
                    const int t = 32 * tn + r;
#pragma unroll
                    for (int g = 0; g < 4; ++g) { const int s0 = 32 * tm + 8 * g + 4 * hh;
                        *(LAS u32x2*)(PS + t * 136 + s0) = (u32x2){pk2(acc[4 * g], acc[4 * g + 1]), pk2(acc[4 * g + 2], acc[4 * g + 3])}; }
                }
#pragma unroll
                for (int k = 0; k < 2; ++k) {
                    const int vt = wave >> 1, dt = 2 * (wave & 1) + k;
                    f32x16 acc;
                    if (sub == 0) {
#pragma unroll
                        for (int i = 0; i < 16; ++i) acc[i] = 0.f;
                    } else { const float ab = AB[32 * dt + r];
#pragma unroll
                        for (int i = 0; i < 16; ++i) acc[i] = DA[k][i] * ab; }
#pragma unroll
                    for (int ks = 0; ks < 4; ++ks) { const bf16x8 a = *(const LAS bf16x8*)(VT + (32 * vt + r) * 136 + 64 * sub + 16 * ks + 8 * hh), bb = *(const LAS bf16x8*)(KHT + (32 * dt + r) * 72 + 16 * ks + 8 * hh); acc = MFMA32(a, bb, acc); }
                    if (sub == 0) DA[k] = acc;
                    else { bf16_t* xp = X + ((size_t)seq * 32 + sc) * 16384 + (size_t)(32 * vt + 4 * hh) * 128 + 32 * dt + r;
#pragma unroll
                        for (int i = 0; i < 16; i += 2) { const unsigned p = pk2(acc[i], acc[i + 1]); const int v0 = (i & 3) + 8 * (i >> 2);
                            xp[(size_t)v0 * 128] = (bf16_t)(p & 0xffffu); xp[(size_t)(v0 + 1) * 128] = (bf16_t)(p >> 16); } }
                }
                {
                    bf16_t* zp = Z + (size_t)dir * ARR + s1_rowoff(it, sub, j8) + 16 * cg8;
                    *(u32x4*)zp = *(const LAS u32x4*)(TZ + j8 * 136 + 16 * cg8); *(u32x4*)(zp + 8) = *(const LAS u32x4*)(TZ + j8 * 136 + 16 * cg8 + 8);
                }
            }
            __syncthreads();
            {
                const int vt = wave & 3, tn = wave >> 2;
                f32x16 acc;
#pragma unroll
                for (int i = 0; i < 16; ++i) acc[i] = 0.f;
                if (sub == 1) {
#pragma unroll
                    for (int ks = 0; ks < 4; ++ks) { const bf16x8 a = *(const LAS bf16x8*)(VT + (32 * vt + r) * 136 + 16 * ks + 8 * hh), bb = *(const LAS bf16x8*)(PS + (32 * tn + r) * 136 + 16 * ks + 8 * hh); acc = MFMA32(a, bb, acc); }
                }
#pragma unroll
                for (int ks = 0; ks < 4; ++ks) { if (ks < 2 * (tn + 1)) { const bf16x8 a = *(const LAS bf16x8*)(VT + (32 * vt + r) * 136 + 64 * sub + 16 * ks + 8 * hh), bb = *(const LAS bf16x8*)(PS + (32 * tn + r) * 136 + 64 * sub + 16 * ks + 8 * hh); acc = MFMA32(a, bb, acc); } }
                LAS bf16_t* op = QS + (32 * tn + r) * 136 + 32 * vt + 4 * hh;
#pragma unroll
                for (int g = 0; g < 4; ++g) *(LAS u32x2*)(op + 8 * g) = (u32x2){pk2(acc[4 * g], acc[4 * g + 1]), pk2(acc[4 * g + 2], acc[4 * g + 3])};
            }
            __syncthreads();
            {
                bf16_t* op = O + (size_t)dir * ARR + s1_rowoff(it, sub, j8) + 16 * cg8;
                *(u32x4*)op = *(const LAS u32x4*)(QS + j8 * 136 + 16 * cg8); *(u32x4*)(op + 8) = *(const LAS u32x4*)(QS + j8 * 136 + 16 * cg8 + 8);
            }
        }
    }
}
DI void phase_lnstats(const bf16_t* GV, f32x2* STATS, int G) {
    const int tid_ = opaque_tid(); const int lane = tid_ & 63, wave = __builtin_amdgcn_readfirstlane(tid_ >> 6);
    const int gw = blockIdx.x * 8 + wave, NGW = G * 8;
    for (int m = gw; m < MH; m += NGW) {
        const bf16_t* p = GV + (size_t)m * D + 16 * lane;
        const u32x4 a0 = *(const u32x4*)p, a1 = *(const u32x4*)(p + 8);
        const unsigned aw[8] = {a0.x, a0.y, a0.z, a0.w, a1.x, a1.y, a1.z, a1.w};
        float s1 = 0.f, s2 = 0.f;
#pragma unroll
        for (int w = 0; w < 8; ++w) { const float x0 = bflo(aw[w]), x1 = bfhi(aw[w]); s1 += x0 + x1; s2 += x0 * x0 + x1 * x1; }
        s1 = wave_sum(s1); s2 = wave_sum(s2);
        const float mean = s1 * (1.0f / D), var = fmaxf(s2 * (1.0f / D) - mean * mean, 0.f);
        if (lane == 0) STATS[m] = (f32x2){mean, rsqrtf(var + 1e-5f)};
    }
}
DI void phase_s2(bf16_t* X, const float* AC, int G) {
    const int tid = opaque_tid();
    for (int gid = blockIdx.x * 512 + tid; gid < 64 * 2048; gid += G * 512) {
        const int seq = gid >> 11, e = gid & 2047, d0 = (e & 15) * 8, dir = seq & 1;
        bf16_t* xp = X + (size_t)seq * 32 * 16384 + (size_t)(e >> 4) * 128 + d0;
        const float* ap = AC + (size_t)seq * 32 * 128 + d0;
        float S[8];
#pragma unroll
        for (int i = 0; i < 8; ++i) S[i] = 0.f;
        for (int st = 0; st < 32; st += 8) {
            u32x4 dv[8]; f32x4 a0[8], a1[8];
#pragma unroll
            for (int u = 0; u < 8; ++u) { const int c = dir ? 31 - (st + u) : st + u; dv[u] = *(const u32x4*)(xp + (size_t)c * 16384); a0[u] = *(const f32x4*)(ap + c * 128); a1[u] = *(const f32x4*)(ap + c * 128 + 4); }
#pragma unroll
            for (int u = 0; u < 8; ++u) { const int c = dir ? 31 - (st + u) : st + u;
                *(u32x4*)(xp + (size_t)c * 16384) = (u32x4){pk2(S[0], S[1]), pk2(S[2], S[3]), pk2(S[4], S[5]), pk2(S[6], S[7])};
                S[0] = a0[u].x * S[0] + bflo(dv[u].x); S[1] = a0[u].y * S[1] + bfhi(dv[u].x); S[2] = a0[u].z * S[2] + bflo(dv[u].y); S[3] = a0[u].w * S[3] + bfhi(dv[u].y);
                S[4] = a1[u].x * S[4] + bflo(dv[u].z); S[5] = a1[u].y * S[5] + bfhi(dv[u].z); S[6] = a1[u].z * S[6] + bflo(dv[u].w); S[7] = a1[u].w * S[7] + bfhi(dv[u].w); }
        }
    }
}
struct S3Regs { u32x4 x[8], q[8]; };
DI void s3_decode(int it, int& c, int& h, int& b) { const int rest = (it & 7) | ((it >> 4) << 3); c = ((rest & 31) << 1) | ((it >> 3) & 1); h = (rest >> 5) & 7; b = rest >> 8; }
DI void s3_load(S3Regs& R, const bf16_t* QH, const bf16_t* X, int it, int dir, int ts, int vt, int lane) {
    int c, h, b; s3_decode(it, c, h, b);
    const bf16_t* xp = X + ((size_t)((b * 8 + h) * 2 + dir) * 32 + (c >> 1)) * 16384 + (size_t)(32 * vt) * 128 + 8 * lane;
    const bf16_t* qp = QH + (size_t)dir * ARR + ((size_t)b * SEQ + c * 64 + 32 * ts + (lane >> 4)) * D + h * 128 + 8 * (lane & 15);
#pragma unroll
    for (int k = 0; k < 8; ++k) { R.x[k] = *(const u32x4*)(xp + 512 * k); R.q[k] = *(const u32x4*)(qp + (size_t)(4 * k) * D); }
}
DI void phase_s3(LAS unsigned char* lds, const bf16_t* QH, const bf16_t* O, const bf16_t* X, const bf16_t* SGA, const float* gw_, bf16_t* YA, int G) {
    const int tid = opaque_tid(), lane = tid & 63, wave = __builtin_amdgcn_readfirstlane(tid >> 6);
    const int r = lane & 31, hh = lane >> 5, ts = wave >> 2, vt = wave & 3;
    LAS bf16_t* XW = (LAS bf16_t*)(lds + wave * 17408);
    LAS bf16_t* QW = XW + 32 * 136;
    LAS float* SS0 = (LAS float*)(lds + 8 * 17408);
    S3Regs R;
    int it = blockIdx.x;
    if (it < 2048) s3_load(R, QH, X, it, 0, ts, vt, lane);
    __syncthreads();
    for (int par = 0; it < 2048; it += G, par ^= 1) {
        int c, h, b; s3_decode(it, c, h, b);
        const size_t row = (size_t)b * SEQ + c * 64 + 32 * ts + r;
        LAS float* SS = SS0 + par * 256;
        const size_t ooff = row * D + h * 128 + 32 * vt + 4 * hh;
        u32x2 ef[4], eb[4], es[4];
        f32x16 acc;
#pragma unroll
        for (int i = 0; i < 16; ++i) acc[i] = 0.f;
#pragma unroll
        for (int dir = 0; dir < 2; ++dir) {
#pragma unroll
            for (int k = 0; k < 8; ++k) { const int id = 64 * k + lane; *(LAS u32x4*)(XW + (id >> 4) * 136 + 8 * (id & 15)) = R.x[k]; *(LAS u32x4*)(QW + (id >> 4) * 136 + 8 * (id & 15)) = R.q[k]; }
            asm volatile("" ::: "memory");
            if (dir == 0) { s3_load(R, QH, X, it, 1, ts, vt, lane);
#pragma unroll
                for (int g = 0; g < 4; ++g) { ef[g] = *(const u32x2*)(O + ooff + 8 * g); eb[g] = *(const u32x2*)(O + ARR + ooff + 8 * g); es[g] = *(const u32x2*)(SGA + ooff + 8 * g); } }
            else if (it + G < 2048) s3_load(R, QH, X, it + G, 0, ts, vt, lane);
#pragma unroll
            for (int ks = 0; ks < 8; ++ks) { const bf16x8 a = *(const LAS bf16x8*)(XW + r * 136 + 16 * ks + 8 * hh), bb = *(const LAS bf16x8*)(QW + r * 136 + 16 * ks + 8 * hh); acc = MFMA32(a, bb, acc); }
        }
        float o[16]; float ss = 0.f;
#pragma unroll
        for (int g = 0; g < 4; ++g) { const u32x2 f = ef[g], bk = eb[g];
            o[4 * g] = acc[4 * g] + bflo(f.x) + bflo(bk.x); o[4 * g + 1] = acc[4 * g + 1] + bfhi(f.x) + bfhi(bk.x); o[4 * g + 2] = acc[4 * g + 2] + bflo(f.y) + bflo(bk.y); o[4 * g + 3] = acc[4 * g + 3] + bfhi(f.y) + bfhi(bk.y); }
#pragma unroll
        for (int i = 0; i < 16; ++i) ss += o[i] * o[i];
        ss += __shfl_xor(ss, 32);
        if (hh == 0) SS[(32 * ts + r) * 4 + vt] = ss;
        __syncthreads();
        const f32x4 s4 = *(const LAS f32x4*)(SS + (32 * ts + r) * 4);
        const float rstd = rsqrtf((s4.x + s4.y + s4.z + s4.w) * (1.0f / 128.0f) + 1e-6f);
#pragma unroll
        for (int g = 0; g < 4; ++g) { const u32x2 sg = es[g]; const f32x4 gv = *(const f32x4*)(gw_ + 32 * vt + 8 * g + 4 * hh);
            *(u32x2*)(YA + ooff + 8 * g) = (u32x2){pk2(o[4 * g] * rstd * gv.x * siluf_(bflo(sg.x)), o[4 * g + 1] * rstd * gv.y * siluf_(bfhi(sg.x))), pk2(o[4 * g + 2] * rstd * gv.z * siluf_(bflo(sg.y)), o[4 * g + 3] * rstd * gv.w * siluf_(bfhi(sg.y)))}; }
    }
}

DI void phase_spatial(LAS unsigned char* lds, const bf16_t* GV, bf16_t* UG, const f32x2* STATS, const float* ln_w, const float* ln_b, const float* w_s, const float* b_s, int G) {
    const int tid = opaque_tid(), lane = tid & 63, wave = __builtin_amdgcn_readfirstlane(tid >> 6);
    const int r = lane & 31, hh = lane >> 5;
    LAS bf16_t* VL = (LAS bf16_t*)(lds);
    LAS bf16_t* WS = (LAS bf16_t*)(lds + 34816);
    int g_last = -1;
    for (int it = blockIdx.x; it < 1024; it += G) {
        const int g = it & 7, n = (it >> 3) & 31, b = it >> 8;
        const size_t rowbase = (size_t)b * SEQ + (size_t)n * 128;
        __syncthreads();
        {
            const int s = tid >> 2, cq = tid & 3; const f32x2 st = STATS[rowbase + s];
            const bf16_t* p = GV + (rowbase + s) * D + 128 * g + 32 * cq;
#pragma unroll
            for (int q = 0; q < 4; ++q) { const u32x4 a = *(const u32x4*)(p + 8 * q); const unsigned aw[4] = {a.x, a.y, a.z, a.w};
                const f32x4 w0 = *(const f32x4*)(ln_w + 128 * g + 32 * cq + 8 * q), w1 = *(const f32x4*)(ln_w + 128 * g + 32 * cq + 8 * q + 4);
                const f32x4 c0 = *(const f32x4*)(ln_b + 128 * g + 32 * cq + 8 * q), c1 = *(const f32x4*)(ln_b + 128 * g + 32 * cq + 8 * q + 4);
                const float wv[8] = {w0.x, w0.y, w0.z, w0.w, w1.x, w1.y, w1.z, w1.w}, bv[8] = {c0.x, c0.y, c0.z, c0.w, c1.x, c1.y, c1.z, c1.w};
#pragma unroll
                for (int w = 0; w < 4; ++w) { const float y0 = (bflo(aw[w]) - st.x) * st.y * wv[2 * w] + bv[2 * w], y1 = (bfhi(aw[w]) - st.x) * st.y * wv[2 * w + 1] + bv[2 * w + 1];
                    const unsigned pk = pk2(y0, y1); const int cc = 32 * cq + 8 * q + 2 * w;
                    VL[cc * 136 + s] = (bf16_t)(pk & 0xffffu); VL[(cc + 1) * 136 + s] = (bf16_t)(pk >> 16); } }
            if (g != g_last) {
                const int t = tid >> 2, sq = tid & 3; const float* wp = w_s + ((size_t)g * 128 + t) * 128 + 32 * sq;
#pragma unroll
                for (int q = 0; q < 4; ++q) { const f32x4 x0 = *(const f32x4*)(wp + 8 * q), x1 = *(const f32x4*)(wp + 8 * q + 4);
                    *(LAS u32x4*)(WS + t * 136 + 32 * sq + 8 * q) = (u32x4){pk2(x0.x, x0.y), pk2(x0.z, x0.w), pk2(x1.x, x1.y), pk2(x1.z, x1.w)}; }
                g_last = g; }
        }
        __syncthreads();
        {
            const int cm = wave & 3;
#pragma unroll
            for (int tt = 0; tt < 2; ++tt) {
                const int tn = 2 * (wave >> 2) + tt;
                f32x16 acc;
#pragma unroll
                for (int i = 0; i < 16; ++i) acc[i] = 0.f;
#pragma unroll
                for (int ks = 0; ks < 8; ++ks) { const bf16x8 a = *(const LAS bf16x8*)(VL + (32 * cm + r) * 136 + 16 * ks + 8 * hh), bb = *(const LAS bf16x8*)(WS + (32 * tn + r) * 136 + 16 * ks + 8 * hh); acc = MFMA32(a, bb, acc); }
                const int t = 32 * tn + r; const float bias = b_s[g * 128 + t];
                bf16_t* up = UG + (rowbase + t) * D + 128 * g + 32 * cm + 4 * hh;
#pragma unroll
                for (int q = 0; q < 4; ++q) { const u32x2 uw = *(const u32x2*)(up + 8 * q);
                    *(u32x2*)(up + 8 * q) = (u32x2){pk2(bflo(uw.x) * (acc[4 * q] + bias), bfhi(uw.x) * (acc[4 * q + 1] + bias)), pk2(bflo(uw.y) * (acc[4 * q + 2] + bias), bfhi(uw.y) * (acc[4 * q + 3] + bias))}; }
            }
        }
    }
}

struct Args { const float* in[13]; float* out; unsigned char* ws; int ph_lo, ph_hi; };
constexpr int PPL = 11;
constexpr int NPH = 4 * PPL + 1;

__global__ void __launch_bounds__(512, 2) mega(Args a) {
    extern __shared__ __attribute__((aligned(16))) unsigned char shm[];
    LAS unsigned char* lds = (LAS unsigned char*)shm;
    cg::grid_group grid = cg::this_grid();
    const int G = gridDim.x, blk = blockIdx.x;
    unsigned char* ws = a.ws;
    const float* x0 = a.in[0];
    bf16_t* Hb = (bf16_t*)(ws + WS_H); bf16_t* out9 = (bf16_t*)(ws + WS_OUT9);
    bf16_t* Qb = out9, *ZFb = out9 + ARR, *Ib = out9 + 3 * ARR, *SGAb = out9 + 4 * ARR, *GVb = out9 + 5 * ARR;
    bf16_t* g3 = (bf16_t*)(ws + WS_G3); bf16_t* UGf = g3, *SMAf = g3 + 2 * ARR, *SMBf = g3 + 4 * ARR;
    bf16_t* OFb = (bf16_t*)(ws + WS_OF); bf16_t* Xb = (bf16_t*)(ws + WS_X); float* ACb = (float*)(ws + WS_AC); f32x2* STb = (f32x2*)(ws + WS_ST);
    volatile LAS unsigned* bst = (volatile LAS unsigned*)(lds + LDS_BYTES - 16);
    if (threadIdx.x < 4) bst[threadIdx.x] = 0u;
    if (blk == 0) for (int i = threadIdx.x; i < XCD_BAR_WORDS; i += 512) ((unsigned*)ws)[i] = 0u;
    __syncthreads();
    XcdBarrier xb; xb.bar = (unsigned*)ws; xb.x = 0; xb.st = bst;
    for (int ph = a.ph_lo; ph < a.ph_hi; ++ph) {
        if (ph == a.ph_lo + 1) { grid.sync(); xb = xcd_barrier_post((unsigned*)ws, bst); }
        else if (ph > a.ph_lo + 1) xcd_barrier(xb);
        if (ph == NPH - 1) { phase_final(a.out, a.in[12], M_ALL, G); continue; }
        const int l = ph / PPL, rr = ph % PPL;
        const float* xin = (l == 0) ? x0 : a.out;
        if (rr == 0) {
            phase_prep(lds, a.in[2] + (size_t)l * D * NIN, a.in[9] + (size_t)l * D * D, a.in[10] + (size_t)l * D * D, a.in[11] + (size_t)l * D * D, ws, G);
            phase_rms_bf16(xin, a.in[1] + l * D, Hb, M_ALL, G);
            if (blk == 0) {
                float* LBT = (float*)(ws + WS_LBT);
                for (int i = threadIdx.x; i < 2048; i += 512) { const float* lp = a.in[3] + i;
                    const float v0 = lp[0], v1 = lp[2048], v2 = lp[4096], v3 = lp[6144], mx = fmaxf(fmaxf(v0, v1), fmaxf(v2, v3));
                    const float e0 = __expf(v0 - mx), e1 = __expf(v1 - mx), e2 = __expf(v2 - mx), e3 = __expf(v3 - mx);
                    float lb = 0.f; if (l >= 1) lb += e1; if (l >= 2) lb += e2; if (l >= 3) lb += e3;
                    lb = lb / (e0 + e1 + e2 + e3);
                    LBT[(i >> 10) * 2048 + (i & 1023)] = fmaxf(lb, 1e-20f); LBT[(i >> 10) * 2048 + 1024 + (i & 1023)] = 1.0f - lb; }
            }
            continue;
        }
        const int hf = (rr <= 8) ? (rr - 1) / 4 : 0, k = (rr <= 8) ? (rr - 1) % 4 : rr - 5;
        bf16_t* Hh = Hb + (size_t)hf * ARR;
        bf16_t* UGb = UGf + (size_t)hf * ARR;
        if (k == 0) {
            pg8::Gemm g{Hh, Hh, (const bf16_t*)(ws + WS_WIN), (const bf16_t*)(ws + WS_WIN), D};
            pg8::Order S; S.init(MH, NIN, G, blk, 0);
            EpiInProj E{out9, g3 + (size_t)hf * ARR};
            pg8::gemm_phase<EpiInProj>(lds, g, S, E);
        } else if (k == 1) {
            phase_lnstats(GVb, STb, G);
            phase_s1(lds, Qb, ZFb, Ib, OFb, Xb, ACb, (const float*)(ws + WS_LBT), G);
        } else if (k == 2) {
            if (blk & 1) phase_s2(Xb, ACb, G);
            phase_spatial(lds, GVb, UGb, STb, a.in[5] + l * D, a.in[6] + l * D, a.in[7] + (size_t)l * 8 * 128 * 128, a.in[8] + l * 8 * 128, G);
            if (!(blk & 1)) phase_s2(Xb, ACb, G);
        } else if (k == 3) {
            phase_s3(lds, ZFb, OFb, Xb, SGAb, a.in[4] + l * 128, Hh, G);
        } else if (k == 4) {
            pg8::Gemm g{Hb, UGf, (const bf16_t*)(ws + WS_WA), (const bf16_t*)(ws + WS_WB), D};
            pg8::Order S; S.init(M_ALL, D, G, blk, 1);
            EpiProjAB E{SMAf, SMBf, out9};
            pg8::gemm_phase<EpiProjAB>(lds, g, S, E);
        } else {
            pg8::Gemm g{out9, out9, (const bf16_t*)(ws + WS_WO), (const bf16_t*)(ws + WS_WO), D};
            pg8::Order S; S.init(M_ALL, D, G, blk, 0);
            EpiResid E{xin, a.out};
            pg8::gemm_phase<EpiResid>(lds, g, S, E);
        }
    }
}


extern "C" void kernel_launch(void* const* d_in, const int* in_sizes, int n_in, void* d_out, int out_size, void* d_ws, size_t ws_size, hipStream_t stream) {
    static int grid = 0;
    if (grid == 0) {
        if (n_in != 13 || ws_size < WS_END) { fprintf(stderr, "kernel_launch: unexpected inputs (n_in %d, ws %zu, need %zu)\n", n_in, ws_size, (size_t)WS_END); grid = -1; return; }
        int dev = 0, cus = 0, per_cu = 0;
        hipGetDevice(&dev); hipDeviceGetAttribute(&cus, hipDeviceAttributeMultiprocessorCount, dev);
        if (hipFuncSetAttribute((const void*)mega, hipFuncAttributeMaxDynamicSharedMemorySize, LDS_BYTES) != hipSuccess) { fprintf(stderr, "kernel_launch: hipFuncSetAttribute failed\n"); grid = -1; return; }
        if (hipOccupancyMaxActiveBlocksPerMultiprocessor(&per_cu, (const void*)mega, 512, LDS_BYTES) != hipSuccess || per_cu < 1) { fprintf(stderr, "kernel_launch: occupancy query gave %d\n", per_cu); per_cu = 1; }
        (void)hipGetLastError();
        grid = cus * 1;
        fprintf(stderr, "kernel_launch: cus %d per_cu %d grid %d\n", cus, per_cu, grid);
    }
    if (grid < 0) return;
    Args a{};
    for (int i = 0; i < 13; ++i) a.in[i] = (const float*)d_in[i];
    a.out = (float*)d_out; a.ws = (unsigned char*)d_ws; a.ph_lo = 0; a.ph_hi = NPH;
    void* args[] = {&a};
    hipError_t e = hipLaunchCooperativeKernel((const void*)mega, dim3(grid), dim3(512), args, LDS_BYTES, stream);
    if (e != hipSuccess) fprintf(stderr, "kernel_launch: cooperative launch failed: %s (grid %d)\n", hipGetErrorString(e), grid);
}
```

```cpp
#include <hip/hip_runtime.h>
#include <hip/hip_cooperative_groups.h>
#include <cstdio>
namespace cg = cooperative_groups;

#define LAS __attribute__((address_space(3)))
#define DI __device__ __forceinline__
typedef unsigned short bf16_t;
typedef short bf16x8 __attribute__((ext_vector_type(8)));
typedef float f32x4 __attribute__((ext_vector_type(4)));
typedef float f32x2 __attribute__((ext_vector_type(2)));
typedef float f32x16 __attribute__((ext_vector_type(16)));
typedef unsigned u32x4 __attribute__((ext_vector_type(4)));
typedef unsigned u32x2 __attribute__((ext_vector_type(2)));
typedef __bf16 bf16v2 __attribute__((ext_vector_type(2)));

constexpr int D = 1024, SEQ = 4096, MH = 16384, M_ALL = 32768, DEPTH = 4, NIN = 10240;
constexpr int LDS_BYTES = 163840;
constexpr float LOG2E = 1.4426950408889634f;
constexpr size_t ARR = (size_t)MH * D;

constexpr size_t WS_WIN = 1ull << 20;
constexpr size_t WS_WA = WS_WIN + (size_t)NIN * D * 2;
constexpr size_t WS_WB = WS_WA + (size_t)D * D * 2;
constexpr size_t WS_WO = WS_WB + (size_t)D * D * 2;
constexpr size_t WS_H = WS_WO + (size_t)D * D * 2;
constexpr size_t WS_OUT9 = WS_H + (size_t)M_ALL * D * 2;
constexpr size_t WS_G3 = WS_OUT9 + 6 * ARR * 2;
constexpr size_t WS_OF = WS_G3 + 6 * ARR * 2;
constexpr size_t WS_X = WS_OF + 2 * ARR * 2;
constexpr size_t WS_AC = WS_X + (size_t)64 * 32 * 16384 * 2;
constexpr size_t WS_ST = WS_AC + (size_t)64 * 32 * 128 * 4;
constexpr size_t WS_LBT = WS_ST + (size_t)MH * 8;
constexpr size_t WS_END = WS_LBT + 4096 * 4;

DI unsigned pk2(float lo, float hi) { f32x2 v = {lo, hi}; bf16v2 r = __builtin_convertvector(v, bf16v2); return __builtin_bit_cast(unsigned, r); }
DI float bflo(unsigned w) { return __uint_as_float(w << 16); }
DI float bfhi(unsigned w) { return __uint_as_float(w & 0xffff0000u); }
DI float fexp2(float x) { return __builtin_amdgcn_exp2f(x); }
DI float frcp(float x) { return __builtin_amdgcn_rcpf(x); }
DI float sigmoidf_(float x) { return frcp(1.0f + fexp2(-x * LOG2E)); }
DI float siluf_(float x) { return x * sigmoidf_(x); }
DI float geluf_(float x) { const float t = x + 0.044715f * x * x * x; return x * frcp(1.0f + fexp2(-2.3022082f * t)); }
DI float wave_sum(float v) {
#pragma unroll
    for (int o = 1; o < 64; o <<= 1) v += __shfl_xor(v, o);
    return v;
}
#define LDS_WAIT() asm volatile("s_waitcnt lgkmcnt(0)" ::: "memory")
template <int CTRL, int ROWMASK, bool BC> DI float dpp_f(float x) { return __int_as_float(__builtin_amdgcn_update_dpp(0, __float_as_int(x), CTRL, ROWMASK, 0xf, BC)); }
DI int opaque_tid() { int t = threadIdx.x; asm volatile("" : "+v"(t)); return t; }


#define XB_TMO      128
#define XB_XCNT(j)  (256  + 64 * (j))
#define XB_XSUB(j)  (1280 + 64 * (j))
#define XB_XGEN(j)  (2304 + 64 * (j))
#define XB_TOP      3328
#define XB_TOPGEN   3392
#define XCD_BAR_WORDS 3456
#define XB_SPIN_CAP (1u << 22)
DI unsigned xb_ld(unsigned* p)              { return __hip_atomic_load(p, __ATOMIC_RELAXED, __HIP_MEMORY_SCOPE_AGENT); }
DI unsigned xb_add(unsigned* p, unsigned v) { return __hip_atomic_fetch_add(p, v, __ATOMIC_RELAXED, __HIP_MEMORY_SCOPE_AGENT); }
DI unsigned xb_xcc_id() { return (unsigned)__builtin_amdgcn_s_getreg((3 << 11) | 20) & 0xFu; }
#define XB_SPIN(cond, bar) do { unsigned _sp = 0; while (cond) { __builtin_amdgcn_s_sleep(1); \
    if ((++_sp & 255u) == 0u) { if (xb_ld(&(bar)[XB_TMO])) break; if (_sp > XB_SPIN_CAP) { atomicAdd(&(bar)[XB_TMO], 1u); break; } } } } while (0)
struct XcdBarrier { unsigned* bar; unsigned x; volatile LAS unsigned* st; };
DI XcdBarrier xcd_barrier_post(unsigned* bar, volatile LAS unsigned* st) {
    XcdBarrier b; b.bar = bar; b.x = xb_xcc_id(); b.st = st;
    if (threadIdx.x == 0) (void)xb_add(&bar[XB_XCNT(b.x)], 1u);
    return b;
}
DI void xcd_barrier_complete(unsigned* bar, unsigned x, unsigned& nloc, unsigned& nx) {
    const unsigned G = gridDim.x * gridDim.y * gridDim.z;
    unsigned sum, cnt, mine, sp = 0u;
    for (;;) {
        sum = 0u; cnt = 0u; mine = 0u;
#pragma unroll
        for (unsigned j = 0; j < 16; ++j) { const unsigned c = xb_ld(&bar[XB_XCNT(j)]); sum += c; cnt += (c > 0u) ? 1u : 0u; mine = (j == x) ? c : mine; }
        if (sum == G) break;
        __builtin_amdgcn_s_sleep(1);
        if ((++sp & 255u) == 0u) { if (xb_ld(&bar[XB_TMO])) break; if (sp > XB_SPIN_CAP) { atomicAdd(&bar[XB_TMO], 1u); break; } }
    }
    nloc = mine > 0u ? mine : 1u; nx = cnt > 0u ? cnt : 1u;
}
DI void xcd_barrier(const XcdBarrier& b) {
    asm volatile("s_waitcnt vmcnt(0)" ::: "memory");
    __syncthreads();
    if (threadIdx.x == 0) {
        unsigned* bar = b.bar;
        __builtin_amdgcn_s_waitcnt(0);
        unsigned nloc = b.st[0], nx = b.st[1];
        if (nloc == 0u) { xcd_barrier_complete(bar, b.x, nloc, nx); b.st[0] = nloc; b.st[1] = nx; }
        const unsigned old = xb_add(&bar[XB_XSUB(b.x)], 1u);
        const unsigned gen = old / nloc;
        if (old + 1u == (gen + 1u) * nloc) {
            __builtin_amdgcn_fence(__ATOMIC_RELEASE, "agent");
            asm volatile("s_waitcnt vmcnt(0)" ::: "memory");
            const unsigned og = xb_add(&bar[XB_TOP], 1u);
            const unsigned tg = og / nx;
            if (og + 1u == (tg + 1u) * nx) xb_add(&bar[XB_TOPGEN], 1u);
            else XB_SPIN(xb_ld(&bar[XB_TOPGEN]) == tg, bar);
            __builtin_amdgcn_fence(__ATOMIC_ACQUIRE, "agent");
            xb_add(&bar[XB_XGEN(b.x)], 1u);
            asm volatile("s_waitcnt vmcnt(0)" ::: "memory");
        } else {
            XB_SPIN(xb_ld(&bar[XB_XGEN(b.x)]) == gen, bar);
            __builtin_amdgcn_fence(__ATOMIC_ACQUIRE, "agent");
            asm volatile("s_waitcnt vmcnt(0)" ::: "memory");
        }
    }
    __syncthreads();
}

namespace pg8 {
constexpr int BM = 256, BK = 64, HALF = 128, HTB = HALF * BK * 2, STAGE_BYTES = 8 * HTB, NXCD = 8, WGM = 8;
DI int lds_byte(int r, int c) { const int st = (r >> 4) * 2 + (c >> 5), rr = r & 15, cc = c & 31, ob = rr * 64 + cc * 2; return st * 1024 + (ob ^ (((ob >> 9) & 1) << 5)); }
DI void stage_rc(int b, int& R, int& C) { const int st = b / 1024, sb = b % 1024, swz = sb ^ (((sb >> 9) & 1) << 5); R = (st >> 1) * 16 + swz / 64; C = (st & 1) * 32 + (swz % 64) / 2; }
DI int perm32(int rho) { const int n = rho >> 4, i = rho & 15; return 8 * (i >> 2) + 4 * n + (i & 3); }

struct Unit { int pm, pn, sel; };
struct Gemm { const bf16_t* A0; const bf16_t* A1; const bf16_t* B0; const bf16_t* B1; int K; };
struct Order {
    int nM, nN, nwg, G, c, dual, rev;
    DI void init(int M, int N, int G_, int c_, int dual_, int rev_ = 0) { nM = M / BM; nN = N / BM; nwg = nM * nN; G = G_; c = c_; dual = dual_; rev = rev_; }
    DI bool next(int i, Unit& u) const {
        const int ti = dual ? (i >> 1) : i; u.sel = dual ? (i & 1) : 0;
        const long L = (long)ti * G + c; if (L >= nwg) return false;
        int wgid = (int)L; { const int q = nwg / NXCD, r = nwg % NXCD, xcd = wgid % NXCD, off = wgid / NXCD; wgid = (xcd < r ? xcd * (q + 1) : r * (q + 1) + (xcd - r) * q) + off; }
        const int nig = WGM * nN, gid = wgid / nig, fm = gid * WGM, gsz = (nM - fm) < WGM ? (nM - fm) : WGM;
        u.pm = fm + ((wgid % nig) % gsz); u.pn = (wgid % nig) / gsz; if (rev) u.pn = nN - 1 - u.pn; return true;
    }
};

template <class Epi>
DI void gemm_phase(LAS unsigned char* lds, const Gemm g, const Order& S, const Epi& E) {
    const int tid = opaque_tid(), wid = __builtin_amdgcn_readfirstlane(tid >> 6), lane = tid & 63, wr = wid >> 2, wc = wid & 3, fr = lane & 15, fq = lane >> 4;
    const int K = g.K, nt = K / BK;
    unsigned voffA[2], voffB[2];
#pragma unroll
    for (int i = 0; i < 2; ++i) { int R, C; stage_rc(tid * 16 + i * 8192, R, C); const int Rb = Epi::PERM ? ((R & ~31) + perm32(R & 31)) : R;
        voffA[i] = (unsigned)(R * K + C) * 2u; voffB[i] = (unsigned)(Rb * K + C) * 2u; }
    const size_t kstep = (size_t)(BK * 2);
    const size_t hstep = (size_t)HALF * K * 2;
    const size_t tstep = 2 * hstep;
    const unsigned ldsw = (unsigned)wid * 1024u;
    const int aoff = lds_byte(wr * 64 + fr, fq * 8), boff = lds_byte(wc * 32 + fr, fq * 8);
#define PG8_SA(b, h) (((b) * 2 + (h)) * HTB)
#define PG8_SB(b, h) ((4 + (b) * 2 + (h)) * HTB)
#define PG8_STAGE(bufoff, gbase, voff) do { _Pragma("unroll") for (int _i = 0; _i < 2; ++_i) \
        __builtin_amdgcn_global_load_lds((const unsigned*)((const char*)(gbase) + (voff)[_i]), (LAS unsigned*)(lds + (bufoff) + ldsw + _i * 8192), 16, 0, 0); } while (0)
#define PG8_LDA(dst, b, h) do { _Pragma("unroll") for (int m = 0; m < 4; ++m) _Pragma("unroll") for (int k = 0; k < 2; ++k) dst[m][k] = *(const LAS bf16x8*)(lds + PG8_SA(b, h) + aoff + m * 2048 + k * 1024); } while (0)
#define PG8_LDB(dst, b, h) do { _Pragma("unroll") for (int n = 0; n < 2; ++n) _Pragma("unroll") for (int k = 0; k < 2; ++k) dst[n][k] = *(const LAS bf16x8*)(lds + PG8_SB(b, h) + boff + n * 2048 + k * 1024); } while (0)
#define PG8_MMA(ai, bj, At, Bt) do { __builtin_amdgcn_s_setprio(1); _Pragma("unroll") for (int m = 0; m < 4; ++m) _Pragma("unroll") for (int n = 0; n < 2; ++n) _Pragma("unroll") for (int k = 0; k < 2; ++k) \
        acc[ai][bj][m][n] = __builtin_amdgcn_mfma_f32_16x16x32_bf16(Bt[n][k], At[m][k], acc[ai][bj][m][n], 0, 0, 0); __builtin_amdgcn_s_setprio(0); } while (0)
#define PG8_WAIT_V(n) asm volatile("s_waitcnt vmcnt(" #n ")" ::: "memory")
#define PG8_WAIT_L(n) asm volatile("s_waitcnt lgkmcnt(" #n ")" ::: "memory")
#define PG8_BAR __builtin_amdgcn_s_barrier()
#define PG8_SCHED __builtin_amdgcn_sched_barrier(0)
    Unit cur, nxt; int ui = 0;
    if (!S.next(0, cur)) return;
    f32x4 acc[2][2][4][2];
#pragma unroll
    for (int a = 0; a < 2; ++a)
#pragma unroll
        for (int b = 0; b < 2; ++b)
#pragma unroll
            for (int m = 0; m < 4; ++m)
#pragma unroll
                for (int n = 0; n < 2; ++n) acc[a][b][m][n] = (f32x4){0.f, 0.f, 0.f, 0.f};
    bf16x8 At[4][2], B0[2][2], B1[2][2];
    const char* cA = (const char*)(cur.sel ? g.A1 : g.A0) + (size_t)cur.pm * tstep; const char* cB = (const char*)(cur.sel ? g.B1 : g.B0) + (size_t)cur.pn * tstep;
    PG8_STAGE(PG8_SB(0, 0), cB, voffB); PG8_STAGE(PG8_SB(0, 1), cB + hstep, voffB); PG8_STAGE(PG8_SA(0, 0), cA, voffA); PG8_STAGE(PG8_SA(0, 1), cA + hstep, voffA);
    if (wr == 1) PG8_BAR;
    PG8_WAIT_V(2); PG8_BAR;
    PG8_STAGE(PG8_SB(1, 0), cB + kstep, voffB); PG8_STAGE(PG8_SA(1, 0), cA + kstep, voffA); PG8_STAGE(PG8_SB(1, 1), cB + hstep + kstep, voffB);
    PG8_WAIT_V(6); PG8_BAR;
    for (;;) {
        const bool has_next = S.next(ui + 1, nxt);
        const char* nA = has_next ? (const char*)(nxt.sel ? g.A1 : g.A0) + (size_t)nxt.pm * tstep : cA; const char* nB = has_next ? (const char*)(nxt.sel ? g.B1 : g.B0) + (size_t)nxt.pn * tstep : cB;
        for (int t = 0; t < nt; t += 2) {
            const bool last = (t == nt - 2);
            const char* a1 = cA + (size_t)(t + 1) * kstep;
            const char* a2 = last ? nA : cA + (size_t)(t + 2) * kstep; const char* b2 = last ? nB : cB + (size_t)(t + 2) * kstep;
            const char* a3 = a2 + kstep; const char* b3 = b2 + kstep;
            PG8_LDB(B0, 0, 0); PG8_LDB(B1, 0, 1); PG8_SCHED; PG8_LDA(At, 0, 0); PG8_STAGE(PG8_SA(1, 1), a1 + hstep, voffA);
            PG8_WAIT_V(8); PG8_WAIT_L(0); PG8_BAR; PG8_MMA(0, 0, At, B0); PG8_MMA(0, 1, At, B1); PG8_BAR; PG8_SCHED;
            PG8_LDA(At, 0, 1); PG8_STAGE(PG8_SB(0, 0), b2, voffB); PG8_STAGE(PG8_SB(0, 1), b2 + hstep, voffB); PG8_STAGE(PG8_SA(0, 0), a2, voffA);
            PG8_WAIT_V(8); PG8_WAIT_L(0); PG8_BAR; PG8_MMA(1, 0, At, B0); PG8_MMA(1, 1, At, B1); PG8_BAR; PG8_SCHED;
            PG8_LDB(B0, 1, 0); PG8_LDB(B1, 1, 1); PG8_SCHED; PG8_LDA(At, 1, 0); PG8_STAGE(PG8_SA(0, 1), a2 + hstep, voffA);
            PG8_WAIT_V(8); PG8_WAIT_L(0); PG8_BAR; PG8_MMA(0, 0, At, B0); PG8_MMA(0, 1, At, B1); PG8_BAR; PG8_SCHED;
            PG8_LDA(At, 1, 1); PG8_STAGE(PG8_SB(1, 0), b3, voffB); PG8_STAGE(PG8_SB(1, 1), b3 + hstep, voffB); PG8_STAGE(PG8_SA(1, 0), a3, voffA);
            PG8_WAIT_V(8); PG8_WAIT_L(0); PG8_BAR; PG8_MMA(1, 0, At, B0); PG8_MMA(1, 1, At, B1); PG8_BAR; PG8_SCHED;
        }
        if (wr == 0) PG8_BAR;
        bool keep = false;
        if constexpr (Epi::KEEP) { if (cur.sel == 0) { E.mid(acc, cur, wr, wc, fr, fq); keep = true; } else E(acc, cur, wr, wc, fr, fq); }
        else E(acc, cur, wr, wc, fr, fq);
        if (!has_next) break;
        if (!keep)
#pragma unroll
        for (int a = 0; a < 2; ++a)
#pragma unroll
            for (int b = 0; b < 2; ++b)
#pragma unroll
                for (int m = 0; m < 4; ++m)
#pragma unroll
                    for (int n = 0; n < 2; ++n) acc[a][b][m][n] = (f32x4){0.f, 0.f, 0.f, 0.f};
        cur = nxt; cA = nA; cB = nB; ++ui;
        if (wr == 1) PG8_BAR;
    }
    PG8_WAIT_V(0);
    PG8_BAR;
#undef PG8_SA
#undef PG8_SB
#undef PG8_STAGE
#undef PG8_LDA
#undef PG8_LDB
#undef PG8_MMA
#undef PG8_WAIT_V
#undef PG8_WAIT_L
#undef PG8_BAR
#undef PG8_SCHED
}
}

template <int ACT> DI float act_fn(float x) {
    if (ACT == 0) return x;
    if (ACT == 1) return siluf_(x) * 0.08838834764831845f;
    if (ACT == 2) return siluf_(x);
    if (ACT == 3) return geluf_(x);
    return sigmoidf_(x);
}
template <int ACT> DI void store_act(const f32x4 (&acc)[2][2][4][2], bf16_t* base, int row0, int col0) {
#pragma unroll
    for (int ai = 0; ai < 2; ++ai)
#pragma unroll
        for (int m = 0; m < 4; ++m) { bf16_t* rowp = base + (size_t)(row0 + ai * 128 + m * 16) * D + col0;
#pragma unroll
            for (int bj = 0; bj < 2; ++bj) { const f32x4 v0 = acc[ai][bj][m][0], v1 = acc[ai][bj][m][1];
                u32x4 w; w.x = pk2(act_fn<ACT>(v0[0]), act_fn<ACT>(v0[1])); w.y = pk2(act_fn<ACT>(v0[2]), act_fn<ACT>(v0[3]));
                w.z = pk2(act_fn<ACT>(v1[0]), act_fn<ACT>(v1[1])); w.w = pk2(act_fn<ACT>(v1[2]), act_fn<ACT>(v1[3]));
                *(u32x4*)(rowp + bj * 128) = w; } }
}
struct EpiInProj {
    static constexpr bool PERM = true, KEEP = false;
    bf16_t* out9; bf16_t* g3;
    DI void operator()(const f32x4 (&acc)[2][2][4][2], const pg8::Unit& u, int wr, int wc, int fr, int fq) const {
        const int pn = u.pn, row0 = u.pm * 256 + wr * 64 + fr, cl = wc * 32 + 8 * fq;
        if (pn >= 20 && pn < 28) {
            bf16_t* base = g3; const int col0 = 128 * (pn - 20) + cl;
#pragma unroll
            for (int ai = 0; ai < 2; ++ai)
#pragma unroll
                for (int m = 0; m < 4; ++m) { bf16_t* rowp = base + (size_t)(row0 + ai * 128 + m * 16) * D + col0;
                    const f32x4 u0 = acc[ai][0][m][0], u1 = acc[ai][0][m][1], g0 = acc[ai][1][m][0], g1 = acc[ai][1][m][1];
                    u32x4 w; w.x = pk2(geluf_(u0[0]) * siluf_(g0[0]), geluf_(u0[1]) * siluf_(g0[1])); w.y = pk2(geluf_(u0[2]) * siluf_(g0[2]), geluf_(u0[3]) * siluf_(g0[3]));
                    w.z = pk2(geluf_(u1[0]) * siluf_(g1[0]), geluf_(u1[1]) * siluf_(g1[1])); w.w = pk2(geluf_(u1[2]) * siluf_(g1[2]), geluf_(u1[3]) * siluf_(g1[3]));
                    *(u32x4*)rowp = w; }
            return;
        }
        if (pn >= 32) {
            bf16_t* sa = g3 + 2 * ARR; bf16_t* rh = g3 + 4 * ARR; const int col0 = 128 * (pn - 32) + cl;
#pragma unroll
            for (int ai = 0; ai < 2; ++ai)
#pragma unroll
                for (int m = 0; m < 4; ++m) { const size_t off = (size_t)(row0 + ai * 128 + m * 16) * D + col0;
                    const f32x4 a0 = acc[ai][0][m][0], a1 = acc[ai][0][m][1], b0 = acc[ai][1][m][0], b1 = acc[ai][1][m][1];
                    const float av[8] = {a0[0], a0[1], a0[2], a0[3], a1[0], a1[1], a1[2], a1[3]}, bv[8] = {b0[0], b0[1], b0[2], b0[3], b1[0], b1[1], b1[2], b1[3]};
                    float sg[8], ro[8];
#pragma unroll
                    for (int j = 0; j < 8; ++j) { const float da = 1.0f + fexp2(-av[j] * LOG2E), db = 1.0f + fexp2(-bv[j] * LOG2E); sg[j] = frcp(da); ro[j] = fminf(da * frcp(db), 3.0e38f); }
                    __builtin_nontemporal_store((u32x4){pk2(sg[0], sg[1]), pk2(sg[2], sg[3]), pk2(sg[4], sg[5]), pk2(sg[6], sg[7])}, (u32x4*)(sa + off));
                    __builtin_nontemporal_store((u32x4){pk2(ro[0], ro[1]), pk2(ro[2], ro[3]), pk2(ro[4], ro[5]), pk2(ro[6], ro[7])}, (u32x4*)(rh + off)); }
            return;
        }
        int idx, ct;
        if (pn < 20) { idx = pn >> 2; ct = pn & 3; } else { idx = 6; ct = pn - 28; }
        bf16_t* base = (idx <= 4) ? out9 + (size_t)idx * ARR : out9 + 5 * ARR; const int col0 = 256 * ct + cl;
        if (idx == 0) store_act<1>(acc, base, row0, col0);
        else if (idx <= 3) store_act<0>(acc, base, row0, col0);
        else if (idx == 4) store_act<0>(acc, base, row0, col0);
        else store_act<3>(acc, base, row0, col0);
    }
};
struct EpiProjAB {
    static constexpr bool PERM = true, KEEP = true;
    const bf16_t* SMA; const bf16_t* RHO; bf16_t* MG;
    DI void mid(f32x4 (&acc)[2][2][4][2], const pg8::Unit& u, int wr, int wc, int fr, int fq) const {
        const int row0 = u.pm * 256 + wr * 64 + fr, col0 = u.pn * 256 + wc * 32 + 8 * fq;
#pragma unroll
        for (int ai = 0; ai < 2; ++ai)
#pragma unroll
            for (int m = 0; m < 4; ++m) { const size_t off = (size_t)(row0 + ai * 128 + m * 16) * D + col0;
#pragma unroll
                for (int bj = 0; bj < 2; ++bj) { const u32x4 gw = *(const u32x4*)(RHO + off + bj * 128);
                    acc[ai][bj][m][0] = acc[ai][bj][m][0] * (f32x4){bflo(gw.x), bfhi(gw.x), bflo(gw.y), bfhi(gw.y)};
                    acc[ai][bj][m][1] = acc[ai][bj][m][1] * (f32x4){bflo(gw.z), bfhi(gw.z), bflo(gw.w), bfhi(gw.w)}; }
                asm volatile("" ::: "memory"); }
    }
    DI void operator()(const f32x4 (&acc)[2][2][4][2], const pg8::Unit& u, int wr, int wc, int fr, int fq) const {
        const int row0 = u.pm * 256 + wr * 64 + fr, col0 = u.pn * 256 + wc * 32 + 8 * fq;
#pragma unroll
        for (int ai = 0; ai < 2; ++ai)
#pragma unroll
            for (int m = 0; m < 4; ++m) { const size_t off = (size_t)(row0 + ai * 128 + m * 16) * D + col0;
#pragma unroll
                for (int bj = 0; bj < 2; ++bj) { const f32x4 v0 = acc[ai][bj][m][0], v1 = acc[ai][bj][m][1];
                    const u32x4 gw = *(const u32x4*)(SMA + off + bj * 128);
                    u32x4 w; w.x = pk2(v0[0] * bflo(gw.x), v0[1] * bfhi(gw.x)); w.y = pk2(v0[2] * bflo(gw.y), v0[3] * bfhi(gw.y)); w.z = pk2(v1[0] * bflo(gw.z), v1[1] * bfhi(gw.z)); w.w = pk2(v1[2] * bflo(gw.w), v1[3] * bfhi(gw.w));
                    *(u32x4*)(MG + off + bj * 128) = w; }
                asm volatile("" ::: "memory"); }
    }
};
struct EpiResid {
    static constexpr bool PERM = true, KEEP = false;
    const float* xin; float* out;
    DI void operator()(const f32x4 (&acc)[2][2][4][2], const pg8::Unit& u, int wr, int wc, int fr, int fq) const {
        const int row0 = u.pm * 256 + wr * 64 + fr, col0 = u.pn * 256 + wc * 32 + 8 * fq;
#pragma unroll
        for (int ai = 0; ai < 2; ++ai)
#pragma unroll
            for (int m = 0; m < 4; ++m) { const size_t off = (size_t)(row0 + ai * 128 + m * 16) * D + col0;
#pragma unroll
                for (int bj = 0; bj < 2; ++bj) {
                    const f32x4 o0 = *(const f32x4*)(xin + off + bj * 128) + acc[ai][bj][m][0], o1 = *(const f32x4*)(xin + off + bj * 128 + 4) + acc[ai][bj][m][1];
                    *(f32x4*)(out + off + bj * 128) = o0; *(f32x4*)(out + off + bj * 128 + 4) = o1; }
                asm volatile("" ::: "memory"); }
    }
};

DI int src_col(int nv) {
    if (nv < 5120) return nv;
    if (nv < 7168) { const int t = (nv - 5120) >> 8, w = (nv - 5120) & 255; return w < 128 ? 5120 + 128 * t + w : 7168 + 128 * t + (w - 128); }
    if (nv < 8192) return 6144 + (nv - 7168);
    { const int t = (nv - 8192) >> 8, w = (nv - 8192) & 255; return w < 128 ? 8192 + 128 * t + w : 9216 + 128 * t + (w - 128); }
}
DI void transpose_item(const float* W, int N, bf16_t* WT, int k0, int nsrc0, int nvirt0, LAS float* scr, int lane) {
#pragma unroll 8
    for (int i = 0; i < 32; ++i) { const int kk = 2 * i + (lane >> 5); scr[kk * 33 + (lane & 31)] = W[(size_t)(k0 + kk) * N + nsrc0 + (lane & 31)]; }
    LDS_WAIT();
    const int c = lane & 7;
#pragma unroll
    for (int j = 0; j < 4; ++j) { const int n = (lane >> 3) + 8 * j; const LAS float* s = scr + (8 * c) * 33 + n;
        u32x4 o; o.x = pk2(s[0 * 33], s[1 * 33]); o.y = pk2(s[2 * 33], s[3 * 33]); o.z = pk2(s[4 * 33], s[5 * 33]); o.w = pk2(s[6 * 33], s[7 * 33]);
        *(u32x4*)(WT + (size_t)(nvirt0 + n) * D + k0 + 8 * c) = o; }
    LDS_WAIT();
}
DI void phase_prep(LAS unsigned char* lds, const float* w_in, const float* wa, const float* wb, const float* wo, unsigned char* ws, int G) {
    const int tid_ = opaque_tid(); const int lane = tid_ & 63, wave = __builtin_amdgcn_readfirstlane(tid_ >> 6);
    LAS float* scr = (LAS float*)(lds + wave * 16384);
    const int gw = blockIdx.x * 8 + wave, NGW = G * 8;
    constexpr int I_IN = 16 * 320, I_P = 16 * 32, PER_L = I_IN + 3 * I_P;
    for (int it = gw; it < PER_L; it += NGW) {
        int r = it;
        if (r < I_IN) { const int kb = r / 320, nb = r % 320; transpose_item(w_in, NIN, (bf16_t*)(ws + WS_WIN), 64 * kb, src_col(32 * nb), 32 * nb, scr, lane); continue; }
        r -= I_IN; const int which = r / I_P; r %= I_P; const int kb = r / 32, nb = r % 32;
        const float* W = (which == 0 ? wa : which == 1 ? wb : wo);
        bf16_t* WT = (bf16_t*)(ws + (which == 0 ? WS_WA : which == 1 ? WS_WB : WS_WO));
        transpose_item(W, D, WT, 64 * kb, 32 * nb, 32 * nb, scr, lane);
    }
}
DI void phase_rms_bf16(const float* x, const float* w, bf16_t* h, int nrows, int G) {
    const int tid_ = opaque_tid(); const int lane = tid_ & 63, wave = __builtin_amdgcn_readfirstlane(tid_ >> 6);
    const int gw = blockIdx.x * 8 + wave, NGW = G * 8;
    f32x4 wv[4];
#pragma unroll
    for (int j = 0; j < 4; ++j) wv[j] = ((const f32x4*)w)[lane + 64 * j];
    for (int m = gw; m < nrows; m += NGW) {
        const f32x4* xr = (const f32x4*)(x + (size_t)m * D) + lane; f32x4 v[4]; float s = 0.f;
#pragma unroll
        for (int j = 0; j < 4; ++j) { v[j] = xr[64 * j]; s += (v[j].x * v[j].x + v[j].y * v[j].y) + (v[j].z * v[j].z + v[j].w * v[j].w); }
        const float rstd = rsqrtf(wave_sum(s) * (1.0f / D) + 1e-6f);
        u32x2* o8 = (u32x2*)(h + (size_t)m * D) + lane;
#pragma unroll
        for (int j = 0; j < 4; ++j) { u32x2 o; o.x = pk2(v[j].x * rstd * wv[j].x, v[j].y * rstd * wv[j].y); o.y = pk2(v[j].z * rstd * wv[j].z, v[j].w * rstd * wv[j].w); o8[64 * j] = o; }
    }
}
DI void phase_final(float* x, const float* w, int nrows, int G) {
    const int tid_ = opaque_tid(); const int lane = tid_ & 63, wave = __builtin_amdgcn_readfirstlane(tid_ >> 6);
    const int gw = blockIdx.x * 8 + wave, NGW = G * 8;
    f32x4 wv[4];
#pragma unroll
    for (int j = 0; j < 4; ++j) wv[j] = ((const f32x4*)w)[lane + 64 * j];
    for (int m = gw; m < nrows; m += NGW) {
        f32x4* xr = (f32x4*)(x + (size_t)m * D) + lane; f32x4 v[4]; float s = 0.f;
#pragma unroll
        for (int j = 0; j < 4; ++j) { v[j] = xr[64 * j]; s += (v[j].x * v[j].x + v[j].y * v[j].y) + (v[j].z * v[j].z + v[j].w * v[j].w); }
        const float rstd = rsqrtf(wave_sum(s) * (1.0f / D) + 1e-6f);
#pragma unroll
        for (int j = 0; j < 4; ++j) xr[64 * j] = v[j] * rstd * wv[j];
    }
}
#define MFMA32(a, b, c) __builtin_amdgcn_mfma_f32_32x32x16_bf16((a), (b), (c), 0, 0, 0)
struct S1Regs { u32x4 q0, q1, z0, z1, v0, v1; };
DI size_t s1_rowoff(int it, int sub, int j) {
    const int sc = it & 31, dir = (it >> 5) & 1, h = (it >> 6) & 7, b = it >> 9, p = 64 * sub + j;
    return ((size_t)b * SEQ + sc * 128 + (dir ? 127 - p : p)) * D + h * 128;
}
DI void s1_load(S1Regs& R, const bf16_t* Q, const bf16_t* Z, const bf16_t* Iv, int it, int sub, int tid) {
    const size_t off = s1_rowoff(it, sub, tid >> 3) + 16 * (tid & 7);
    const bf16_t* zp = Z + (size_t)((it >> 5) & 1) * ARR;
    R.q0 = *(const u32x4*)(Q + off); R.q1 = *(const u32x4*)(Q + off + 8);
    R.z0 = *(const u32x4*)(zp + off); R.z1 = *(const u32x4*)(zp + off + 8);
    R.v0 = *(const u32x4*)(Iv + off); R.v1 = *(const u32x4*)(Iv + off + 8);
}
DI void phase_s1(LAS unsigned char* lds, const bf16_t* Q, bf16_t* Z, const bf16_t* Iv, bf16_t* O, bf16_t* X, float* AC, const float* LBT, int G) {
    const int tid = opaque_tid(), lane = tid & 63, wave = __builtin_amdgcn_readfirstlane(tid >> 6);
    const int r = lane & 31, hh = lane >> 5, j8 = tid >> 3, cg8 = tid & 7;
    LAS bf16_t* TQ = (LAS bf16_t*)(lds);
    LAS bf16_t* TV = (LAS bf16_t*)(lds + 17408);
    LAS bf16_t* TZ = (LAS bf16_t*)(lds + 34816);
    LAS bf16_t* QS = (LAS bf16_t*)(lds + 52224);
    LAS bf16_t* KSA = (LAS bf16_t*)(lds + 69632);
    LAS bf16_t* KSB = (LAS bf16_t*)(lds + 87040);
    LAS bf16_t* KHT = (LAS bf16_t*)(lds + 104448);
    LAS bf16_t* VT = (LAS bf16_t*)(lds + 122880);
    LAS float* TA = (LAS float*)(lds + 157696);
    LAS float* AA = TA + 128;
    LAS float* AB = TA + 256;
    LAS float* TT = TA + 384;
    LAS float* TR = TA + 512;
    LAS float* EC1 = TA + 640;
    LAS float* ER = TA + 768;
    LAS float* EF = TA + 896;
    LAS bf16_t* PS = TV;
    S1Regs R;
    int it = blockIdx.x;
    if (it < 2048) s1_load(R, Q, Z, Iv, it, 0, tid);
    __syncthreads();
    for (; it < 2048; it += G) {
        const int sc = it & 31, dir = (it >> 5) & 1, h = (it >> 6) & 7, b = it >> 9, seq = (b * 8 + h) * 2 + dir;
        f32x16 DA[2];
        float lbv[16], omv[16];
        { const float* lp = LBT + dir * 2048 + h * 128 + 16 * wave;
#pragma unroll
          for (int i = 0; i < 16; ++i) { lbv[i] = lp[i]; omv[i] = lp[1024 + i]; } }
#pragma unroll
        for (int sub = 0; sub < 2; ++sub) {
            *(LAS u32x4*)(TQ + j8 * 136 + 16 * cg8) = R.q0; *(LAS u32x4*)(TQ + j8 * 136 + 16 * cg8 + 8) = R.q1;
            *(LAS u32x4*)(TZ + j8 * 136 + 16 * cg8) = R.z0; *(LAS u32x4*)(TZ + j8 * 136 + 16 * cg8 + 8) = R.z1;
            *(LAS u32x4*)(TV + j8 * 136 + 16 * cg8) = R.v0; *(LAS u32x4*)(TV + j8 * 136 + 16 * cg8 + 8) = R.v1;
            __syncthreads();
            {
                const u32x4 z0 = *(const LAS u32x4*)(TZ + lane * 136 + 16 * wave), z1 = *(const LAS u32x4*)(TZ + lane * 136 + 16 * wave + 8);
                const u32x4 q0 = *(const LAS u32x4*)(TQ + lane * 136 + 16 * wave), q1 = *(const LAS u32x4*)(TQ + lane * 136 + 16 * wave + 8);
                const u32x4 v0 = *(const LAS u32x4*)(TV + lane * 136 + 16 * wave), v1 = *(const LAS u32x4*)(TV + lane * 136 + 16 * wave + 8);
                const unsigned zw[8] = {z0.x, z0.y, z0.z, z0.w, z1.x, z1.y, z1.z, z1.w};
                const unsigned qw[8] = {q0.x, q0.y, q0.z, q0.w, q1.x, q1.y, q1.z, q1.w};
                const unsigned vw[8] = {v0.x, v0.y, v0.z, v0.w, v1.x, v1.y, v1.z, v1.w};
                float kk[16], gg[16];
                if (sub == 0) s1_load(R, Q, Z, Iv, it, 1, tid); else if (it + G < 2048) s1_load(R, Q, Z, Iv, it + G, 0, tid);
#pragma unroll
                for (int i = 0; i < 16; ++i) { const unsigned w = zw[i >> 1]; float z = (i & 1) ? bfhi(w) : bflo(w); z = __builtin_amdgcn_fmed3f(z, -30.f, 30.f);
                    const float e = fexp2(-z * LOG2E), sg = frcp(1.0f + e); const float om = omv[i];
                    kk[i] = om * e * sg; gg[i] = __builtin_amdgcn_logf(lbv[i] + om * sg); }
#define S1_DPP16(MOD) asm volatile("s_nop 1\n\t" \
                    "v_add_f32_dpp %0, %0, %0 " MOD "\n\tv_add_f32_dpp %1, %1, %1 " MOD "\n\tv_add_f32_dpp %2, %2, %2 " MOD "\n\tv_add_f32_dpp %3, %3, %3 " MOD "\n\t" \
                    "v_add_f32_dpp %4, %4, %4 " MOD "\n\tv_add_f32_dpp %5, %5, %5 " MOD "\n\tv_add_f32_dpp %6, %6, %6 " MOD "\n\tv_add_f32_dpp %7, %7, %7 " MOD "\n\t" \
                    "v_add_f32_dpp %8, %8, %8 " MOD "\n\tv_add_f32_dpp %9, %9, %9 " MOD "\n\tv_add_f32_dpp %10, %10, %10 " MOD "\n\tv_add_f32_dpp %11, %11, %11 " MOD "\n\t" \
                    "v_add_f32_dpp %12, %12, %12 " MOD "\n\tv_add_f32_dpp %13, %13, %13 " MOD "\n\tv_add_f32_dpp %14, %14, %14 " MOD "\n\tv_add_f32_dpp %15, %15, %15 " MOD "\n\ts_nop 1" \
                    : "+v"(gg[0]), "+v"(gg[1]), "+v"(gg[2]), "+v"(gg[3]), "+v"(gg[4]), "+v"(gg[5]), "+v"(gg[6]), "+v"(gg[7]), \
                      "+v"(gg[8]), "+v"(gg[9]), "+v"(gg[10]), "+v"(gg[11]), "+v"(gg[12]), "+v"(gg[13]), "+v"(gg[14]), "+v"(gg[15]))
                S1_DPP16("row_shr:1 row_mask:0xf bank_mask:0xf bound_ctrl:1");
                S1_DPP16("row_shr:2 row_mask:0xf bank_mask:0xf bound_ctrl:1");
                S1_DPP16("row_shr:4 row_mask:0xf bank_mask:0xf bound_ctrl:1");
                S1_DPP16("row_shr:8 row_mask:0xf bank_mask:0xf bound_ctrl:1");
                S1_DPP16("row_bcast:15 row_mask:0xa bank_mask:0xf");
                S1_DPP16("row_bcast:31 row_mask:0xc bank_mask:0xf");
#undef S1_DPP16
                float Rv[16], aa[16], fv[16], erv[16];
#pragma unroll
                for (int i = 0; i < 16; ++i) Rv[i] = __int_as_float(__builtin_amdgcn_readlane(__float_as_int(gg[i]), 31));
                if (lane == 63) {
#pragma unroll
                    for (int q4 = 0; q4 < 4; ++q4) { const f32x4 t4 = (f32x4){gg[4 * q4] - Rv[4 * q4], gg[4 * q4 + 1] - Rv[4 * q4 + 1], gg[4 * q4 + 2] - Rv[4 * q4 + 2], gg[4 * q4 + 3] - Rv[4 * q4 + 3]};
                        *(LAS f32x4*)(TT + 16 * wave + 4 * q4) = t4; if (sub == 0) *(LAS f32x4*)(TA + 16 * wave + 4 * q4) = t4;
                        *(LAS f32x4*)(TR + 16 * wave + 4 * q4) = (f32x4){Rv[4 * q4], Rv[4 * q4 + 1], Rv[4 * q4 + 2], Rv[4 * q4 + 3]}; }
                }
                asm volatile("" ::: "memory");
                {
                    const int ci = 16 * wave + (lane & 15);
                    const float x1 = TT[ci], x2 = TR[ci];
                    const float e1 = fexp2(x1), e2 = fexp2(x2), ea = e1 * e2;
                    EC1[ci] = e1; ER[ci] = e2;
                    if (sub == 0) AA[ci] = ea;
                    else { const float aav = AA[ci]; AB[ci] = ea; EF[ci] = fexp2(x2 + TA[ci]);
                        if (lane < 16) AC[((size_t)seq * 32 + sc) * 128 + ci] = ea * aav; }
                }
                asm volatile("" ::: "memory");
#pragma unroll
                for (int q4 = 0; q4 < 4; ++q4) { const f32x4 e4 = *(const LAS f32x4*)(ER + 16 * wave + 4 * q4);
                    erv[4 * q4] = e4.x; erv[4 * q4 + 1] = e4.y; erv[4 * q4 + 2] = e4.z; erv[4 * q4 + 3] = e4.w;
                    if (sub == 1) { const f32x4 a4 = *(const LAS f32x4*)(AA + 16 * wave + 4 * q4), f4 = *(const LAS f32x4*)(EF + 16 * wave + 4 * q4);
                        aa[4 * q4] = a4.x; aa[4 * q4 + 1] = a4.y; aa[4 * q4 + 2] = a4.z; aa[4 * q4 + 3] = a4.w; fv[4 * q4] = f4.x; fv[4 * q4 + 1] = f4.y; fv[4 * q4 + 2] = f4.z; fv[4 * q4 + 3] = f4.w; } }
                unsigned qo[8], ko[8], qh[8];
#pragma unroll
                for (int w = 0; w < 8; ++w) {
                    float qt_[2], kt_[2], qh_[2];
#pragma unroll
                    for (int e2 = 0; e2 < 2; ++e2) { const int i = 2 * w + e2; const float qf = e2 ? bfhi(qw[w]) : bflo(qw[w]);
                        const float dq = gg[i] - Rv[i];
                        qt_[e2] = qf * fexp2(fminf(dq, 100.f)); kt_[e2] = kk[i] * fexp2(fminf(-dq, 100.f));
                        qh_[e2] = (sub == 0) ? qt_[e2] * erv[i] : qt_[e2] * erv[i] * aa[i]; }
                    qo[w] = pk2(qt_[0], qt_[1]); ko[w] = pk2(kt_[0], kt_[1]); qh[w] = pk2(qh_[0], qh_[1]);
                }
                LAS bf16_t* KSx = (sub == 0) ? KSA : KSB;
                *(LAS u32x4*)(QS + lane * 136 + 16 * wave) = (u32x4){qo[0], qo[1], qo[2], qo[3]}; *(LAS u32x4*)(QS + lane * 136 + 16 * wave + 8) = (u32x4){qo[4], qo[5], qo[6], qo[7]};
                *(LAS u32x4*)(KSx + lane * 136 + 16 * wave) = (u32x4){ko[0], ko[1], ko[2], ko[3]}; *(LAS u32x4*)(KSx + lane * 136 + 16 * wave + 8) = (u32x4){ko[4], ko[5], ko[6], ko[7]};
                *(LAS u32x4*)(TZ + lane * 136 + 16 * wave) = (u32x4){qh[0], qh[1], qh[2], qh[3]}; *(LAS u32x4*)(TZ + lane * 136 + 16 * wave + 8) = (u32x4){qh[4], qh[5], qh[6], qh[7]};
#pragma unroll
                for (int w = 0; w < 8; ++w) {
                    KHT[(16 * wave + 2 * w) * 72 + lane] = (bf16_t)(ko[w] & 0xffffu); KHT[(16 * wave + 2 * w + 1) * 72 + lane] = (bf16_t)(ko[w] >> 16);
                    VT[(16 * wave + 2 * w) * 136 + 64 * sub + lane] = (bf16_t)(vw[w] & 0xffffu); VT[(16 * wave + 2 * w + 1) * 136 + 64 * sub + lane] = (bf16_t)(vw[w] >> 16);
                }
                if (sub == 1) {
                    const u32x4 k0 = *(const LAS u32x4*)(KSA + lane * 136 + 16 * wave), k1 = *(const LAS u32x4*)(KSA + lane * 136 + 16 * wave + 8);
                    const unsigned kw[8] = {k0.x, k0.y, k0.z, k0.w, k1.x, k1.y, k1.z, k1.w}; unsigned kn[8];
#pragma unroll
                    for (int w = 0; w < 8; ++w) kn[w] = pk2(bflo(kw[w]) * fv[2 * w], bfhi(kw[w]) * fv[2 * w + 1]);
                    *(LAS u32x4*)(KSA + lane * 136 + 16 * wave) = (u32x4){kn[0], kn[1], kn[2], kn[3]}; *(LAS u32x4*)(KSA + lane * 136 + 16 * wave + 8) = (u32x4){kn[4], kn[5], kn[6], kn[7]};
                }
            }
            __syncthreads();
            {
                LAS bf16_t* KSx = (sub == 0) ? KSA : KSB;
                if (wave < 3) {
                    const int tm = (wave == 2) ? 1 : 0, tn = (wave == 0) ? 0 : 1;
                    f32x16 acc;
#pragma unroll
                    for (int i = 0; i < 16; ++i) acc[i] = 0.f;
#pragma unroll
                    for (int ks = 0; ks < 8; ++ks) { const bf16x8 a = *(const LAS bf16x8*)(KSx + (32 * tm + r) * 136 + 16 * ks + 8 * hh), bb = *(const LAS bf16x8*)(QS + (32 * tn + r) * 136 + 16 * ks + 8 * hh); acc = MFMA32(a, bb, acc); }
                    const int t = 32 * tn + r;
#pragma unroll
                    for (int g = 0; g < 4; ++g) { const int s0 = 32 * tm + 8 * g + 4 * hh;
                        const float p0 = (s0 + 0 <= t) ? acc[4 * g + 0] : 0.f, p1 = (s0 + 1 <= t) ? acc[4 * g + 1] : 0.f, p2 = (s0 + 2 <= t) ? acc[4 * g + 2] : 0.f, p3 = (s0 + 3 <= t) ? acc[4 * g + 3] : 0.f;
                        *(LAS u32x2*)(PS + t * 136 + 64 * sub + s0) = (u32x2){pk2(p0, p1), pk2(p2, p3)}; }
                } else if (sub == 1 && wave < 7) {
                    const int tm = (wave - 3) >> 1, tn = (wave - 3) & 1;
                    f32x16 acc;
#pragma unroll
                    for (int i = 0; i < 16; ++i) acc[i] = 0.f;
#pragma unroll
                    for (int ks = 0; ks < 8; ++ks) { const bf16x8 a = *(const LAS bf16x8*)(KSA + (32 * tm + r) * 136 + 16 * ks + 8 * hh), bb = *(const LAS bf16x8*)(QS + (32 * tn + r) * 136 + 16 * ks + 8 * hh); acc = MFMA32(a, bb, acc); }
                    const int t = 32 * tn + r;
#pragma unroll
                    for (int g = 0; g < 4; ++g) { const int s0 = 32 * tm + 8 * g + 4 * hh;
                        *(LAS u32x2*)(PS + t * 136 + s0) = (u32x2){pk2(acc[4 * g], acc[4 * g + 1]), pk2(acc[4 * g + 2], acc[4 * g + 3])}; }
                }
#pragma unroll
                for (int k = 0; k < 2; ++k) {
                    const int vt = wave >> 1, dt = 2 * (wave & 1) + k;
                    f32x16 acc;
#pragma unroll
                    for (int i = 0; i < 16; ++i) acc[i] = 0.f;
#pragma unroll
                    for (int ks = 0; ks < 4; ++ks) { const bf16x8 a = *(const LAS bf16x8*)(VT + (32 * vt + r) * 136 + 64 * sub + 16 * ks + 8 * hh), bb = *(const LAS bf16x8*)(KHT + (32 * dt + r) * 72 + 16 * ks + 8 * hh); acc = MFMA32(a, bb, acc); }
                    const float c1 = EC1[32 * dt + r];
                    if (sub == 0) {
#pragma unroll
                        for (int i = 0; i < 16; ++i) DA[k][i] = acc[i] * c1;
                    } else { const float ab = AB[32 * dt + r];
#pragma unroll
                        for (int i = 0; i < 16; ++i) acc[i] = DA[k][i] * ab + acc[i] * c1;
                        bf16_t* xp = X + ((size_t)seq * 32 + sc) * 16384 + (size_t)(32 * vt + 4 * hh) * 128 + 32 * dt + r;
#pragma unroll
                        for (int i = 0; i < 16; i += 2) { const unsigned p = pk2(acc[i], acc[i + 1]); const int v0 = (i & 3) + 8 * (i >> 2);
                            xp[(size_t)v0 * 128] = (bf16_t)(p & 0xffffu); xp[(size_t)(v0 + 1) * 128] = (bf16_t)(p >> 16); } }
                }
                {
                    bf16_t* zp = Z + (size_t)dir * ARR + s1_rowoff(it, sub, j8) + 16 * cg8;
                    __builtin_nontemporal_store(*(const LAS u32x4*)(TZ + j8 * 136 + 16 * cg8), (u32x4*)zp); __builtin_nontemporal_store(*(const LAS u32x4*)(TZ + j8 * 136 + 16 * cg8 + 8), (u32x4*)(zp + 8));
                }
            }
            __syncthreads();
            {
                const int vt = wave & 3, tn = wave >> 2;
                f32x16 acc;
#pragma unroll
                for (int i = 0; i < 16; ++i) acc[i] = 0.f;
                if (sub == 1) {
#pragma unroll
                    for (int ks = 0; ks < 4; ++ks) { const bf16x8 a = *(const LAS bf16x8*)(VT + (32 * vt + r) * 136 + 16 * ks + 8 * hh), bb = *(const LAS bf16x8*)(PS + (32 * tn + r) * 136 + 16 * ks + 8 * hh); acc = MFMA32(a, bb, acc); }
                }
#pragma unroll
                for (int ks = 0; ks < 4; ++ks) { if (ks < 2 * (tn + 1)) { const bf16x8 a = *(const LAS bf16x8*)(VT + (32 * vt + r) * 136 + 64 * sub + 16 * ks + 8 * hh), bb = *(const LAS bf16x8*)(PS + (32 * tn + r) * 136 + 64 * sub + 16 * ks + 8 * hh); acc = MFMA32(a, bb, acc); } }
                LAS bf16_t* op = QS + (32 * tn + r) * 136 + 32 * vt + 4 * hh;
#pragma unroll
                for (int g = 0; g < 4; ++g) *(LAS u32x2*)(op + 8 * g) = (u32x2){pk2(acc[4 * g], acc[4 * g + 1]), pk2(acc[4 * g + 2], acc[4 * g + 3])};
            }
            __syncthreads();
            {
                bf16_t* op = O + (size_t)dir * ARR + s1_rowoff(it, sub, j8) + 16 * cg8;
                __builtin_nontemporal_store(*(const LAS u32x4*)(QS + j8 * 136 + 16 * cg8), (u32x4*)op); __builtin_nontemporal_store(*(const LAS u32x4*)(QS + j8 * 136 + 16 * cg8 + 8), (u32x4*)(op + 8));
            }
        }
    }
}
DI void phase_lnstats(const bf16_t* GV, f32x2* STATS, int G) {
    const int tid_ = opaque_tid(); const int lane = tid_ & 63, wave = __builtin_amdgcn_readfirstlane(tid_ >> 6);
    const int gw = blockIdx.x * 8 + wave, NGW = G * 8;
    for (int m = gw; m < MH; m += NGW) {
        const bf16_t* p = GV + (size_t)m * D + 16 * lane;
        const u32x4 a0 = *(const u32x4*)p, a1 = *(const u32x4*)(p + 8);
        const unsigned aw[8] = {a0.x, a0.y, a0.z, a0.w, a1.x, a1.y, a1.z, a1.w};
        float s1 = 0.f, s2 = 0.f;
#pragma unroll
        for (int w = 0; w < 8; ++w) { const float x0 = bflo(aw[w]), x1 = bfhi(aw[w]); s1 += x0 + x1; s2 += x0 * x0 + x1 * x1; }
        s1 = wave_sum(s1); s2 = wave_sum(s2);
        const float mean = s1 * (1.0f / D), var = fmaxf(s2 * (1.0f / D) - mean * mean, 0.f);
        if (lane == 0) STATS[m] = (f32x2){mean, rsqrtf(var + 1e-5f)};
    }
}
DI void phase_s2(bf16_t* X, const float* AC, int G) {
    const int tid = opaque_tid();
    for (int gid = blockIdx.x * 512 + tid; gid < 64 * 2048; gid += G * 512) {
        const int seq = gid >> 11, e = gid & 2047, d0 = (e & 15) * 8, dir = seq & 1;
        bf16_t* xp = X + (size_t)seq * 32 * 16384 + (size_t)(e >> 4) * 128 + d0;
        const float* ap = AC + (size_t)seq * 32 * 128 + d0;
        float S[8];
#pragma unroll
        for (int i = 0; i < 8; ++i) S[i] = 0.f;
        for (int st = 0; st < 32; st += 8) {
            u32x4 dv[8]; f32x4 a0[8], a1[8];
#pragma unroll
            for (int u = 0; u < 8; ++u) { const int c = dir ? 31 - (st + u) : st + u; dv[u] = *(const u32x4*)(xp + (size_t)c * 16384); a0[u] = *(const f32x4*)(ap + c * 128); a1[u] = *(const f32x4*)(ap + c * 128 + 4); }
#pragma unroll
            for (int u = 0; u < 8; ++u) { const int c = dir ? 31 - (st + u) : st + u;
                *(u32x4*)(xp + (size_t)c * 16384) = (u32x4){pk2(S[0], S[1]), pk2(S[2], S[3]), pk2(S[4], S[5]), pk2(S[6], S[7])};
                S[0] = a0[u].x * S[0] + bflo(dv[u].x); S[1] = a0[u].y * S[1] + bfhi(dv[u].x); S[2] = a0[u].z * S[2] + bflo(dv[u].y); S[3] = a0[u].w * S[3] + bfhi(dv[u].y);
                S[4] = a1[u].x * S[4] + bflo(dv[u].z); S[5] = a1[u].y * S[5] + bfhi(dv[u].z); S[6] = a1[u].z * S[6] + bflo(dv[u].w); S[7] = a1[u].w * S[7] + bfhi(dv[u].w); }
        }
    }
}
struct S3Regs { u32x4 x[8], q[8]; };
DI void s3_decode(int it, int& c, int& h, int& b) { const int rest = (it & 7) | ((it >> 4) << 3); c = ((rest & 31) << 1) | ((it >> 3) & 1); h = (rest >> 5) & 7; b = rest >> 8; }
DI void s3_load(S3Regs& R, const bf16_t* QH, const bf16_t* X, int it, int dir, int ts, int vt, int lane) {
    int c, h, b; s3_decode(it, c, h, b);
    const bf16_t* xp = X + ((size_t)((b * 8 + h) * 2 + dir) * 32 + (c >> 1)) * 16384 + (size_t)(32 * vt) * 128 + 8 * lane;
    const bf16_t* qp = QH + (size_t)dir * ARR + ((size_t)b * SEQ + c * 64 + 32 * ts + (lane >> 4)) * D + h * 128 + 8 * (lane & 15);
#pragma unroll
    for (int k = 0; k < 8; ++k) { R.x[k] = *(const u32x4*)(xp + 512 * k); R.q[k] = *(const u32x4*)(qp + (size_t)(4 * k) * D); }
}
DI void phase_s3(LAS unsigned char* lds, const bf16_t* QH, const bf16_t* O, const bf16_t* X, const bf16_t* SGA, const float* gw_, bf16_t* YA, int G) {
    const int tid = opaque_tid(), lane = tid & 63, wave = __builtin_amdgcn_readfirstlane(tid >> 6);
    const int r = lane & 31, hh = lane >> 5, ts = wave >> 2, vt = wave & 3;
    LAS bf16_t* XW = (LAS bf16_t*)(lds + wave * 17408);
    LAS bf16_t* QW = XW + 32 * 136;
    LAS float* SS0 = (LAS float*)(lds + 8 * 17408);
    S3Regs R;
    int it = blockIdx.x;
    if (it < 2048) s3_load(R, QH, X, it, 0, ts, vt, lane);
    __syncthreads();
    for (int par = 0; it < 2048; it += G, par ^= 1) {
        int c, h, b; s3_decode(it, c, h, b);
        const size_t row = (size_t)b * SEQ + c * 64 + 32 * ts + r;
        LAS float* SS = SS0 + par * 256;
        const size_t eoff = ((size_t)b * SEQ + c * 64 + 32 * ts + (lane >> 2)) * D + h * 128 + 32 * vt + 8 * (lane & 3);
        u32x4 ef2[2], eb2[2], es2[2];
        f32x16 acc;
#pragma unroll
        for (int i = 0; i < 16; ++i) acc[i] = 0.f;
#pragma unroll
        for (int dir = 0; dir < 2; ++dir) {
#pragma unroll
            for (int k = 0; k < 8; ++k) { const int id = 64 * k + lane; *(LAS u32x4*)(XW + (id >> 4) * 136 + 8 * (id & 15)) = R.x[k]; *(LAS u32x4*)(QW + (id >> 4) * 136 + 8 * (id & 15)) = R.q[k]; }
            asm volatile("" ::: "memory");
            if (dir == 0) { s3_load(R, QH, X, it, 1, ts, vt, lane);
#pragma unroll
                for (int k = 0; k < 2; ++k) { ef2[k] = *(const u32x4*)(O + eoff + (size_t)(16 * k) * D); eb2[k] = *(const u32x4*)(O + ARR + eoff + (size_t)(16 * k) * D); es2[k] = *(const u32x4*)(SGA + eoff + (size_t)(16 * k) * D); } }
            else if (it + G < 2048) s3_load(R, QH, X, it + G, 0, ts, vt, lane);
#pragma unroll
            for (int ks = 0; ks < 8; ++ks) { const bf16x8 a = *(const LAS bf16x8*)(XW + r * 136 + 16 * ks + 8 * hh), bb = *(const LAS bf16x8*)(QW + r * 136 + 16 * ks + 8 * hh); acc = MFMA32(a, bb, acc); }
        }
        asm volatile("" ::: "memory");
        LAS bf16_t* T0 = XW; LAS bf16_t* T1 = XW + 1280; LAS bf16_t* T2 = XW + 2560; LAS bf16_t* TY = XW + 3840;
#pragma unroll
        for (int k = 0; k < 2; ++k) { const int eo = ((lane >> 2) + 16 * k) * 40 + 8 * (lane & 3);
            *(LAS u32x4*)(T0 + eo) = ef2[k]; *(LAS u32x4*)(T1 + eo) = eb2[k]; *(LAS u32x4*)(T2 + eo) = es2[k]; }
        asm volatile("" ::: "memory");
        u32x2 ef[4], eb[4], es[4];
#pragma unroll
        for (int g = 0; g < 4; ++g) { const int co = r * 40 + 8 * g + 4 * hh; ef[g] = *(const LAS u32x2*)(T0 + co); eb[g] = *(const LAS u32x2*)(T1 + co); es[g] = *(const LAS u32x2*)(T2 + co); }
        float o[16]; float ss = 0.f;
#pragma unroll
        for (int g = 0; g < 4; ++g) { const u32x2 f = ef[g], bk = eb[g];
            o[4 * g] = acc[4 * g] + bflo(f.x) + bflo(bk.x); o[4 * g + 1] = acc[4 * g + 1] + bfhi(f.x) + bfhi(bk.x); o[4 * g + 2] = acc[4 * g + 2] + bflo(f.y) + bflo(bk.y); o[4 * g + 3] = acc[4 * g + 3] + bfhi(f.y) + bfhi(bk.y); }
#pragma unroll
        for (int i = 0; i < 16; ++i) ss += o[i] * o[i];
        ss += __shfl_xor(ss, 32);
        if (hh == 0) SS[(32 * ts + r) * 4 + vt] = ss;
        __syncthreads();
        const f32x4 s4 = *(const LAS f32x4*)(SS + (32 * ts + r) * 4);
        const float rstd = rsqrtf((s4.x + s4.y + s4.z + s4.w) * (1.0f / 128.0f) + 1e-6f);
#pragma unroll
        for (int g = 0; g < 4; ++g) { const u32x2 sg = es[g]; const f32x4 gv = *(const f32x4*)(gw_ + 32 * vt + 8 * g + 4 * hh);
            *(LAS u32x2*)(TY + r * 40 + 8 * g + 4 * hh) = (u32x2){pk2(o[4 * g] * rstd * gv.x * siluf_(bflo(sg.x)), o[4 * g + 1] * rstd * gv.y * siluf_(bfhi(sg.x))), pk2(o[4 * g + 2] * rstd * gv.z * siluf_(bflo(sg.y)), o[4 * g + 3] * rstd * gv.w * siluf_(bfhi(sg.y)))}; }
        asm volatile("" ::: "memory");
#pragma unroll
        for (int k = 0; k < 2; ++k) *(u32x4*)(YA + eoff + (size_t)(16 * k) * D) = *(const LAS u32x4*)(TY + ((lane >> 2) + 16 * k) * 40 + 8 * (lane & 3));
        asm volatile("" ::: "memory");
    }
}

DI void phase_spatial(LAS unsigned char* lds, const bf16_t* GV, bf16_t* UG, const f32x2* STATS, const float* ln_w, const float* ln_b, const float* w_s, const float* b_s, int G) {
    const int tid = opaque_tid(), lane = tid & 63, wave = __builtin_amdgcn_readfirstlane(tid >> 6);
    const int r = lane & 31, hh = lane >> 5;
    LAS bf16_t* VL = (LAS bf16_t*)(lds);
    LAS bf16_t* WS = (LAS bf16_t*)(lds + 34816);
    int g_last = -1;
    for (int it = blockIdx.x; it < 1024; it += G) {
        const int g = it & 7, n = (it >> 3) & 31, b = it >> 8;
        const size_t rowbase = (size_t)b * SEQ + (size_t)n * 128;
        __syncthreads();
        {
            const int s = tid >> 2, cq = tid & 3; const f32x2 st = STATS[rowbase + s];
            const bf16_t* p = GV + (rowbase + s) * D + 128 * g + 32 * cq;
#pragma unroll
            for (int q = 0; q < 4; ++q) { const u32x4 a = *(const u32x4*)(p + 8 * q); const unsigned aw[4] = {a.x, a.y, a.z, a.w};
                const f32x4 w0 = *(const f32x4*)(ln_w + 128 * g + 32 * cq + 8 * q), w1 = *(const f32x4*)(ln_w + 128 * g + 32 * cq + 8 * q + 4);
                const f32x4 c0 = *(const f32x4*)(ln_b + 128 * g + 32 * cq + 8 * q), c1 = *(const f32x4*)(ln_b + 128 * g + 32 * cq + 8 * q + 4);
                const float wv[8] = {w0.x, w0.y, w0.z, w0.w, w1.x, w1.y, w1.z, w1.w}, bv[8] = {c0.x, c0.y, c0.z, c0.w, c1.x, c1.y, c1.z, c1.w};
#pragma unroll
                for (int w = 0; w < 4; ++w) { const float y0 = (bflo(aw[w]) - st.x) * st.y * wv[2 * w] + bv[2 * w], y1 = (bfhi(aw[w]) - st.x) * st.y * wv[2 * w + 1] + bv[2 * w + 1];
                    const unsigned pk = pk2(y0, y1); const int cc = 32 * cq + 8 * q + 2 * w;
                    VL[cc * 136 + s] = (bf16_t)(pk & 0xffffu); VL[(cc + 1) * 136 + s] = (bf16_t)(pk >> 16); } }
            if (g != g_last) {
                const int t = tid >> 2, sq = tid & 3; const float* wp = w_s + ((size_t)g * 128 + t) * 128 + 32 * sq;
#pragma unroll
                for (int q = 0; q < 4; ++q) { const f32x4 x0 = *(const f32x4*)(wp + 8 * q), x1 = *(const f32x4*)(wp + 8 * q + 4);
                    *(LAS u32x4*)(WS + t * 136 + 32 * sq + 8 * q) = (u32x4){pk2(x0.x, x0.y), pk2(x0.z, x0.w), pk2(x1.x, x1.y), pk2(x1.z, x1.w)}; }
                g_last = g; }
        }
        __syncthreads();
        {
            const int cm = wave & 3;
#pragma unroll
            for (int tt = 0; tt < 2; ++tt) {
                const int tn = 2 * (wave >> 2) + tt;
                f32x16 acc;
#pragma unroll
                for (int i = 0; i < 16; ++i) acc[i] = 0.f;
#pragma unroll
                for (int ks = 0; ks < 8; ++ks) { const bf16x8 a = *(const LAS bf16x8*)(VL + (32 * cm + r) * 136 + 16 * ks + 8 * hh), bb = *(const LAS bf16x8*)(WS + (32 * tn + r) * 136 + 16 * ks + 8 * hh); acc = MFMA32(a, bb, acc); }
                const int t = 32 * tn + r; const float bias = b_s[g * 128 + t];
                LAS bf16_t* TU = (LAS bf16_t*)(lds + 69632 + wave * 2560);
                bf16_t* ug = UG + (rowbase + 32 * tn + (lane >> 2)) * D + 128 * g + 32 * cm + 8 * (lane & 3);
                const int eo = (lane >> 2) * 40 + 8 * (lane & 3);
                const u32x4 u0 = *(const u32x4*)ug, u1 = *(const u32x4*)(ug + (size_t)16 * D);
                asm volatile("" ::: "memory");
                *(LAS u32x4*)(TU + eo) = u0; *(LAS u32x4*)(TU + eo + 16 * 40) = u1;
                asm volatile("" ::: "memory");
#pragma unroll
                for (int q = 0; q < 4; ++q) { const int co = r * 40 + 8 * q + 4 * hh; const u32x2 uw = *(const LAS u32x2*)(TU + co);
                    *(LAS u32x2*)(TU + co) = (u32x2){pk2(bflo(uw.x) * (acc[4 * q] + bias), bfhi(uw.x) * (acc[4 * q + 1] + bias)), pk2(bflo(uw.y) * (acc[4 * q + 2] + bias), bfhi(uw.y) * (acc[4 * q + 3] + bias))}; }
                asm volatile("" ::: "memory");
                *(u32x4*)ug = *(const LAS u32x4*)(TU + eo); *(u32x4*)(ug + (size_t)16 * D) = *(const LAS u32x4*)(TU + eo + 16 * 40);
                asm volatile("" ::: "memory");
            }
        }
    }
}

struct Args { const float* in[13]; float* out; unsigned char* ws; int ph_lo, ph_hi; };
constexpr int PPL = 11;
constexpr int NPH = 4 * PPL + 1;

__global__ void __launch_bounds__(512, 2) mega(Args a) {
    extern __shared__ __attribute__((aligned(16))) unsigned char shm[];
    LAS unsigned char* lds = (LAS unsigned char*)shm;
    cg::grid_group grid = cg::this_grid();
    const int G = gridDim.x, blk = blockIdx.x;
    unsigned char* ws = a.ws;
    const float* x0 = a.in[0];
    bf16_t* Hb = (bf16_t*)(ws + WS_H); bf16_t* out9 = (bf16_t*)(ws + WS_OUT9);
    bf16_t* Qb = out9, *ZFb = out9 + ARR, *Ib = out9 + 3 * ARR, *SGAb = out9 + 4 * ARR, *GVb = out9 + 5 * ARR;
    bf16_t* g3 = (bf16_t*)(ws + WS_G3); bf16_t* UGf = g3, *SMAf = g3 + 2 * ARR, *SMBf = g3 + 4 * ARR;
    bf16_t* OFb = (bf16_t*)(ws + WS_OF); bf16_t* Xb = (bf16_t*)(ws + WS_X); float* ACb = (float*)(ws + WS_AC); f32x2* STb = (f32x2*)(ws + WS_ST);
    volatile LAS unsigned* bst = (volatile LAS unsigned*)(lds + LDS_BYTES - 16);
    if (threadIdx.x < 4) bst[threadIdx.x] = 0u;
    if (blk == 0) for (int i = threadIdx.x; i < XCD_BAR_WORDS; i += 512) ((unsigned*)ws)[i] = 0u;
    __syncthreads();
    XcdBarrier xb; xb.bar = (unsigned*)ws; xb.x = 0; xb.st = bst;
    for (int ph = a.ph_lo; ph < a.ph_hi; ++ph) {
        if (ph == a.ph_lo + 1) { grid.sync(); xb = xcd_barrier_post((unsigned*)ws, bst); }
        else if (ph > a.ph_lo + 1) xcd_barrier(xb);
        if (ph == NPH - 1) { phase_final(a.out, a.in[12], M_ALL, G); continue; }
        const int l = ph / PPL, rr = ph % PPL;
        const float* xin = (l == 0) ? x0 : a.out;
        if (rr == 0) {
            phase_prep(lds, a.in[2] + (size_t)l * D * NIN, a.in[9] + (size_t)l * D * D, a.in[10] + (size_t)l * D * D, a.in[11] + (size_t)l * D * D, ws, G);
            phase_rms_bf16(xin, a.in[1] + l * D, Hb, M_ALL, G);
            if (blk == 0) {
                float* LBT = (float*)(ws + WS_LBT);
                for (int i = threadIdx.x; i < 2048; i += 512) { const float* lp = a.in[3] + i;
                    const float v0 = lp[0], v1 = lp[2048], v2 = lp[4096], v3 = lp[6144], mx = fmaxf(fmaxf(v0, v1), fmaxf(v2, v3));
                    const float e0 = __expf(v0 - mx), e1 = __expf(v1 - mx), e2 = __expf(v2 - mx), e3 = __expf(v3 - mx);
                    float lb = 0.f; if (l >= 1) lb += e1; if (l >= 2) lb += e2; if (l >= 3) lb += e3;
                    lb = lb / (e0 + e1 + e2 + e3);
                    LBT[(i >> 10) * 2048 + (i & 1023)] = fmaxf(lb, 1e-20f); LBT[(i >> 10) * 2048 + 1024 + (i & 1023)] = 1.0f - lb; }
            }
            continue;
        }
        const int hf = (rr <= 8) ? (rr - 1) / 4 : 0, k = (rr <= 8) ? (rr - 1) % 4 : rr - 5;
        bf16_t* Hh = Hb + (size_t)hf * ARR;
        bf16_t* UGb = UGf + (size_t)hf * ARR;
        if (k == 0) {
            pg8::Gemm g{Hh, Hh, (const bf16_t*)(ws + WS_WIN), (const bf16_t*)(ws + WS_WIN), D};
            pg8::Order S; S.init(MH, NIN, G, blk, 0, 1);
            EpiInProj E{out9, g3 + (size_t)hf * ARR};
            pg8::gemm_phase<EpiInProj>(lds, g, S, E);
        } else if (k == 1) {
            phase_lnstats(GVb, STb, G);
            phase_s1(lds, Qb, ZFb, Ib, OFb, Xb, ACb, (const float*)(ws + WS_LBT), G);
        } else if (k == 2) {
            phase_s2(Xb, ACb, G);
        } else if (k == 3) {
            if (blk & 1) phase_s3(lds, ZFb, OFb, Xb, SGAb, a.in[4] + l * 128, Hh, G);
            __syncthreads();
            phase_spatial(lds, GVb, UGb, STb, a.in[5] + l * D, a.in[6] + l * D, a.in[7] + (size_t)l * 8 * 128 * 128, a.in[8] + l * 8 * 128, G);
            __syncthreads();
            if (!(blk & 1)) phase_s3(lds, ZFb, OFb, Xb, SGAb, a.in[4] + l * 128, Hh, G);
        } else if (k == 4) {
            pg8::Gemm g{UGf, Hb, (const bf16_t*)(ws + WS_WB), (const bf16_t*)(ws + WS_WA), D};
            pg8::Order S; S.init(M_ALL, D, G, blk, 1);
            EpiProjAB E{SMAf, SMBf, out9};
            pg8::gemm_phase<EpiProjAB>(lds, g, S, E);
        } else {
            pg8::Gemm g{out9, out9, (const bf16_t*)(ws + WS_WO), (const bf16_t*)(ws + WS_WO), D};
            pg8::Order S; S.init(M_ALL, D, G, blk, 0);
            EpiResid E{xin, a.out};
            pg8::gemm_phase<EpiResid>(lds, g, S, E);
        }
    }
}


extern "C" void kernel_launch(void* const* d_in, const int* in_sizes, int n_in, void* d_out, int out_size, void* d_ws, size_t ws_size, hipStream_t stream) {
    static int grid = 0;
    if (grid == 0) {
        if (n_in != 13 || ws_size < WS_END) { fprintf(stderr, "kernel_launch: unexpected inputs (n_in %d, ws %zu, need %zu)\n", n_in, ws_size, (size_t)WS_END); grid = -1; return; }
        int dev = 0, cus = 0, per_cu = 0;
        hipGetDevice(&dev); hipDeviceGetAttribute(&cus, hipDeviceAttributeMultiprocessorCount, dev);
        if (hipFuncSetAttribute((const void*)mega, hipFuncAttributeMaxDynamicSharedMemorySize, LDS_BYTES) != hipSuccess) { fprintf(stderr, "kernel_launch: hipFuncSetAttribute failed\n"); grid = -1; return; }
        if (hipOccupancyMaxActiveBlocksPerMultiprocessor(&per_cu, (const void*)mega, 512, LDS_BYTES) != hipSuccess || per_cu < 1) { fprintf(stderr, "kernel_launch: occupancy query gave %d\n", per_cu); per_cu = 1; }
        (void)hipGetLastError();
        grid = cus * 1;
        fprintf(stderr, "kernel_launch: cus %d per_cu %d grid %d\n", cus, per_cu, grid);
    }
    if (grid < 0) return;
    Args a{};
    for (int i = 0; i < 13; ++i) a.in[i] = (const float*)d_in[i];
    a.out = (float*)d_out; a.ws = (unsigned char*)d_ws; a.ph_lo = 0; a.ph_hi = NPH;
    void* args[] = {&a};
    hipError_t e = hipLaunchCooperativeKernel((const void*)mega, dim3(grid), dim3(512), args, LDS_BYTES, stream);
    if (e != hipSuccess) fprintf(stderr, "kernel_launch: cooperative launch failed: %s (grid %d)\n", hipGetErrorString(e), grid);
}
```

```cpp
#include <hip/hip_runtime.h>
#include <hip/hip_cooperative_groups.h>
#include <cstdio>
namespace cg = cooperative_groups;

#define LAS __attribute__((address_space(3)))
#define DI __device__ __forceinline__
typedef unsigned short bf16_t;
typedef short bf16x8 __attribute__((ext_vector_type(8)));
typedef float f32x4 __attribute__((ext_vector_type(4)));
typedef float f32x2 __attribute__((ext_vector_type(2)));
typedef float f32x16 __attribute__((ext_vector_type(16)));
typedef unsigned u32x4 __attribute__((ext_vector_type(4)));
typedef unsigned u32x2 __attribute__((ext_vector_type(2)));
typedef __bf16 bf16v2 __attribute__((ext_vector_type(2)));

constexpr int D = 1024, SEQ = 4096, MH = 16384, M_ALL = 32768, DEPTH = 4, NIN = 10240;
constexpr int LDS_BYTES = 163840;
constexpr float LOG2E = 1.4426950408889634f;
constexpr size_t ARR = (size_t)MH * D;

constexpr size_t WS_WIN = 1ull << 20;
constexpr size_t WS_WA = WS_WIN + (size_t)NIN * D * 2;
constexpr size_t WS_WB = WS_WA + (size_t)D * D * 2;
constexpr size_t WS_WO = WS_WB + (size_t)D * D * 2;
constexpr size_t WS_H = WS_WO + (size_t)D * D * 2;
constexpr size_t WS_OUT9 = WS_H + (size_t)M_ALL * D * 2;
constexpr size_t WS_G3 = WS_OUT9 + 6 * ARR * 2;
constexpr size_t WS_OF = WS_G3 + 6 * ARR * 2;
constexpr size_t WS_X = WS_OF + 2 * ARR * 2;
constexpr size_t WS_AC = WS_X + (size_t)64 * 32 * 16384 * 2;
constexpr size_t WS_ST = WS_AC + (size_t)64 * 32 * 128 * 4;
constexpr size_t WS_LBT = WS_ST + (size_t)MH * 8;
constexpr size_t WS_END = WS_LBT + 4096 * 4;

DI unsigned pk2(float lo, float hi) { f32x2 v = {lo, hi}; bf16v2 r = __builtin_convertvector(v, bf16v2); return __builtin_bit_cast(unsigned, r); }
DI float bflo(unsigned w) { return __uint_as_float(w << 16); }
DI float bfhi(unsigned w) { return __uint_as_float(w & 0xffff0000u); }
DI float fexp2(float x) { return __builtin_amdgcn_exp2f(x); }
DI float frcp(float x) { return __builtin_amdgcn_rcpf(x); }
DI float sigmoidf_(float x) { return frcp(1.0f + fexp2(-x * LOG2E)); }
DI float siluf_(float x) { return x * sigmoidf_(x); }
DI float geluf_(float x) { const float t = x + 0.044715f * x * x * x; return x * frcp(1.0f + fexp2(-2.3022082f * t)); }
DI float wave_sum(float v) {
#pragma unroll
    for (int o = 1; o < 64; o <<= 1) v += __shfl_xor(v, o);
    return v;
}
#define LDS_WAIT() asm volatile("s_waitcnt lgkmcnt(0)" ::: "memory")
template <int CTRL, int ROWMASK, bool BC> DI float dpp_f(float x) { return __int_as_float(__builtin_amdgcn_update_dpp(0, __float_as_int(x), CTRL, ROWMASK, 0xf, BC)); }
DI int opaque_tid() { int t = threadIdx.x; asm volatile("" : "+v"(t)); return t; }


#define XB_TMO      128
#define XB_XCNT(j)  (256  + 64 * (j))
#define XB_XSUB(j)  (1280 + 64 * (j))
#define XB_XGEN(j)  (2304 + 64 * (j))
#define XB_TOP      3328
#define XB_TOPGEN   3392
#define XCD_BAR_WORDS 3456
#define XB_SPIN_CAP (1u << 22)
DI unsigned xb_ld(unsigned* p)              { return __hip_atomic_load(p, __ATOMIC_RELAXED, __HIP_MEMORY_SCOPE_AGENT); }
DI unsigned xb_add(unsigned* p, unsigned v) { return __hip_atomic_fetch_add(p, v, __ATOMIC_RELAXED, __HIP_MEMORY_SCOPE_AGENT); }
DI unsigned xb_xcc_id() { return (unsigned)__builtin_amdgcn_s_getreg((3 << 11) | 20) & 0xFu; }
#define XB_SPIN(cond, bar) do { unsigned _sp = 0; while (cond) { __builtin_amdgcn_s_sleep(1); \
    if ((++_sp & 255u) == 0u) { if (xb_ld(&(bar)[XB_TMO])) break; if (_sp > XB_SPIN_CAP) { atomicAdd(&(bar)[XB_TMO], 1u); break; } } } } while (0)
struct XcdBarrier { unsigned* bar; unsigned x; volatile LAS unsigned* st; };
DI XcdBarrier xcd_barrier_post(unsigned* bar, volatile LAS unsigned* st) {
    XcdBarrier b; b.bar = bar; b.x = xb_xcc_id(); b.st = st;
    if (threadIdx.x == 0) (void)xb_add(&bar[XB_XCNT(b.x)], 1u);
    return b;
}
DI void xcd_barrier_complete(unsigned* bar, unsigned x, unsigned& nloc, unsigned& nx) {
    const unsigned G = gridDim.x * gridDim.y * gridDim.z;
    unsigned sum, cnt, mine, sp = 0u;
    for (;;) {
        sum = 0u; cnt = 0u; mine = 0u;
#pragma unroll
        for (unsigned j = 0; j < 16; ++j) { const unsigned c = xb_ld(&bar[XB_XCNT(j)]); sum += c; cnt += (c > 0u) ? 1u : 0u; mine = (j == x) ? c : mine; }
        if (sum == G) break;
        __builtin_amdgcn_s_sleep(1);
        if ((++sp & 255u) == 0u) { if (xb_ld(&bar[XB_TMO])) break; if (sp > XB_SPIN_CAP) { atomicAdd(&bar[XB_TMO], 1u); break; } }
    }
    nloc = mine > 0u ? mine : 1u; nx = cnt > 0u ? cnt : 1u;
}
DI void xcd_barrier(const XcdBarrier& b) {
    asm volatile("s_waitcnt vmcnt(0)" ::: "memory");
    __syncthreads();
    if (threadIdx.x == 0) {
        unsigned* bar = b.bar;
        __builtin_amdgcn_s_waitcnt(0);
        unsigned nloc = b.st[0], nx = b.st[1];
        if (nloc == 0u) { xcd_barrier_complete(bar, b.x, nloc, nx); b.st[0] = nloc; b.st[1] = nx; }
        const unsigned old = xb_add(&bar[XB_XSUB(b.x)], 1u);
        const unsigned gen = old / nloc;
        if (old + 1u == (gen + 1u) * nloc) {
            __builtin_amdgcn_fence(__ATOMIC_RELEASE, "agent");
            asm volatile("s_waitcnt vmcnt(0)" ::: "memory");
            const unsigned og = xb_add(&bar[XB_TOP], 1u);
            const unsigned tg = og / nx;
            if (og + 1u == (tg + 1u) * nx) xb_add(&bar[XB_TOPGEN], 1u);
            else XB_SPIN(xb_ld(&bar[XB_TOPGEN]) == tg, bar);
            __builtin_amdgcn_fence(__ATOMIC_ACQUIRE, "agent");
            xb_add(&bar[XB_XGEN(b.x)], 1u);
            asm volatile("s_waitcnt vmcnt(0)" ::: "memory");
        } else {
            XB_SPIN(xb_ld(&bar[XB_XGEN(b.x)]) == gen, bar);
            __builtin_amdgcn_fence(__ATOMIC_ACQUIRE, "agent");
            asm volatile("s_waitcnt vmcnt(0)" ::: "memory");
        }
    }
    __syncthreads();
}

namespace pg8 {
constexpr int BM = 256, BK = 64, HALF = 128, HTB = HALF * BK * 2, STAGE_BYTES = 8 * HTB, NXCD = 8, WGM = 8;
DI int lds_byte(int r, int c) { const int st = (r >> 4) * 2 + (c >> 5), rr = r & 15, cc = c & 31, ob = rr * 64 + cc * 2; return st * 1024 + (ob ^ (((ob >> 9) & 1) << 5)); }
DI void stage_rc(int b, int& R, int& C) { const int st = b / 1024, sb = b % 1024, swz = sb ^ (((sb >> 9) & 1) << 5); R = (st >> 1) * 16 + swz / 64; C = (st & 1) * 32 + (swz % 64) / 2; }
DI int perm32(int rho) { const int n = rho >> 4, i = rho & 15; return 8 * (i >> 2) + 4 * n + (i & 3); }

struct Unit { int pm, pn, sel; };
struct Gemm { const bf16_t* A0; const bf16_t* A1; const bf16_t* B0; const bf16_t* B1; int K; };
struct Order {
    int nM, nN, nwg, G, c, dual, rev;
    DI void init(int M, int N, int G_, int c_, int dual_, int rev_ = 0) { nM = M / BM; nN = N / BM; nwg = nM * nN; G = G_; c = c_; dual = dual_; rev = rev_; }
    DI bool next(int i, Unit& u) const {
        const int ti = dual ? (i >> 1) : i; u.sel = dual ? (i & 1) : 0;
        const long L = (long)ti * G + c; if (L >= nwg) return false;
        int wgid = (int)L; { const int q = nwg / NXCD, r = nwg % NXCD, xcd = wgid % NXCD, off = wgid / NXCD; wgid = (xcd < r ? xcd * (q + 1) : r * (q + 1) + (xcd - r) * q) + off; }
        const int nig = WGM * nN, gid = wgid / nig, fm = gid * WGM, gsz = (nM - fm) < WGM ? (nM - fm) : WGM;
        u.pm = fm + ((wgid % nig) % gsz); u.pn = (wgid % nig) / gsz; if (rev) u.pn = nN - 1 - u.pn; return true;
    }
};

template <class Epi>
DI void gemm_phase(LAS unsigned char* lds, const Gemm g, const Order& S, const Epi& E) {
    const int tid = opaque_tid(), wid = __builtin_amdgcn_readfirstlane(tid >> 6), lane = tid & 63, wr = wid >> 2, wc = wid & 3, fr = lane & 15, fq = lane >> 4;
    const int K = g.K, nt = K / BK;
    unsigned voffA[2], voffB[2];
#pragma unroll
    for (int i = 0; i < 2; ++i) { int R, C; stage_rc(tid * 16 + i * 8192, R, C); const int Rb = Epi::PERM ? ((R & ~31) + perm32(R & 31)) : R;
        voffA[i] = (unsigned)(R * K + C) * 2u; voffB[i] = (unsigned)(Rb * K + C) * 2u; }
    const size_t kstep = (size_t)(BK * 2);
    const size_t hstep = (size_t)HALF * K * 2;
    const size_t tstep = 2 * hstep;
    const unsigned ldsw = (unsigned)wid * 1024u;
    const int aoff = lds_byte(wr * 64 + fr, fq * 8), boff = lds_byte(wc * 32 + fr, fq * 8);
#define PG8_SA(b, h) (((b) * 2 + (h)) * HTB)
#define PG8_SB(b, h) ((4 + (b) * 2 + (h)) * HTB)
#define PG8_STAGE(bufoff, gbase, voff) do { _Pragma("unroll") for (int _i = 0; _i < 2; ++_i) \
        __builtin_amdgcn_global_load_lds((const unsigned*)((const char*)(gbase) + (voff)[_i]), (LAS unsigned*)(lds + (bufoff) + ldsw + _i * 8192), 16, 0, 0); } while (0)
#define PG8_LDA(dst, b, h) do { _Pragma("unroll") for (int m = 0; m < 4; ++m) _Pragma("unroll") for (int k = 0; k < 2; ++k) dst[m][k] = *(const LAS bf16x8*)(lds + PG8_SA(b, h) + aoff + m * 2048 + k * 1024); } while (0)
#define PG8_LDB(dst, b, h) do { _Pragma("unroll") for (int n = 0; n < 2; ++n) _Pragma("unroll") for (int k = 0; k < 2; ++k) dst[n][k] = *(const LAS bf16x8*)(lds + PG8_SB(b, h) + boff + n * 2048 + k * 1024); } while (0)
#define PG8_MMA(ai, bj, At, Bt) do { __builtin_amdgcn_s_setprio(1); _Pragma("unroll") for (int m = 0; m < 4; ++m) _Pragma("unroll") for (int n = 0; n < 2; ++n) _Pragma("unroll") for (int k = 0; k < 2; ++k) \
        acc[ai][bj][m][n] = __builtin_amdgcn_mfma_f32_16x16x32_bf16(Bt[n][k], At[m][k], acc[ai][bj][m][n], 0, 0, 0); __builtin_amdgcn_s_setprio(0); } while (0)
#define PG8_WAIT_V(n) asm volatile("s_waitcnt vmcnt(" #n ")" ::: "memory")
#define PG8_WAIT_L(n) asm volatile("s_waitcnt lgkmcnt(" #n ")" ::: "memory")
#define PG8_BAR __builtin_amdgcn_s_barrier()
#define PG8_SCHED __builtin_amdgcn_sched_barrier(0)
    Unit cur, nxt; int ui = 0;
    if (!S.next(0, cur)) return;
    f32x4 acc[2][2][4][2];
#pragma unroll
    for (int a = 0; a < 2; ++a)
#pragma unroll
        for (int b = 0; b < 2; ++b)
#pragma unroll
            for (int m = 0; m < 4; ++m)
#pragma unroll
                for (int n = 0; n < 2; ++n) acc[a][b][m][n] = (f32x4){0.f, 0.f, 0.f, 0.f};
    bf16x8 At[4][2], B0[2][2], B1[2][2];
    const char* cA = (const char*)(cur.sel ? g.A1 : g.A0) + (size_t)cur.pm * tstep; const char* cB = (const char*)(cur.sel ? g.B1 : g.B0) + (size_t)cur.pn * tstep;
    PG8_STAGE(PG8_SB(0, 0), cB, voffB); PG8_STAGE(PG8_SB(0, 1), cB + hstep, voffB); PG8_STAGE(PG8_SA(0, 0), cA, voffA); PG8_STAGE(PG8_SA(0, 1), cA + hstep, voffA);
    if (wr == 1) PG8_BAR;
    PG8_WAIT_V(2); PG8_BAR;
    PG8_STAGE(PG8_SB(1, 0), cB + kstep, voffB); PG8_STAGE(PG8_SA(1, 0), cA + kstep, voffA); PG8_STAGE(PG8_SB(1, 1), cB + hstep + kstep, voffB);
    PG8_WAIT_V(6); PG8_BAR;
    for (;;) {
        const bool has_next = S.next(ui + 1, nxt);
        const char* nA = has_next ? (const char*)(nxt.sel ? g.A1 : g.A0) + (size_t)nxt.pm * tstep : cA; const char* nB = has_next ? (const char*)(nxt.sel ? g.B1 : g.B0) + (size_t)nxt.pn * tstep : cB;
        for (int t = 0; t < nt; t += 2) {
            const bool last = (t == nt - 2);
            const char* a1 = cA + (size_t)(t + 1) * kstep;
            const char* a2 = last ? nA : cA + (size_t)(t + 2) * kstep; const char* b2 = last ? nB : cB + (size_t)(t + 2) * kstep;
            const char* a3 = a2 + kstep; const char* b3 = b2 + kstep;
            PG8_LDB(B0, 0, 0); PG8_LDB(B1, 0, 1); PG8_SCHED; PG8_LDA(At, 0, 0); PG8_STAGE(PG8_SA(1, 1), a1 + hstep, voffA);
            PG8_WAIT_V(8); PG8_WAIT_L(0); PG8_BAR; PG8_MMA(0, 0, At, B0); PG8_MMA(0, 1, At, B1); PG8_BAR; PG8_SCHED;
            PG8_LDA(At, 0, 1); PG8_STAGE(PG8_SB(0, 0), b2, voffB); PG8_STAGE(PG8_SB(0, 1), b2 + hstep, voffB); PG8_STAGE(PG8_SA(0, 0), a2, voffA);
            PG8_WAIT_V(8); PG8_WAIT_L(0); PG8_BAR; PG8_MMA(1, 0, At, B0); PG8_MMA(1, 1, At, B1); PG8_BAR; PG8_SCHED;
            PG8_LDB(B0, 1, 0); PG8_LDB(B1, 1, 1); PG8_SCHED; PG8_LDA(At, 1, 0); PG8_STAGE(PG8_SA(0, 1), a2 + hstep, voffA);
            PG8_WAIT_V(8); PG8_WAIT_L(0); PG8_BAR; PG8_MMA(0, 0, At, B0); PG8_MMA(0, 1, At, B1); PG8_BAR; PG8_SCHED;
            PG8_LDA(At, 1, 1); PG8_STAGE(PG8_SB(1, 0), b3, voffB); PG8_STAGE(PG8_SB(1, 1), b3 + hstep, voffB); PG8_STAGE(PG8_SA(1, 0), a3, voffA);
            PG8_WAIT_V(8); PG8_WAIT_L(0); PG8_BAR; PG8_MMA(1, 0, At, B0); PG8_MMA(1, 1, At, B1); PG8_BAR; PG8_SCHED;
        }
        if (wr == 0) PG8_BAR;
        bool keep = false;
        if constexpr (Epi::KEEP) { if (cur.sel == 0) { E.mid(acc, cur, wr, wc, fr, fq); keep = true; } else E(acc, cur, wr, wc, fr, fq); }
        else E(acc, cur, wr, wc, fr, fq);
        if (!has_next) break;
        if (!keep)
#pragma unroll
        for (int a = 0; a < 2; ++a)
#pragma unroll
            for (int b = 0; b < 2; ++b)
#pragma unroll
                for (int m = 0; m < 4; ++m)
#pragma unroll
                    for (int n = 0; n < 2; ++n) acc[a][b][m][n] = (f32x4){0.f, 0.f, 0.f, 0.f};
        cur = nxt; cA = nA; cB = nB; ++ui;
        if (wr == 1) PG8_BAR;
    }
    PG8_WAIT_V(0);
    PG8_BAR;
#undef PG8_SA
#undef PG8_SB
#undef PG8_STAGE
#undef PG8_LDA
#undef PG8_LDB
#undef PG8_MMA
#undef PG8_WAIT_V
#undef PG8_WAIT_L
#undef PG8_BAR
#undef PG8_SCHED
}
}

DI f32x2 exp2_2(f32x2 v) { return (f32x2){fexp2(v.x), fexp2(v.y)}; }
DI f32x2 rcp_2(f32x2 v) { return (f32x2){frcp(v.x), frcp(v.y)}; }
DI f32x2 sigmoid2(f32x2 x) { return rcp_2(exp2_2(x * (-LOG2E)) + 1.0f); }
DI f32x2 silu2(f32x2 x) { return x * sigmoid2(x); }
DI f32x2 gelu2(f32x2 x) { const f32x2 t = x + (x * x) * x * 0.044715f; return x * rcp_2(exp2_2(t * (-2.3022082f)) + 1.0f); }
template <int ACT> DI unsigned act_pk(f32x2 x) {
    f32x2 y;
    if (ACT == 0) y = x; else if (ACT == 1) y = silu2(x) * 0.08838834764831845f; else if (ACT == 2) y = silu2(x); else if (ACT == 3) y = gelu2(x); else y = sigmoid2(x);
    return pk2(y.x, y.y);
}
template <int ACT> DI float act_fn(float x) {
    if (ACT == 0) return x;
    if (ACT == 1) return siluf_(x) * 0.08838834764831845f;
    if (ACT == 2) return siluf_(x);
    if (ACT == 3) return geluf_(x);
    return sigmoidf_(x);
}
template <int ACT> DI void store_act(const f32x4 (&acc)[2][2][4][2], bf16_t* base, int row0, int col0) {
#pragma unroll
    for (int ai = 0; ai < 2; ++ai)
#pragma unroll
        for (int m = 0; m < 4; ++m) { bf16_t* rowp = base + (size_t)(row0 + ai * 128 + m * 16) * D + col0;
#pragma unroll
            for (int bj = 0; bj < 2; ++bj) { const f32x4 v0 = acc[ai][bj][m][0], v1 = acc[ai][bj][m][1];
                u32x4 w; w.x = act_pk<ACT>((f32x2){v0[0], v0[1]}); w.y = act_pk<ACT>((f32x2){v0[2], v0[3]});
                w.z = act_pk<ACT>((f32x2){v1[0], v1[1]}); w.w = act_pk<ACT>((f32x2){v1[2], v1[3]});
                *(u32x4*)(rowp + bj * 128) = w; } }
}
struct EpiInProj {
    static constexpr bool PERM = true, KEEP = false;
    bf16_t* out9; bf16_t* g3;
    DI void operator()(const f32x4 (&acc)[2][2][4][2], const pg8::Unit& u, int wr, int wc, int fr, int fq) const {
        const int pn = u.pn, row0 = u.pm * 256 + wr * 64 + fr, cl = wc * 32 + 8 * fq;
        if (pn >= 20 && pn < 28) {
            bf16_t* base = g3; const int col0 = 128 * (pn - 20) + cl;
#pragma unroll
            for (int ai = 0; ai < 2; ++ai)
#pragma unroll
                for (int m = 0; m < 4; ++m) { bf16_t* rowp = base + (size_t)(row0 + ai * 128 + m * 16) * D + col0;
                    const f32x4 u0 = acc[ai][0][m][0], u1 = acc[ai][0][m][1], g0 = acc[ai][1][m][0], g1 = acc[ai][1][m][1];
                    u32x4 w;
                    { const f32x2 y = gelu2((f32x2){u0[0], u0[1]}) * silu2((f32x2){g0[0], g0[1]}); w.x = pk2(y.x, y.y); }
                    { const f32x2 y = gelu2((f32x2){u0[2], u0[3]}) * silu2((f32x2){g0[2], g0[3]}); w.y = pk2(y.x, y.y); }
                    { const f32x2 y = gelu2((f32x2){u1[0], u1[1]}) * silu2((f32x2){g1[0], g1[1]}); w.z = pk2(y.x, y.y); }
                    { const f32x2 y = gelu2((f32x2){u1[2], u1[3]}) * silu2((f32x2){g1[2], g1[3]}); w.w = pk2(y.x, y.y); }
                    *(u32x4*)rowp = w; }
            return;
        }
        if (pn >= 32) {
            bf16_t* sa = g3 + 2 * ARR; bf16_t* rh = g3 + 4 * ARR; const int col0 = 128 * (pn - 32) + cl;
#pragma unroll
            for (int ai = 0; ai < 2; ++ai)
#pragma unroll
                for (int m = 0; m < 4; ++m) { const size_t off = (size_t)(row0 + ai * 128 + m * 16) * D + col0;
                    const f32x4 a0 = acc[ai][0][m][0], a1 = acc[ai][0][m][1], b0 = acc[ai][1][m][0], b1 = acc[ai][1][m][1];
                    const float av[8] = {a0[0], a0[1], a0[2], a0[3], a1[0], a1[1], a1[2], a1[3]}, bv[8] = {b0[0], b0[1], b0[2], b0[3], b1[0], b1[1], b1[2], b1[3]};
                    float sg[8], ro[8];
#pragma unroll
                    for (int j = 0; j < 8; j += 2) { const f32x2 da = exp2_2((f32x2){av[j], av[j + 1]} * (-LOG2E)) + 1.0f, db = exp2_2((f32x2){bv[j], bv[j + 1]} * (-LOG2E)) + 1.0f;
                        const f32x2 s2 = rcp_2(da), r2 = da * rcp_2(db);
                        sg[j] = s2.x; sg[j + 1] = s2.y; ro[j] = fminf(r2.x, 3.0e38f); ro[j + 1] = fminf(r2.y, 3.0e38f); }
                    *(u32x4*)(sa + off) = (u32x4){pk2(sg[0], sg[1]), pk2(sg[2], sg[3]), pk2(sg[4], sg[5]), pk2(sg[6], sg[7])};
                    *(u32x4*)(rh + off) = (u32x4){pk2(ro[0], ro[1]), pk2(ro[2], ro[3]), pk2(ro[4], ro[5]), pk2(ro[6], ro[7])}; }
            return;
        }
        int idx, ct;
        if (pn < 20) { idx = pn >> 2; ct = pn & 3; } else { idx = 6; ct = pn - 28; }
        bf16_t* base = (idx <= 4) ? out9 + (size_t)idx * ARR : out9 + 5 * ARR; const int col0 = 256 * ct + cl;
        if (idx == 0) store_act<1>(acc, base, row0, col0);
        else if (idx <= 3) store_act<0>(acc, base, row0, col0);
        else if (idx == 4) store_act<0>(acc, base, row0, col0);
        else store_act<3>(acc, base, row0, col0);
    }
};
struct EpiProjAB {
    static constexpr bool PERM = true, KEEP = true;
    const bf16_t* SMA; const bf16_t* RHO; bf16_t* MG;
    DI void mid(f32x4 (&acc)[2][2][4][2], const pg8::Unit& u, int wr, int wc, int fr, int fq) const {
        const int row0 = u.pm * 256 + wr * 64 + fr, col0 = u.pn * 256 + wc * 32 + 8 * fq;
#pragma unroll
        for (int ai = 0; ai < 2; ++ai)
#pragma unroll
            for (int m = 0; m < 4; ++m) { const size_t off = (size_t)(row0 + ai * 128 + m * 16) * D + col0;
#pragma unroll
                for (int bj = 0; bj < 2; ++bj) { const u32x4 gw = *(const u32x4*)(RHO + off + bj * 128);
                    acc[ai][bj][m][0] = acc[ai][bj][m][0] * (f32x4){bflo(gw.x), bfhi(gw.x), bflo(gw.y), bfhi(gw.y)};
                    acc[ai][bj][m][1] = acc[ai][bj][m][1] * (f32x4){bflo(gw.z), bfhi(gw.z), bflo(gw.w), bfhi(gw.w)}; }
                asm volatile("" ::: "memory"); }
    }
    DI void operator()(const f32x4 (&acc)[2][2][4][2], const pg8::Unit& u, int wr, int wc, int fr, int fq) const {
        const int row0 = u.pm * 256 + wr * 64 + fr, col0 = u.pn * 256 + wc * 32 + 8 * fq;
#pragma unroll
        for (int ai = 0; ai < 2; ++ai)
#pragma unroll
            for (int m = 0; m < 4; ++m) { const size_t off = (size_t)(row0 + ai * 128 + m * 16) * D + col0;
#pragma unroll
                for (int bj = 0; bj < 2; ++bj) { const f32x4 v0 = acc[ai][bj][m][0], v1 = acc[ai][bj][m][1];
                    const u32x4 gw = *(const u32x4*)(SMA + off + bj * 128);
                    u32x4 w; w.x = pk2(v0[0] * bflo(gw.x), v0[1] * bfhi(gw.x)); w.y = pk2(v0[2] * bflo(gw.y), v0[3] * bfhi(gw.y)); w.z = pk2(v1[0] * bflo(gw.z), v1[1] * bfhi(gw.z)); w.w = pk2(v1[2] * bflo(gw.w), v1[3] * bfhi(gw.w));
                    *(u32x4*)(MG + off + bj * 128) = w; }
                asm volatile("" ::: "memory"); }
    }
};
struct EpiResid {
    static constexpr bool PERM = true, KEEP = false;
    const float* xin; float* out;
    DI void operator()(const f32x4 (&acc)[2][2][4][2], const pg8::Unit& u, int wr, int wc, int fr, int fq) const {
        const int row0 = u.pm * 256 + wr * 64 + fr, col0 = u.pn * 256 + wc * 32 + 8 * fq;
#pragma unroll
        for (int ai = 0; ai < 2; ++ai)
#pragma unroll
            for (int m = 0; m < 4; ++m) { const size_t off = (size_t)(row0 + ai * 128 + m * 16) * D + col0;
#pragma unroll
                for (int bj = 0; bj < 2; ++bj) {
                    const f32x4 o0 = *(const f32x4*)(xin + off + bj * 128) + acc[ai][bj][m][0], o1 = *(const f32x4*)(xin + off + bj * 128 + 4) + acc[ai][bj][m][1];
                    *(f32x4*)(out + off + bj * 128) = o0; *(f32x4*)(out + off + bj * 128 + 4) = o1; }
                asm volatile("" ::: "memory"); }
    }
};

DI int src_col(int nv) {
    if (nv < 5120) return nv;
    if (nv < 7168) { const int t = (nv - 5120) >> 8, w = (nv - 5120) & 255; return w < 128 ? 5120 + 128 * t + w : 7168 + 128 * t + (w - 128); }
    if (nv < 8192) return 6144 + (nv - 7168);
    { const int t = (nv - 8192) >> 8, w = (nv - 8192) & 255; return w < 128 ? 8192 + 128 * t + w : 9216 + 128 * t + (w - 128); }
}
DI void transpose_item(const float* W, int N, bf16_t* WT, int k0, int nsrc0, int nvirt0, LAS float* scr, int lane) {
#pragma unroll 8
    for (int i = 0; i < 32; ++i) { const int kk = 2 * i + (lane >> 5); scr[kk * 33 + (lane & 31)] = W[(size_t)(k0 + kk) * N + nsrc0 + (lane & 31)]; }
    LDS_WAIT();
    const int c = lane & 7;
#pragma unroll
    for (int j = 0; j < 4; ++j) { const int n = (lane >> 3) + 8 * j; const LAS float* s = scr + (8 * c) * 33 + n;
        u32x4 o; o.x = pk2(s[0 * 33], s[1 * 33]); o.y = pk2(s[2 * 33], s[3 * 33]); o.z = pk2(s[4 * 33], s[5 * 33]); o.w = pk2(s[6 * 33], s[7 * 33]);
        *(u32x4*)(WT + (size_t)(nvirt0 + n) * D + k0 + 8 * c) = o; }
    LDS_WAIT();
}
DI void phase_prep(LAS unsigned char* lds, const float* w_in, const float* wa, const float* wb, const float* wo, unsigned char* ws, int G) {
    const int tid_ = opaque_tid(); const int lane = tid_ & 63, wave = __builtin_amdgcn_readfirstlane(tid_ >> 6);
    LAS float* scr = (LAS float*)(lds + wave * 16384);
    const int gw = blockIdx.x * 8 + wave, NGW = G * 8;
    constexpr int I_IN = 16 * 320, I_P = 16 * 32, PER_L = I_IN + 3 * I_P;
    for (int it = gw; it < PER_L; it += NGW) {
        int r = it;
        if (r < I_IN) { const int kb = r / 320, nb = r % 320; transpose_item(w_in, NIN, (bf16_t*)(ws + WS_WIN), 64 * kb, src_col(32 * nb), 32 * nb, scr, lane); continue; }
        r -= I_IN; const int which = r / I_P; r %= I_P; const int kb = r / 32, nb = r % 32;
        const float* W = (which == 0 ? wa : which == 1 ? wb : wo);
        bf16_t* WT = (bf16_t*)(ws + (which == 0 ? WS_WA : which == 1 ? WS_WB : WS_WO));
        transpose_item(W, D, WT, 64 * kb, 32 * nb, 32 * nb, scr, lane);
    }
}
DI void phase_rms_bf16(const float* x, const float* w, bf16_t* h, int nrows, int G) {
    const int tid_ = opaque_tid(); const int lane = tid_ & 63, wave = __builtin_amdgcn_readfirstlane(tid_ >> 6);
    const int gw = blockIdx.x * 8 + wave, NGW = G * 8;
    f32x4 wv[4];
#pragma unroll
    for (int j = 0; j < 4; ++j) wv[j] = ((const f32x4*)w)[lane + 64 * j];
    for (int m = gw; m < nrows; m += NGW) {
        const f32x4* xr = (const f32x4*)(x + (size_t)m * D) + lane; f32x4 v[4]; float s = 0.f;
#pragma unroll
        for (int j = 0; j < 4; ++j) { v[j] = xr[64 * j]; s += (v[j].x * v[j].x + v[j].y * v[j].y) + (v[j].z * v[j].z + v[j].w * v[j].w); }
        const float rstd = rsqrtf(wave_sum(s) * (1.0f / D) + 1e-6f);
        u32x2* o8 = (u32x2*)(h + (size_t)m * D) + lane;
#pragma unroll
        for (int j = 0; j < 4; ++j) { u32x2 o; o.x = pk2(v[j].x * rstd * wv[j].x, v[j].y * rstd * wv[j].y); o.y = pk2(v[j].z * rstd * wv[j].z, v[j].w * rstd * wv[j].w); o8[64 * j] = o; }
    }
}
DI void phase_final(float* x, const float* w, int nrows, int G) {
    const int tid_ = opaque_tid(); const int lane = tid_ & 63, wave = __builtin_amdgcn_readfirstlane(tid_ >> 6);
    const int gw = blockIdx.x * 8 + wave, NGW = G * 8;
    f32x4 wv[4];
#pragma unroll
    for (int j = 0; j < 4; ++j) wv[j] = ((const f32x4*)w)[lane + 64 * j];
    for (int m = gw; m < nrows; m += NGW) {
        f32x4* xr = (f32x4*)(x + (size_t)m * D) + lane; f32x4 v[4]; float s = 0.f;
#pragma unroll
        for (int j = 0; j < 4; ++j) { v[j] = xr[64 * j]; s += (v[j].x * v[j].x + v[j].y * v[j].y) + (v[j].z * v[j].z + v[j].w * v[j].w); }
        const float rstd = rsqrtf(wave_sum(s) * (1.0f / D) + 1e-6f);
#pragma unroll
        for (int j = 0; j < 4; ++j) xr[64 * j] = v[j] * rstd * wv[j];
    }
}
#define MFMA32(a, b, c) __builtin_amdgcn_mfma_f32_32x32x16_bf16((a), (b), (c), 0, 0, 0)
struct S1Regs { u32x4 q0, q1, z0, z1, v0, v1; };
DI size_t s1_rowoff(int it, int sub, int j) {
    const int sc = it & 31, dir = (it >> 5) & 1, h = (it >> 6) & 7, b = it >> 9, p = 64 * sub + j;
    return ((size_t)b * SEQ + sc * 128 + (dir ? 127 - p : p)) * D + h * 128;
}
DI void s1_load(S1Regs& R, const bf16_t* Q, const bf16_t* Z, const bf16_t* Iv, int it, int sub, int tid) {
    const size_t off = s1_rowoff(it, sub, tid >> 3) + 16 * (tid & 7);
    const bf16_t* zp = Z + (size_t)((it >> 5) & 1) * ARR;
    R.q0 = *(const u32x4*)(Q + off); R.q1 = *(const u32x4*)(Q + off + 8);
    R.z0 = *(const u32x4*)(zp + off); R.z1 = *(const u32x4*)(zp + off + 8);
    R.v0 = *(const u32x4*)(Iv + off); R.v1 = *(const u32x4*)(Iv + off + 8);
}
DI void phase_s1(LAS unsigned char* lds, const bf16_t* Q, bf16_t* Z, const bf16_t* Iv, bf16_t* O, bf16_t* X, float* AC, const float* LBT, int G) {
    const int tid = opaque_tid(), lane = tid & 63, wave = __builtin_amdgcn_readfirstlane(tid >> 6);
    const int r = lane & 31, hh = lane >> 5, j8 = tid >> 3, cg8 = tid & 7;
    LAS bf16_t* TQ = (LAS bf16_t*)(lds);
    LAS bf16_t* TV = (LAS bf16_t*)(lds + 17408);
    LAS bf16_t* TZ = (LAS bf16_t*)(lds + 34816);
    LAS bf16_t* QS = (LAS bf16_t*)(lds + 52224);
    LAS bf16_t* KSA = (LAS bf16_t*)(lds + 69632);
    LAS bf16_t* KSB = (LAS bf16_t*)(lds + 87040);
    LAS bf16_t* KHT = (LAS bf16_t*)(lds + 104448);
    LAS bf16_t* VT = (LAS bf16_t*)(lds + 122880);
    LAS float* TA = (LAS float*)(lds + 157696);
    LAS float* AA = TA + 128;
    LAS float* AB = TA + 256;
    LAS float* TT = TA + 384;
    LAS float* TR = TA + 512;
    LAS float* EC1 = TA + 640;
    LAS float* ER = TA + 768;
    LAS float* EF = TA + 896;
    LAS bf16_t* PS = TV;
    S1Regs R;
    int it = blockIdx.x;
    if (it < 2048) s1_load(R, Q, Z, Iv, it, 0, tid);
    __syncthreads();
    for (; it < 2048; it += G) {
        const int sc = it & 31, dir = (it >> 5) & 1, h = (it >> 6) & 7, b = it >> 9, seq = (b * 8 + h) * 2 + dir;
        f32x16 DA[2];
        float lbv[16], omv[16];
        { const float* lp = LBT + dir * 2048 + h * 128 + 16 * wave;
#pragma unroll
          for (int i = 0; i < 16; ++i) { lbv[i] = lp[i]; omv[i] = lp[1024 + i]; } }
#pragma unroll
        for (int sub = 0; sub < 2; ++sub) {
            *(LAS u32x4*)(TQ + j8 * 136 + 16 * cg8) = R.q0; *(LAS u32x4*)(TQ + j8 * 136 + 16 * cg8 + 8) = R.q1;
            *(LAS u32x4*)(TZ + j8 * 136 + 16 * cg8) = R.z0; *(LAS u32x4*)(TZ + j8 * 136 + 16 * cg8 + 8) = R.z1;
            *(LAS u32x4*)(TV + j8 * 136 + 16 * cg8) = R.v0; *(LAS u32x4*)(TV + j8 * 136 + 16 * cg8 + 8) = R.v1;
            __syncthreads();
            {
                const u32x4 z0 = *(const LAS u32x4*)(TZ + lane * 136 + 16 * wave), z1 = *(const LAS u32x4*)(TZ + lane * 136 + 16 * wave + 8);
                const u32x4 q0 = *(const LAS u32x4*)(TQ + lane * 136 + 16 * wave), q1 = *(const LAS u32x4*)(TQ + lane * 136 + 16 * wave + 8);
                const u32x4 v0 = *(const LAS u32x4*)(TV + lane * 136 + 16 * wave), v1 = *(const LAS u32x4*)(TV + lane * 136 + 16 * wave + 8);
                const unsigned zw[8] = {z0.x, z0.y, z0.z, z0.w, z1.x, z1.y, z1.z, z1.w};
                const unsigned qw[8] = {q0.x, q0.y, q0.z, q0.w, q1.x, q1.y, q1.z, q1.w};
                const unsigned vw[8] = {v0.x, v0.y, v0.z, v0.w, v1.x, v1.y, v1.z, v1.w};
                float kk[16], gg[16];
                if (sub == 0) s1_load(R, Q, Z, Iv, it, 1, tid); else if (it + G < 2048) s1_load(R, Q, Z, Iv, it + G, 0, tid);
#pragma unroll
                for (int i = 0; i < 16; ++i) { const unsigned w = zw[i >> 1]; float z = (i & 1) ? bfhi(w) : bflo(w); z = __builtin_amdgcn_fmed3f(z, -30.f, 30.f);
                    const float e = fexp2(-z * LOG2E), sg = frcp(1.0f + e); const float om = omv[i];
                    kk[i] = om * e * sg; gg[i] = __builtin_amdgcn_logf(lbv[i] + om * sg); }
#define S1_DPP16(MOD) asm volatile("s_nop 1\n\t" \
                    "v_add_f32_dpp %0, %0, %0 " MOD "\n\tv_add_f32_dpp %1, %1, %1 " MOD "\n\tv_add_f32_dpp %2, %2, %2 " MOD "\n\tv_add_f32_dpp %3, %3, %3 " MOD "\n\t" \
                    "v_add_f32_dpp %4, %4, %4 " MOD "\n\tv_add_f32_dpp %5, %5, %5 " MOD "\n\tv_add_f32_dpp %6, %6, %6 " MOD "\n\tv_add_f32_dpp %7, %7, %7 " MOD "\n\t" \
                    "v_add_f32_dpp %8, %8, %8 " MOD "\n\tv_add_f32_dpp %9, %9, %9 " MOD "\n\tv_add_f32_dpp %10, %10, %10 " MOD "\n\tv_add_f32_dpp %11, %11, %11 " MOD "\n\t" \
                    "v_add_f32_dpp %12, %12, %12 " MOD "\n\tv_add_f32_dpp %13, %13, %13 " MOD "\n\tv_add_f32_dpp %14, %14, %14 " MOD "\n\tv_add_f32_dpp %15, %15, %15 " MOD "\n\ts_nop 1" \
                    : "+v"(gg[0]), "+v"(gg[1]), "+v"(gg[2]), "+v"(gg[3]), "+v"(gg[4]), "+v"(gg[5]), "+v"(gg[6]), "+v"(gg[7]), \
                      "+v"(gg[8]), "+v"(gg[9]), "+v"(gg[10]), "+v"(gg[11]), "+v"(gg[12]), "+v"(gg[13]), "+v"(gg[14]), "+v"(gg[15]))
                S1_DPP16("row_shr:1 row_mask:0xf bank_mask:0xf bound_ctrl:1");
                S1_DPP16("row_shr:2 row_mask:0xf bank_mask:0xf bound_ctrl:1");
                S1_DPP16("row_shr:4 row_mask:0xf bank_mask:0xf bound_ctrl:1");
                S1_DPP16("row_shr:8 row_mask:0xf bank_mask:0xf bound_ctrl:1");
                S1_DPP16("row_bcast:15 row_mask:0xa bank_mask:0xf");
                S1_DPP16("row_bcast:31 row_mask:0xc bank_mask:0xf");
#undef S1_DPP16
                float Rv[16], aa[16], fv[16], erv[16];
#pragma unroll
                for (int i = 0; i < 16; ++i) Rv[i] = __int_as_float(__builtin_amdgcn_readlane(__float_as_int(gg[i]), 31));
                if (lane == 63) {
#pragma unroll
                    for (int q4 = 0; q4 < 4; ++q4) { const f32x4 t4 = (f32x4){gg[4 * q4] - Rv[4 * q4], gg[4 * q4 + 1] - Rv[4 * q4 + 1], gg[4 * q4 + 2] - Rv[4 * q4 + 2], gg[4 * q4 + 3] - Rv[4 * q4 + 3]};
                        *(LAS f32x4*)(TT + 16 * wave + 4 * q4) = t4; if (sub == 0) *(LAS f32x4*)(TA + 16 * wave + 4 * q4) = t4;
                        *(LAS f32x4*)(TR + 16 * wave + 4 * q4) = (f32x4){Rv[4 * q4], Rv[4 * q4 + 1], Rv[4 * q4 + 2], Rv[4 * q4 + 3]}; }
                }
                asm volatile("" ::: "memory");
                {
                    const int ci = 16 * wave + (lane & 15);
                    const float x1 = TT[ci], x2 = TR[ci];
                    const float e1 = fexp2(x1), e2 = fexp2(x2), ea = e1 * e2;
                    EC1[ci] = e1; ER[ci] = e2;
                    if (sub == 0) AA[ci] = ea;
                    else { const float aav = AA[ci]; AB[ci] = ea; EF[ci] = fexp2(x2 + TA[ci]);
                        if (lane < 16) AC[((size_t)seq * 32 + sc) * 128 + ci] = ea * aav; }
                }
                asm volatile("" ::: "memory");
#pragma unroll
                for (int q4 = 0; q4 < 4; ++q4) { const f32x4 e4 = *(const LAS f32x4*)(ER + 16 * wave + 4 * q4);
                    erv[4 * q4] = e4.x; erv[4 * q4 + 1] = e4.y; erv[4 * q4 + 2] = e4.z; erv[4 * q4 + 3] = e4.w;
                    if (sub == 1) { const f32x4 a4 = *(const LAS f32x4*)(AA + 16 * wave + 4 * q4), f4 = *(const LAS f32x4*)(EF + 16 * wave + 4 * q4);
                        aa[4 * q4] = a4.x; aa[4 * q4 + 1] = a4.y; aa[4 * q4 + 2] = a4.z; aa[4 * q4 + 3] = a4.w; fv[4 * q4] = f4.x; fv[4 * q4 + 1] = f4.y; fv[4 * q4 + 2] = f4.z; fv[4 * q4 + 3] = f4.w; } }
                unsigned qo[8], ko[8], qh[8];
#pragma unroll
                for (int w = 0; w < 8; ++w) {
                    float qt_[2], kt_[2], qh_[2];
#pragma unroll
                    for (int e2 = 0; e2 < 2; ++e2) { const int i = 2 * w + e2; const float qf = e2 ? bfhi(qw[w]) : bflo(qw[w]);
                        const float dq = gg[i] - Rv[i];
                        qt_[e2] = qf * fexp2(fminf(dq, 100.f)); kt_[e2] = kk[i] * fexp2(fminf(-dq, 100.f));
                        qh_[e2] = (sub == 0) ? qt_[e2] * erv[i] : qt_[e2] * erv[i] * aa[i]; }
                    qo[w] = pk2(qt_[0], qt_[1]); ko[w] = pk2(kt_[0], kt_[1]); qh[w] = pk2(qh_[0], qh_[1]);
                }
                LAS bf16_t* KSx = (sub == 0) ? KSA : KSB;
                *(LAS u32x4*)(QS + lane * 136 + 16 * wave) = (u32x4){qo[0], qo[1], qo[2], qo[3]}; *(LAS u32x4*)(QS + lane * 136 + 16 * wave + 8) = (u32x4){qo[4], qo[5], qo[6], qo[7]};
                *(LAS u32x4*)(KSx + lane * 136 + 16 * wave) = (u32x4){ko[0], ko[1], ko[2], ko[3]}; *(LAS u32x4*)(KSx + lane * 136 + 16 * wave + 8) = (u32x4){ko[4], ko[5], ko[6], ko[7]};
                *(LAS u32x4*)(TZ + lane * 136 + 16 * wave) = (u32x4){qh[0], qh[1], qh[2], qh[3]}; *(LAS u32x4*)(TZ + lane * 136 + 16 * wave + 8) = (u32x4){qh[4], qh[5], qh[6], qh[7]};
#pragma unroll
                for (int w = 0; w < 8; ++w) {
                    KHT[(16 * wave + 2 * w) * 72 + lane] = (bf16_t)(ko[w] & 0xffffu); KHT[(16 * wave + 2 * w + 1) * 72 + lane] = (bf16_t)(ko[w] >> 16);
                    VT[(16 * wave + 2 * w) * 136 + 64 * sub + lane] = (bf16_t)(vw[w] & 0xffffu); VT[(16 * wave + 2 * w + 1) * 136 + 64 * sub + lane] = (bf16_t)(vw[w] >> 16);
                }
                if (sub == 1) {
                    const u32x4 k0 = *(const LAS u32x4*)(KSA + lane * 136 + 16 * wave), k1 = *(const LAS u32x4*)(KSA + lane * 136 + 16 * wave + 8);
                    const unsigned kw[8] = {k0.x, k0.y, k0.z, k0.w, k1.x, k1.y, k1.z, k1.w}; unsigned kn[8];
#pragma unroll
                    for (int w = 0; w < 8; ++w) kn[w] = pk2(bflo(kw[w]) * fv[2 * w], bfhi(kw[w]) * fv[2 * w + 1]);
                    *(LAS u32x4*)(KSA + lane * 136 + 16 * wave) = (u32x4){kn[0], kn[1], kn[2], kn[3]}; *(LAS u32x4*)(KSA + lane * 136 + 16 * wave + 8) = (u32x4){kn[4], kn[5], kn[6], kn[7]};
                }
            }
            __syncthreads();
            {
                LAS bf16_t* KSx = (sub == 0) ? KSA : KSB;
                if (wave < 3) {
                    const int tm = (wave == 2) ? 1 : 0, tn = (wave == 0) ? 0 : 1;
                    f32x16 acc;
#pragma unroll
                    for (int i = 0; i < 16; ++i) acc[i] = 0.f;
#pragma unroll
                    for (int ks = 0; ks < 8; ++ks) { const bf16x8 a = *(const LAS bf16x8*)(KSx + (32 * tm + r) * 136 + 16 * ks + 8 * hh), bb = *(const LAS bf16x8*)(QS + (32 * tn + r) * 136 + 16 * ks + 8 * hh); acc = MFMA32(a, bb, acc); }
                    const int t = 32 * tn + r;
#pragma unroll
                    for (int g = 0; g < 4; ++g) { const int s0 = 32 * tm + 8 * g + 4 * hh;
                        const float p0 = (s0 + 0 <= t) ? acc[4 * g + 0] : 0.f, p1 = (s0 + 1 <= t) ? acc[4 * g + 1] : 0.f, p2 = (s0 + 2 <= t) ? acc[4 * g + 2] : 0.f, p3 = (s0 + 3 <= t) ? acc[4 * g + 3] : 0.f;
                        *(LAS u32x2*)(PS + t * 136 + 64 * sub + s0) = (u32x2){pk2(p0, p1), pk2(p2, p3)}; }
                } else if (sub == 1 && wave < 7) {
                    const int tm = (wave - 3) >> 1, tn = (wave - 3) & 1;
                    f32x16 acc;
#pragma unroll
                    for (int i = 0; i < 16; ++i) acc[i] = 0.f;
#pragma unroll
                    for (int ks = 0; ks < 8; ++ks) { const bf16x8 a = *(const LAS bf16x8*)(KSA + (32 * tm + r) * 136 + 16 * ks + 8 * hh), bb = *(const LAS bf16x8*)(QS + (32 * tn + r) * 136 + 16 * ks + 8 * hh); acc = MFMA32(a, bb, acc); }
                    const int t = 32 * tn + r;
#pragma unroll
                    for (int g = 0; g < 4; ++g) { const int s0 = 32 * tm + 8 * g + 4 * hh;
                        *(LAS u32x2*)(PS + t * 136 + s0) = (u32x2){pk2(acc[4 * g], acc[4 * g + 1]), pk2(acc[4 * g + 2], acc[4 * g + 3])}; }
                }
#pragma unroll
                for (int k = 0; k < 2; ++k) {
                    const int vt = wave >> 1, dt = 2 * (wave & 1) + k;
                    f32x16 acc;
#pragma unroll
                    for (int i = 0; i < 16; ++i) acc[i] = 0.f;
#pragma unroll
                    for (int ks = 0; ks < 4; ++ks) { const bf16x8 a = *(const LAS bf16x8*)(VT + (32 * vt + r) * 136 + 64 * sub + 16 * ks + 8 * hh), bb = *(const LAS bf16x8*)(KHT + (32 * dt + r) * 72 + 16 * ks + 8 * hh); acc = MFMA32(a, bb, acc); }
                    const float c1 = EC1[32 * dt + r];
                    if (sub == 0) {
#pragma unroll
                        for (int i = 0; i < 16; ++i) DA[k][i] = acc[i] * c1;
                    } else { const float ab = AB[32 * dt + r];
#pragma unroll
                        for (int i = 0; i < 16; ++i) acc[i] = DA[k][i] * ab + acc[i] * c1;
                        bf16_t* xp = X + ((size_t)seq * 32 + sc) * 16384 + (size_t)(32 * vt + 4 * hh) * 128 + 32 * dt + r;
#pragma unroll
                        for (int i = 0; i < 16; i += 2) { const unsigned p = pk2(acc[i], acc[i + 1]); const int v0 = (i & 3) + 8 * (i >> 2);
                            xp[(size_t)v0 * 128] = (bf16_t)(p & 0xffffu); xp[(size_t)(v0 + 1) * 128] = (bf16_t)(p >> 16); } }
                }
                {
                    bf16_t* zp = Z + (size_t)dir * ARR + s1_rowoff(it, sub, j8) + 16 * cg8;
                    __builtin_nontemporal_store(*(const LAS u32x4*)(TZ + j8 * 136 + 16 * cg8), (u32x4*)zp); __builtin_nontemporal_store(*(const LAS u32x4*)(TZ + j8 * 136 + 16 * cg8 + 8), (u32x4*)(zp + 8));
                }
            }
            __syncthreads();
            {
                const int vt = wave & 3, tn = wave >> 2;
                f32x16 acc;
#pragma unroll
                for (int i = 0; i < 16; ++i) acc[i] = 0.f;
                if (sub == 1) {
#pragma unroll
                    for (int ks = 0; ks < 4; ++ks) { const bf16x8 a = *(const LAS bf16x8*)(VT + (32 * vt + r) * 136 + 16 * ks + 8 * hh), bb = *(const LAS bf16x8*)(PS + (32 * tn + r) * 136 + 16 * ks + 8 * hh); acc = MFMA32(a, bb, acc); }
                }
#pragma unroll
                for (int ks = 0; ks < 4; ++ks) { if (ks < 2 * (tn + 1)) { const bf16x8 a = *(const LAS bf16x8*)(VT + (32 * vt + r) * 136 + 64 * sub + 16 * ks + 8 * hh), bb = *(const LAS bf16x8*)(PS + (32 * tn + r) * 136 + 64 * sub + 16 * ks + 8 * hh); acc = MFMA32(a, bb, acc); } }
                LAS bf16_t* op = QS + (32 * tn + r) * 136 + 32 * vt + 4 * hh;
#pragma unroll
                for (int g = 0; g < 4; ++g) *(LAS u32x2*)(op + 8 * g) = (u32x2){pk2(acc[4 * g], acc[4 * g + 1]), pk2(acc[4 * g + 2], acc[4 * g + 3])};
            }
            __syncthreads();
            {
                bf16_t* op = O + (size_t)dir * ARR + s1_rowoff(it, sub, j8) + 16 * cg8;
                __builtin_nontemporal_store(*(const LAS u32x4*)(QS + j8 * 136 + 16 * cg8), (u32x4*)op); __builtin_nontemporal_store(*(const LAS u32x4*)(QS + j8 * 136 + 16 * cg8 + 8), (u32x4*)(op + 8));
            }
        }
    }
}
DI void phase_lnstats(const bf16_t* GV, f32x2* STATS, int G) {
    const int tid_ = opaque_tid(); const int lane = tid_ & 63, wave = __builtin_amdgcn_readfirstlane(tid_ >> 6);
    const int gw = blockIdx.x * 8 + wave, NGW = G * 8;
    for (int m = gw; m < MH; m += NGW) {
        const bf16_t* p = GV + (size_t)m * D + 16 * lane;
        const u32x4 a0 = *(const u32x4*)p, a1 = *(const u32x4*)(p + 8);
        const unsigned aw[8] = {a0.x, a0.y, a0.z, a0.w, a1.x, a1.y, a1.z, a1.w};
        float s1 = 0.f, s2 = 0.f;
#pragma unroll
        for (int w = 0; w < 8; ++w) { const float x0 = bflo(aw[w]), x1 = bfhi(aw[w]); s1 += x0 + x1; s2 += x0 * x0 + x1 * x1; }
        s1 = wave_sum(s1); s2 = wave_sum(s2);
        const float mean = s1 * (1.0f / D), var = fmaxf(s2 * (1.0f / D) - mean * mean, 0.f);
        if (lane == 0) STATS[m] = (f32x2){mean, rsqrtf(var + 1e-5f)};
    }
}
DI void phase_s2(bf16_t* X, const float* AC, int G) {
    const int tid = opaque_tid();
    for (int gid = blockIdx.x * 512 + tid; gid < 64 * 2048; gid += G * 512) {
        const int seq = gid >> 11, e = gid & 2047, d0 = (e & 15) * 8, dir = seq & 1;
        bf16_t* xp = X + (size_t)seq * 32 * 16384 + (size_t)(e >> 4) * 128 + d0;
        const float* ap = AC + (size_t)seq * 32 * 128 + d0;
        float S[8];
#pragma unroll
        for (int i = 0; i < 8; ++i) S[i] = 0.f;
        for (int st = 0; st < 32; st += 8) {
            u32x4 dv[8]; f32x4 a0[8], a1[8];
#pragma unroll
            for (int u = 0; u < 8; ++u) { const int c = dir ? 31 - (st + u) : st + u; dv[u] = *(const u32x4*)(xp + (size_t)c * 16384); a0[u] = *(const f32x4*)(ap + c * 128); a1[u] = *(const f32x4*)(ap + c * 128 + 4); }
#pragma unroll
            for (int u = 0; u < 8; ++u) { const int c = dir ? 31 - (st + u) : st + u;
                *(u32x4*)(xp + (size_t)c * 16384) = (u32x4){pk2(S[0], S[1]), pk2(S[2], S[3]), pk2(S[4], S[5]), pk2(S[6], S[7])};
                S[0] = a0[u].x * S[0] + bflo(dv[u].x); S[1] = a0[u].y * S[1] + bfhi(dv[u].x); S[2] = a0[u].z * S[2] + bflo(dv[u].y); S[3] = a0[u].w * S[3] + bfhi(dv[u].y);
                S[4] = a1[u].x * S[4] + bflo(dv[u].z); S[5] = a1[u].y * S[5] + bfhi(dv[u].z); S[6] = a1[u].z * S[6] + bflo(dv[u].w); S[7] = a1[u].w * S[7] + bfhi(dv[u].w); }
        }
    }
}
struct S3Regs { u32x4 x[8], q[8]; };
DI void s3_decode(int it, int& c, int& h, int& b) { const int rest = (it & 7) | ((it >> 4) << 3); c = ((rest & 31) << 1) | ((it >> 3) & 1); h = (rest >> 5) & 7; b = rest >> 8; }
DI void s3_load(S3Regs& R, const bf16_t* QH, const bf16_t* X, int it, int dir, int ts, int vt, int lane) {
    int c, h, b; s3_decode(it, c, h, b);
    const bf16_t* xp = X + ((size_t)((b * 8 + h) * 2 + dir) * 32 + (c >> 1)) * 16384 + (size_t)(32 * vt) * 128 + 8 * lane;
    const bf16_t* qp = QH + (size_t)dir * ARR + ((size_t)b * SEQ + c * 64 + 32 * ts + (lane >> 4)) * D + h * 128 + 8 * (lane & 15);
#pragma unroll
    for (int k = 0; k < 8; ++k) { R.x[k] = *(const u32x4*)(xp + 512 * k); R.q[k] = *(const u32x4*)(qp + (size_t)(4 * k) * D); }
}
DI void phase_s3(LAS unsigned char* lds, const bf16_t* QH, const bf16_t* O, const bf16_t* X, const bf16_t* SGA, const float* gw_, bf16_t* YA, int G) {
    const int tid = opaque_tid(), lane = tid & 63, wave = __builtin_amdgcn_readfirstlane(tid >> 6);
    const int r = lane & 31, hh = lane >> 5, ts = wave >> 2, vt = wave & 3;
    LAS bf16_t* XW = (LAS bf16_t*)(lds + wave * 17408);
    LAS bf16_t* QW = XW + 32 * 136;
    LAS float* SS0 = (LAS float*)(lds + 8 * 17408);
    S3Regs R;
    int it = blockIdx.x;
    if (it < 2048) s3_load(R, QH, X, it, 0, ts, vt, lane);
    __syncthreads();
    for (int par = 0; it < 2048; it += G, par ^= 1) {
        int c, h, b; s3_decode(it, c, h, b);
        const size_t row = (size_t)b * SEQ + c * 64 + 32 * ts + r;
        LAS float* SS = SS0 + par * 256;
        const size_t eoff = ((size_t)b * SEQ + c * 64 + 32 * ts + (lane >> 2)) * D + h * 128 + 32 * vt + 8 * (lane & 3);
        u32x4 ef2[2], eb2[2], es2[2];
        f32x16 acc;
#pragma unroll
        for (int i = 0; i < 16; ++i) acc[i] = 0.f;
#pragma unroll
        for (int dir = 0; dir < 2; ++dir) {
#pragma unroll
            for (int k = 0; k < 8; ++k) { const int id = 64 * k + lane; *(LAS u32x4*)(XW + (id >> 4) * 136 + 8 * (id & 15)) = R.x[k]; *(LAS u32x4*)(QW + (id >> 4) * 136 + 8 * (id & 15)) = R.q[k]; }
            asm volatile("" ::: "memory");
            if (dir == 0) { s3_load(R, QH, X, it, 1, ts, vt, lane);
#pragma unroll
                for (int k = 0; k < 2; ++k) { ef2[k] = *(const u32x4*)(O + eoff + (size_t)(16 * k) * D); eb2[k] = *(const u32x4*)(O + ARR + eoff + (size_t)(16 * k) * D); es2[k] = *(const u32x4*)(SGA + eoff + (size_t)(16 * k) * D); } }
            else if (it + G < 2048) s3_load(R, QH, X, it + G, 0, ts, vt, lane);
#pragma unroll
            for (int ks = 0; ks < 8; ++ks) { const bf16x8 a = *(const LAS bf16x8*)(XW + r * 136 + 16 * ks + 8 * hh), bb = *(const LAS bf16x8*)(QW + r * 136 + 16 * ks + 8 * hh); acc = MFMA32(a, bb, acc); }
        }
        asm volatile("" ::: "memory");
        LAS bf16_t* T0 = XW; LAS bf16_t* T1 = XW + 1280; LAS bf16_t* T2 = XW + 2560; LAS bf16_t* TY = XW + 3840;
#pragma unroll
        for (int k = 0; k < 2; ++k) { const int eo = ((lane >> 2) + 16 * k) * 40 + 8 * (lane & 3);
            *(LAS u32x4*)(T0 + eo) = ef2[k]; *(LAS u32x4*)(T1 + eo) = eb2[k]; *(LAS u32x4*)(T2 + eo) = es2[k]; }
        asm volatile("" ::: "memory");
        u32x2 ef[4], eb[4], es[4];
#pragma unroll
        for (int g = 0; g < 4; ++g) { const int co = r * 40 + 8 * g + 4 * hh; ef[g] = *(const LAS u32x2*)(T0 + co); eb[g] = *(const LAS u32x2*)(T1 + co); es[g] = *(const LAS u32x2*)(T2 + co); }
        float o[16]; float ss = 0.f;
#pragma unroll
        for (int g = 0; g < 4; ++g) { const u32x2 f = ef[g], bk = eb[g];
            o[4 * g] = acc[4 * g] + bflo(f.x) + bflo(bk.x); o[4 * g + 1] = acc[4 * g + 1] + bfhi(f.x) + bfhi(bk.x); o[4 * g + 2] = acc[4 * g + 2] + bflo(f.y) + bflo(bk.y); o[4 * g + 3] = acc[4 * g + 3] + bfhi(f.y) + bfhi(bk.y); }
#pragma unroll
        for (int i = 0; i < 16; ++i) ss += o[i] * o[i];
        ss += __shfl_xor(ss, 32);
        if (hh == 0) SS[(32 * ts + r) * 4 + vt] = ss;
        __syncthreads();
        const f32x4 s4 = *(const LAS f32x4*)(SS + (32 * ts + r) * 4);
        const float rstd = rsqrtf((s4.x + s4.y + s4.z + s4.w) * (1.0f / 128.0f) + 1e-6f);
#pragma unroll
        for (int g = 0; g < 4; ++g) { const u32x2 sg = es[g]; const f32x4 gv = *(const f32x4*)(gw_ + 32 * vt + 8 * g + 4 * hh);
            *(LAS u32x2*)(TY + r * 40 + 8 * g + 4 * hh) = (u32x2){pk2(o[4 * g] * rstd * gv.x * siluf_(bflo(sg.x)), o[4 * g + 1] * rstd * gv.y * siluf_(bfhi(sg.x))), pk2(o[4 * g + 2] * rstd * gv.z * siluf_(bflo(sg.y)), o[4 * g + 3] * rstd * gv.w * siluf_(bfhi(sg.y)))}; }
        asm volatile("" ::: "memory");
#pragma unroll
        for (int k = 0; k < 2; ++k) *(u32x4*)(YA + eoff + (size_t)(16 * k) * D) = *(const LAS u32x4*)(TY + ((lane >> 2) + 16 * k) * 40 + 8 * (lane & 3));
        asm volatile("" ::: "memory");
    }
}

DI void phase_spatial(LAS unsigned char* lds, const bf16_t* GV, bf16_t* UG, const f32x2* STATS, const float* ln_w, const float* ln_b, const float* w_s, const float* b_s, int G) {
    const int tid = opaque_tid(), lane = tid & 63, wave = __builtin_amdgcn_readfirstlane(tid >> 6);
    const int r = lane & 31, hh = lane >> 5;
    LAS bf16_t* VL = (LAS bf16_t*)(lds);
    LAS bf16_t* WS = (LAS bf16_t*)(lds + 34816);
    int g_last = -1;
    for (int it = blockIdx.x; it < 1024; it += G) {
        const int g = it & 7, n = (it >> 3) & 31, b = it >> 8;
        const size_t rowbase = (size_t)b * SEQ + (size_t)n * 128;
        __syncthreads();
        {
            const int s = tid >> 2, cq = tid & 3; const f32x2 st = STATS[rowbase + s];
            const bf16_t* p = GV + (rowbase + s) * D + 128 * g + 32 * cq;
#pragma unroll
            for (int q = 0; q < 4; ++q) { const u32x4 a = *(const u32x4*)(p + 8 * q); const unsigned aw[4] = {a.x, a.y, a.z, a.w};
                const f32x4 w0 = *(const f32x4*)(ln_w + 128 * g + 32 * cq + 8 * q), w1 = *(const f32x4*)(ln_w + 128 * g + 32 * cq + 8 * q + 4);
                const f32x4 c0 = *(const f32x4*)(ln_b + 128 * g + 32 * cq + 8 * q), c1 = *(const f32x4*)(ln_b + 128 * g + 32 * cq + 8 * q + 4);
                const float wv[8] = {w0.x, w0.y, w0.z, w0.w, w1.x, w1.y, w1.z, w1.w}, bv[8] = {c0.x, c0.y, c0.z, c0.w, c1.x, c1.y, c1.z, c1.w};
#pragma unroll
                for (int w = 0; w < 4; ++w) { const float y0 = (bflo(aw[w]) - st.x) * st.y * wv[2 * w] + bv[2 * w], y1 = (bfhi(aw[w]) - st.x) * st.y * wv[2 * w + 1] + bv[2 * w + 1];
                    const unsigned pk = pk2(y0, y1); const int cc = 32 * cq + 8 * q + 2 * w;
                    VL[cc * 136 + s] = (bf16_t)(pk & 0xffffu); VL[(cc + 1) * 136 + s] = (bf16_t)(pk >> 16); } }
            if (g != g_last) {
                const int t = tid >> 2, sq = tid & 3; const float* wp = w_s + ((size_t)g * 128 + t) * 128 + 32 * sq;
#pragma unroll
                for (int q = 0; q < 4; ++q) { const f32x4 x0 = *(const f32x4*)(wp + 8 * q), x1 = *(const f32x4*)(wp + 8 * q + 4);
                    *(LAS u32x4*)(WS + t * 136 + 32 * sq + 8 * q) = (u32x4){pk2(x0.x, x0.y), pk2(x0.z, x0.w), pk2(x1.x, x1.y), pk2(x1.z, x1.w)}; }
                g_last = g; }
        }
        __syncthreads();
        {
            const int cm = wave & 3;
#pragma unroll
            for (int tt = 0; tt < 2; ++tt) {
                const int tn = 2 * (wave >> 2) + tt;
                f32x16 acc;
#pragma unroll
                for (int i = 0; i < 16; ++i) acc[i] = 0.f;
#pragma unroll
                for (int ks = 0; ks < 8; ++ks) { const bf16x8 a = *(const LAS bf16x8*)(VL + (32 * cm + r) * 136 + 16 * ks + 8 * hh), bb = *(const LAS bf16x8*)(WS + (32 * tn + r) * 136 + 16 * ks + 8 * hh); acc = MFMA32(a, bb, acc); }
                const int t = 32 * tn + r; const float bias = b_s[g * 128 + t];
                LAS bf16_t* TU = (LAS bf16_t*)(lds + 69632 + wave * 2560);
                bf16_t* ug = UG + (rowbase + 32 * tn + (lane >> 2)) * D + 128 * g + 32 * cm + 8 * (lane & 3);
                const int eo = (lane >> 2) * 40 + 8 * (lane & 3);
                const u32x4 u0 = *(const u32x4*)ug, u1 = *(const u32x4*)(ug + (size_t)16 * D);
                asm volatile("" ::: "memory");
                *(LAS u32x4*)(TU + eo) = u0; *(LAS u32x4*)(TU + eo + 16 * 40) = u1;
                asm volatile("" ::: "memory");
#pragma unroll
                for (int q = 0; q < 4; ++q) { const int co = r * 40 + 8 * q + 4 * hh; const u32x2 uw = *(const LAS u32x2*)(TU + co);
                    *(LAS u32x2*)(TU + co) = (u32x2){pk2(bflo(uw.x) * (acc[4 * q] + bias), bfhi(uw.x) * (acc[4 * q + 1] + bias)), pk2(bflo(uw.y) * (acc[4 * q + 2] + bias), bfhi(uw.y) * (acc[4 * q + 3] + bias))}; }
                asm volatile("" ::: "memory");
                *(u32x4*)ug = *(const LAS u32x4*)(TU + eo); *(u32x4*)(ug + (size_t)16 * D) = *(const LAS u32x4*)(TU + eo + 16 * 40);
                asm volatile("" ::: "memory");
            }
        }
    }
}

struct Args { const float* in[13]; float* out; unsigned char* ws; int ph_lo, ph_hi; };
constexpr int PPL = 11;
constexpr int NPH = 4 * PPL + 1;

__global__ void __launch_bounds__(512, 2) mega(Args a) {
    extern __shared__ __attribute__((aligned(16))) unsigned char shm[];
    LAS unsigned char* lds = (LAS unsigned char*)shm;
    cg::grid_group grid = cg::this_grid();
    const int G = gridDim.x, blk = blockIdx.x;
    unsigned char* ws = a.ws;
    const float* x0 = a.in[0];
    bf16_t* Hb = (bf16_t*)(ws + WS_H); bf16_t* out9 = (bf16_t*)(ws + WS_OUT9);
    bf16_t* Qb = out9, *ZFb = out9 + ARR, *Ib = out9 + 3 * ARR, *SGAb = out9 + 4 * ARR, *GVb = out9 + 5 * ARR;
    bf16_t* g3 = (bf16_t*)(ws + WS_G3); bf16_t* UGf = g3, *SMAf = g3 + 2 * ARR, *SMBf = g3 + 4 * ARR;
    bf16_t* OFb = (bf16_t*)(ws + WS_OF); bf16_t* Xb = (bf16_t*)(ws + WS_X); float* ACb = (float*)(ws + WS_AC); f32x2* STb = (f32x2*)(ws + WS_ST);
    volatile LAS unsigned* bst = (volatile LAS unsigned*)(lds + LDS_BYTES - 16);
    if (threadIdx.x < 4) bst[threadIdx.x] = 0u;
    if (blk == 0) for (int i = threadIdx.x; i < XCD_BAR_WORDS; i += 512) ((unsigned*)ws)[i] = 0u;
    __syncthreads();
    XcdBarrier xb; xb.bar = (unsigned*)ws; xb.x = 0; xb.st = bst;
    for (int ph = a.ph_lo; ph < a.ph_hi; ++ph) {
        if (ph == a.ph_lo + 1) { grid.sync(); xb = xcd_barrier_post((unsigned*)ws, bst); }
        else if (ph > a.ph_lo + 1) xcd_barrier(xb);
        if (ph == NPH - 1) { phase_final(a.out, a.in[12], M_ALL, G); continue; }
        const int l = ph / PPL, rr = ph % PPL;
        const float* xin = (l == 0) ? x0 : a.out;
        if (rr == 0) {
            phase_prep(lds, a.in[2] + (size_t)l * D * NIN, a.in[9] + (size_t)l * D * D, a.in[10] + (size_t)l * D * D, a.in[11] + (size_t)l * D * D, ws, G);
            phase_rms_bf16(xin, a.in[1] + l * D, Hb, M_ALL, G);
            if (blk == 0) {
                float* LBT = (float*)(ws + WS_LBT);
                for (int i = threadIdx.x; i < 2048; i += 512) { const float* lp = a.in[3] + i;
                    const float v0 = lp[0], v1 = lp[2048], v2 = lp[4096], v3 = lp[6144], mx = fmaxf(fmaxf(v0, v1), fmaxf(v2, v3));
                    const float e0 = __expf(v0 - mx), e1 = __expf(v1 - mx), e2 = __expf(v2 - mx), e3 = __expf(v3 - mx);
                    float lb = 0.f; if (l >= 1) lb += e1; if (l >= 2) lb += e2; if (l >= 3) lb += e3;
                    lb = lb / (e0 + e1 + e2 + e3);
                    LBT[(i >> 10) * 2048 + (i & 1023)] = fmaxf(lb, 1e-20f); LBT[(i >> 10) * 2048 + 1024 + (i & 1023)] = 1.0f - lb; }
            }
            continue;
        }
        const int hf = (rr <= 8) ? (rr - 1) / 4 : 0, k = (rr <= 8) ? (rr - 1) % 4 : rr - 5;
        bf16_t* Hh = Hb + (size_t)hf * ARR;
        bf16_t* UGb = UGf + (size_t)hf * ARR;
        if (k == 0) {
            pg8::Gemm g{Hh, Hh, (const bf16_t*)(ws + WS_WIN), (const bf16_t*)(ws + WS_WIN), D};
            pg8::Order S; S.init(MH, NIN, G, blk, 0, 1);
            EpiInProj E{out9, g3 + (size_t)hf * ARR};
            pg8::gemm_phase<EpiInProj>(lds, g, S, E);
        } else if (k == 1) {
            phase_lnstats(GVb, STb, G);
            phase_s1(lds, Qb, ZFb, Ib, OFb, Xb, ACb, (const float*)(ws + WS_LBT), G);
        } else if (k == 2) {
            phase_s2(Xb, ACb, G);
        } else if (k == 3) {
            if (blk & 1) phase_s3(lds, ZFb, OFb, Xb, SGAb, a.in[4] + l * 128, Hh, G);
            __syncthreads();
            phase_spatial(lds, GVb, UGb, STb, a.in[5] + l * D, a.in[6] + l * D, a.in[7] + (size_t)l * 8 * 128 * 128, a.in[8] + l * 8 * 128, G);
            __syncthreads();
            if (!(blk & 1)) phase_s3(lds, ZFb, OFb, Xb, SGAb, a.in[4] + l * 128, Hh, G);
        } else if (k == 4) {
            pg8::Gemm g{UGf, Hb, (const bf16_t*)(ws + WS_WB), (const bf16_t*)(ws + WS_WA), D};
            pg8::Order S; S.init(M_ALL, D, G, blk, 1);
            EpiProjAB E{SMAf, SMBf, out9};
            pg8::gemm_phase<EpiProjAB>(lds, g, S, E);
        } else {
            pg8::Gemm g{out9, out9, (const bf16_t*)(ws + WS_WO), (const bf16_t*)(ws + WS_WO), D};
            pg8::Order S; S.init(M_ALL, D, G, blk, 0);
            EpiResid E{xin, a.out};
            pg8::gemm_phase<EpiResid>(lds, g, S, E);
        }
    }
}


extern "C" void kernel_launch(void* const* d_in, const int* in_sizes, int n_in, void* d_out, int out_size, void* d_ws, size_t ws_size, hipStream_t stream) {
    static int grid = 0;
    if (grid == 0) {
        if (n_in != 13 || ws_size < WS_END) { fprintf(stderr, "kernel_launch: unexpected inputs (n_in %d, ws %zu, need %zu)\n", n_in, ws_size, (size_t)WS_END); grid = -1; return; }
        int dev = 0, cus = 0, per_cu = 0;
        hipGetDevice(&dev); hipDeviceGetAttribute(&cus, hipDeviceAttributeMultiprocessorCount, dev);
        if (hipFuncSetAttribute((const void*)mega, hipFuncAttributeMaxDynamicSharedMemorySize, LDS_BYTES) != hipSuccess) { fprintf(stderr, "kernel_launch: hipFuncSetAttribute failed\n"); grid = -1; return; }
        if (hipOccupancyMaxActiveBlocksPerMultiprocessor(&per_cu, (const void*)mega, 512, LDS_BYTES) != hipSuccess || per_cu < 1) { fprintf(stderr, "kernel_launch: occupancy query gave %d\n", per_cu); per_cu = 1; }
        (void)hipGetLastError();
        grid = cus * 1;
        fprintf(stderr, "kernel_launch: cus %d per_cu %d grid %d\n", cus, per_cu, grid);
    }
    if (grid < 0) return;
    Args a{};
    for (int i = 0; i < 13; ++i) a.in[i] = (const float*)d_in[i];
    a.out = (float*)d_out; a.ws = (unsigned char*)d_ws; a.ph_lo = 0; a.ph_hi = NPH;
    void* args[] = {&a};
    hipError_t e = hipLaunchCooperativeKernel((const void*)mega, dim3(grid), dim3(512), args, LDS_BYTES, stream);
    if (e != hipSuccess) fprintf(stderr, "kernel_launch: cooperative launch failed: %s (grid %d)\n", hipGetErrorString(e), grid);
}
```

```cpp
#include <hip/hip_runtime.h>
#include <hip/hip_cooperative_groups.h>
#include <cstdio>
namespace cg = cooperative_groups;

#define LAS __attribute__((address_space(3)))
#define DI __device__ __forceinline__
typedef unsigned short bf16_t;
typedef short bf16x8 __attribute__((ext_vector_type(8)));
typedef float f32x4 __attribute__((ext_vector_type(4)));
typedef float f32x2 __attribute__((ext_vector_type(2)));
typedef float f32x16 __attribute__((ext_vector_type(16)));
typedef unsigned u32x4 __attribute__((ext_vector_type(4)));
typedef unsigned u32x2 __attribute__((ext_vector_type(2)));
typedef __bf16 bf16v2 __attribute__((ext_vector_type(2)));

constexpr int D = 1024, SEQ = 4096, MH = 16384, M_ALL = 32768, DEPTH = 4, NIN = 10240;
constexpr int LDS_BYTES = 163840;
constexpr float LOG2E = 1.4426950408889634f;
constexpr size_t ARR = (size_t)MH * D;

constexpr size_t WS_WIN = 1ull << 20;
constexpr size_t WS_WA = WS_WIN + (size_t)NIN * D * 2;
constexpr size_t WS_WB = WS_WA + (size_t)D * D * 2;
constexpr size_t WS_WO = WS_WB + (size_t)D * D * 2;
constexpr size_t WS_H = WS_WO + (size_t)D * D * 2;
constexpr size_t WS_OUT9 = WS_H + (size_t)M_ALL * D * 2;
constexpr size_t WS_G3 = WS_OUT9 + 6 * ARR * 2;
constexpr size_t WS_OF = WS_G3 + 6 * ARR * 2;
constexpr size_t WS_X = WS_OF + 2 * ARR * 2;
constexpr size_t WS_AC = WS_X + (size_t)64 * 32 * 16384 * 2;
constexpr size_t WS_ST = WS_AC + (size_t)64 * 32 * 128 * 4;
constexpr size_t WS_LBT = WS_ST + (size_t)MH * 8;
constexpr size_t WS_END = WS_LBT + 4096 * 4;

DI unsigned pk2(float lo, float hi) { f32x2 v = {lo, hi}; bf16v2 r = __builtin_convertvector(v, bf16v2); return __builtin_bit_cast(unsigned, r); }
DI float bflo(unsigned w) { return __uint_as_float(w << 16); }
DI float bfhi(unsigned w) { return __uint_as_float(w & 0xffff0000u); }
DI float fexp2(float x) { return __builtin_amdgcn_exp2f(x); }
DI float frcp(float x) { return __builtin_amdgcn_rcpf(x); }
DI float sigmoidf_(float x) { return frcp(1.0f + fexp2(-x * LOG2E)); }
DI float siluf_(float x) { return x * sigmoidf_(x); }
DI float geluf_(float x) { const float t = x + 0.044715f * x * x * x; return x * frcp(1.0f + fexp2(-2.3022082f * t)); }
DI float wave_sum(float v) {
#pragma unroll
    for (int o = 1; o < 64; o <<= 1) v += __shfl_xor(v, o);
    return v;
}
#define LDS_WAIT() asm volatile("s_waitcnt lgkmcnt(0)" ::: "memory")
template <int CTRL, int ROWMASK, bool BC> DI float dpp_f(float x) { return __int_as_float(__builtin_amdgcn_update_dpp(0, __float_as_int(x), CTRL, ROWMASK, 0xf, BC)); }
DI int opaque_tid() { int t = threadIdx.x; asm volatile("" : "+v"(t)); return t; }


#define XB_TMO      128
#define XB_XCNT(j)  (256  + 64 * (j))
#define XB_XSUB(j)  (1280 + 64 * (j))
#define XB_XGEN(j)  (2304 + 64 * (j))
#define XB_TOP      3328
#define XB_TOPGEN   3392
#define XCD_BAR_WORDS 3456
#define XB_SPIN_CAP (1u << 22)
DI unsigned xb_ld(unsigned* p)              { return __hip_atomic_load(p, __ATOMIC_RELAXED, __HIP_MEMORY_SCOPE_AGENT); }
DI unsigned xb_add(unsigned* p, unsigned v) { return __hip_atomic_fetch_add(p, v, __ATOMIC_RELAXED, __HIP_MEMORY_SCOPE_AGENT); }
DI unsigned xb_xcc_id() { return (unsigned)__builtin_amdgcn_s_getreg((3 << 11) | 20) & 0xFu; }
#define XB_SPIN(cond, bar) do { unsigned _sp = 0; while (cond) { __builtin_amdgcn_s_sleep(1); \
    if ((++_sp & 255u) == 0u) { if (xb_ld(&(bar)[XB_TMO])) break; if (_sp > XB_SPIN_CAP) { atomicAdd(&(bar)[XB_TMO], 1u); break; } } } } while (0)
struct XcdBarrier { unsigned* bar; unsigned x; volatile LAS unsigned* st; };
DI XcdBarrier xcd_barrier_post(unsigned* bar, volatile LAS unsigned* st) {
    XcdBarrier b; b.bar = bar; b.x = xb_xcc_id(); b.st = st;
    if (threadIdx.x == 0) (void)xb_add(&bar[XB_XCNT(b.x)], 1u);
    return b;
}
DI void xcd_barrier_complete(unsigned* bar, unsigned x, unsigned& nloc, unsigned& nx) {
    const unsigned G = gridDim.x * gridDim.y * gridDim.z;
    unsigned sum, cnt, mine, sp = 0u;
    for (;;) {
        sum = 0u; cnt = 0u; mine = 0u;
#pragma unroll
        for (unsigned j = 0; j < 16; ++j) { const unsigned c = xb_ld(&bar[XB_XCNT(j)]); sum += c; cnt += (c > 0u) ? 1u : 0u; mine = (j == x) ? c : mine; }
        if (sum == G) break;
        __builtin_amdgcn_s_sleep(1);
        if ((++sp & 255u) == 0u) { if (xb_ld(&bar[XB_TMO])) break; if (sp > XB_SPIN_CAP) { atomicAdd(&bar[XB_TMO], 1u); break; } }
    }
    nloc = mine > 0u ? mine : 1u; nx = cnt > 0u ? cnt : 1u;
}
DI void xcd_barrier(const XcdBarrier& b) {
    asm volatile("s_waitcnt vmcnt(0)" ::: "memory");
    __syncthreads();
    if (threadIdx.x == 0) {
        unsigned* bar = b.bar;
        __builtin_amdgcn_s_waitcnt(0);
        unsigned nloc = b.st[0], nx = b.st[1];
        if (nloc == 0u) { xcd_barrier_complete(bar, b.x, nloc, nx); b.st[0] = nloc; b.st[1] = nx; }
        const unsigned old = xb_add(&bar[XB_XSUB(b.x)], 1u);
        const unsigned gen = old / nloc;
        if (old + 1u == (gen + 1u) * nloc) {
            __builtin_amdgcn_fence(__ATOMIC_RELEASE, "agent");
            asm volatile("s_waitcnt vmcnt(0)" ::: "memory");
            const unsigned og = xb_add(&bar[XB_TOP], 1u);
            const unsigned tg = og / nx;
            if (og + 1u == (tg + 1u) * nx) xb_add(&bar[XB_TOPGEN], 1u);
            else XB_SPIN(xb_ld(&bar[XB_TOPGEN]) == tg, bar);
            __builtin_amdgcn_fence(__ATOMIC_ACQUIRE, "agent");
            xb_add(&bar[XB_XGEN(b.x)], 1u);
            asm volatile("s_waitcnt vmcnt(0)" ::: "memory");
        } else {
            XB_SPIN(xb_ld(&bar[XB_XGEN(b.x)]) == gen, bar);
            __builtin_amdgcn_fence(__ATOMIC_ACQUIRE, "agent");
            asm volatile("s_waitcnt vmcnt(0)" ::: "memory");
        }
    }
    __syncthreads();
}

namespace pg8 {
constexpr int BM = 256, BK = 64, HALF = 128, HTB = HALF * BK * 2, STAGE_BYTES = 8 * HTB, NXCD = 8, WGM = 8;
DI int lds_byte(int r, int c) { const int st = (r >> 4) * 2 + (c >> 5), rr = r & 15, cc = c & 31, ob = rr * 64 + cc * 2; return st * 1024 + (ob ^ (((ob >> 9) & 1) << 5)); }
DI void stage_rc(int b, int& R, int& C) { const int st = b / 1024, sb = b % 1024, swz = sb ^ (((sb >> 9) & 1) << 5); R = (st >> 1) * 16 + swz / 64; C = (st & 1) * 32 + (swz % 64) / 2; }
DI int perm32(int rho) { const int n = rho >> 4, i = rho & 15; return 8 * (i >> 2) + 4 * n + (i & 3); }

struct Unit { int pm, pn, sel; };
struct Gemm { const bf16_t* A0; const bf16_t* A1; const bf16_t* B0; const bf16_t* B1; int K; };
struct Order {
    int nM, nN, nwg, G, c, dual, rev;
    DI void init(int M, int N, int G_, int c_, int dual_, int rev_ = 0) { nM = M / BM; nN = N / BM; nwg = nM * nN; G = G_; c = c_; dual = dual_; rev = rev_; }
    DI bool next(int i, Unit& u) const {
        const int ti = dual ? (i >> 1) : i; u.sel = dual ? (i & 1) : 0;
        const long L = (long)ti * G + c; if (L >= nwg) return false;
        int wgid = (int)L; { const int q = nwg / NXCD, r = nwg % NXCD, xcd = wgid % NXCD, off = wgid / NXCD; wgid = (xcd < r ? xcd * (q + 1) : r * (q + 1) + (xcd - r) * q) + off; }
        const int nig = WGM * nN, gid = wgid / nig, fm = gid * WGM, gsz = (nM - fm) < WGM ? (nM - fm) : WGM;
        u.pm = fm + ((wgid % nig) % gsz); u.pn = (wgid % nig) / gsz; if (rev) u.pn = nN - 1 - u.pn; return true;
    }
};

template <class Epi>
DI void gemm_phase(LAS unsigned char* lds, const Gemm g, const Order& S, const Epi& E) {
    const int tid = opaque_tid(), wid = __builtin_amdgcn_readfirstlane(tid >> 6), lane = tid & 63, wr = wid >> 2, wc = wid & 3, fr = lane & 15, fq = lane >> 4;
    const int K = g.K, nt = K / BK;
    unsigned voffA[2], voffB[2];
#pragma unroll
    for (int i = 0; i < 2; ++i) { int R, C; stage_rc(tid * 16 + i * 8192, R, C); const int Rb = Epi::PERM ? ((R & ~31) + perm32(R & 31)) : R;
        voffA[i] = (unsigned)(R * K + C) * 2u; voffB[i] = (unsigned)(Rb * K + C) * 2u; }
    const size_t kstep = (size_t)(BK * 2);
    const size_t hstep = (size_t)HALF * K * 2;
    const size_t tstep = 2 * hstep;
    const unsigned ldsw = (unsigned)wid * 1024u;
    const int aoff = lds_byte(wr * 64 + fr, fq * 8), boff = lds_byte(wc * 32 + fr, fq * 8);
#define PG8_SA(b, h) (((b) * 2 + (h)) * HTB)
#define PG8_SB(b, h) ((4 + (b) * 2 + (h)) * HTB)
#define PG8_STAGE(bufoff, gbase, voff) do { _Pragma("unroll") for (int _i = 0; _i < 2; ++_i) \
        __builtin_amdgcn_global_load_lds((const unsigned*)((const char*)(gbase) + (voff)[_i]), (LAS unsigned*)(lds + (bufoff) + ldsw + _i * 8192), 16, 0, 0); } while (0)
#define PG8_LDA(dst, b, h) do { _Pragma("unroll") for (int m = 0; m < 4; ++m) _Pragma("unroll") for (int k = 0; k < 2; ++k) dst[m][k] = *(const LAS bf16x8*)(lds + PG8_SA(b, h) + aoff + m * 2048 + k * 1024); } while (0)
#define PG8_LDB(dst, b, h) do { _Pragma("unroll") for (int n = 0; n < 2; ++n) _Pragma("unroll") for (int k = 0; k < 2; ++k) dst[n][k] = *(const LAS bf16x8*)(lds + PG8_SB(b, h) + boff + n * 2048 + k * 1024); } while (0)
#define PG8_MMA(ai, bj, At, Bt) do { __builtin_amdgcn_s_setprio(1); _Pragma("unroll") for (int m = 0; m < 4; ++m) _Pragma("unroll") for (int n = 0; n < 2; ++n) _Pragma("unroll") for (int k = 0; k < 2; ++k) \
        acc[ai][bj][m][n] = __builtin_amdgcn_mfma_f32_16x16x32_bf16(Bt[n][k], At[m][k], acc[ai][bj][m][n], 0, 0, 0); __builtin_amdgcn_s_setprio(0); } while (0)
#define PG8_WAIT_V(n) asm volatile("s_waitcnt vmcnt(" #n ")" ::: "memory")
#define PG8_WAIT_L(n) asm volatile("s_waitcnt lgkmcnt(" #n ")" ::: "memory")
#define PG8_BAR __builtin_amdgcn_s_barrier()
#define PG8_SCHED __builtin_amdgcn_sched_barrier(0)
    Unit cur, nxt; int ui = 0;
    if (!S.next(0, cur)) return;
    f32x4 acc[2][2][4][2];
#pragma unroll
    for (int a = 0; a < 2; ++a)
#pragma unroll
        for (int b = 0; b < 2; ++b)
#pragma unroll
            for (int m = 0; m < 4; ++m)
#pragma unroll
                for (int n = 0; n < 2; ++n) acc[a][b][m][n] = (f32x4){0.f, 0.f, 0.f, 0.f};
    bf16x8 At[4][2], B0[2][2], B1[2][2];
    const char* cA = (const char*)(cur.sel ? g.A1 : g.A0) + (size_t)cur.pm * tstep; const char* cB = (const char*)(cur.sel ? g.B1 : g.B0) + (size_t)cur.pn * tstep;
    PG8_STAGE(PG8_SB(0, 0), cB, voffB); PG8_STAGE(PG8_SB(0, 1), cB + hstep, voffB); PG8_STAGE(PG8_SA(0, 0), cA, voffA); PG8_STAGE(PG8_SA(0, 1), cA + hstep, voffA);
    if (wr == 1) PG8_BAR;
    PG8_WAIT_V(2); PG8_BAR;
    PG8_STAGE(PG8_SB(1, 0), cB + kstep, voffB); PG8_STAGE(PG8_SA(1, 0), cA + kstep, voffA); PG8_STAGE(PG8_SB(1, 1), cB + hstep + kstep, voffB);
    PG8_WAIT_V(6); PG8_BAR;
    for (;;) {
        const bool has_next = S.next(ui + 1, nxt);
        const char* nA = has_next ? (const char*)(nxt.sel ? g.A1 : g.A0) + (size_t)nxt.pm * tstep : cA; const char* nB = has_next ? (const char*)(nxt.sel ? g.B1 : g.B0) + (size_t)nxt.pn * tstep : cB;
        for (int t = 0; t < nt; t += 2) {
            const bool last = (t == nt - 2);
            const char* a1 = cA + (size_t)(t + 1) * kstep;
            const char* a2 = last ? nA : cA + (size_t)(t + 2) * kstep; const char* b2 = last ? nB : cB + (size_t)(t + 2) * kstep;
            const char* a3 = a2 + kstep; const char* b3 = b2 + kstep;
            PG8_LDB(B0, 0, 0); PG8_LDB(B1, 0, 1); PG8_SCHED; PG8_LDA(At, 0, 0); PG8_STAGE(PG8_SA(1, 1), a1 + hstep, voffA);
            PG8_WAIT_V(8); PG8_WAIT_L(0); PG8_BAR; PG8_MMA(0, 0, At, B0); PG8_MMA(0, 1, At, B1); PG8_BAR; PG8_SCHED;
            PG8_LDA(At, 0, 1); PG8_STAGE(PG8_SB(0, 0), b2, voffB); PG8_STAGE(PG8_SB(0, 1), b2 + hstep, voffB); PG8_STAGE(PG8_SA(0, 0), a2, voffA);
            PG8_WAIT_V(8); PG8_WAIT_L(0); PG8_BAR; PG8_MMA(1, 0, At, B0); PG8_MMA(1, 1, At, B1); PG8_BAR; PG8_SCHED;
            PG8_LDB(B0, 1, 0); PG8_LDB(B1, 1, 1); PG8_SCHED; PG8_LDA(At, 1, 0); PG8_STAGE(PG8_SA(0, 1), a2 + hstep, voffA);
            PG8_WAIT_V(8); PG8_WAIT_L(0); PG8_BAR; PG8_MMA(0, 0, At, B0); PG8_MMA(0, 1, At, B1); PG8_BAR; PG8_SCHED;
            PG8_LDA(At, 1, 1); PG8_STAGE(PG8_SB(1, 0), b3, voffB); PG8_STAGE(PG8_SB(1, 1), b3 + hstep, voffB); PG8_STAGE(PG8_SA(1, 0), a3, voffA);
            PG8_WAIT_V(8); PG8_WAIT_L(0); PG8_BAR; PG8_MMA(1, 0, At, B0); PG8_MMA(1, 1, At, B1); PG8_BAR; PG8_SCHED;
        }
        if (wr == 0) PG8_BAR;
        bool keep = false;
        if constexpr (Epi::KEEP) { if (cur.sel == 0) { E.mid(acc, cur, wr, wc, fr, fq); keep = true; } else E(acc, cur, wr, wc, fr, fq); }
        else E(acc, cur, wr, wc, fr, fq);
        if (!has_next) break;
        if (!keep)
#pragma unroll
        for (int a = 0; a < 2; ++a)
#pragma unroll
            for (int b = 0; b < 2; ++b)
#pragma unroll
                for (int m = 0; m < 4; ++m)
#pragma unroll
                    for (int n = 0; n < 2; ++n) acc[a][b][m][n] = (f32x4){0.f, 0.f, 0.f, 0.f};
        cur = nxt; cA = nA; cB = nB; ++ui;
        if (wr == 1) PG8_BAR;
    }
    PG8_WAIT_V(0);
    PG8_BAR;
#undef PG8_SA
#undef PG8_SB
#undef PG8_STAGE
#undef PG8_LDA
#undef PG8_LDB
#undef PG8_MMA
#undef PG8_WAIT_V
#undef PG8_WAIT_L
#undef PG8_BAR
#undef PG8_SCHED
}
}

DI float gelu_silu_(float u, float g) { const float t = u + 0.044715f * u * u * u; const float den = (1.0f + fexp2(-2.3022082f * t)) * (1.0f + fexp2(-g * LOG2E)); return u * g * frcp(den); }
template <int ACT> DI float act_fn(float x) {
    if (ACT == 0) return x;
    if (ACT == 1) return siluf_(x) * 0.08838834764831845f;
    if (ACT == 2) return siluf_(x);
    if (ACT == 3) return geluf_(x);
    return sigmoidf_(x);
}
template <int ACT> DI void store_act(const f32x4 (&acc)[2][2][4][2], bf16_t* base, int row0, int col0) {
#pragma unroll
    for (int ai = 0; ai < 2; ++ai)
#pragma unroll
        for (int m = 0; m < 4; ++m) { bf16_t* rowp = base + (size_t)(row0 + ai * 128 + m * 16) * D + col0;
#pragma unroll
            for (int bj = 0; bj < 2; ++bj) { const f32x4 v0 = acc[ai][bj][m][0], v1 = acc[ai][bj][m][1];
                u32x4 w; w.x = pk2(act_fn<ACT>(v0[0]), act_fn<ACT>(v0[1])); w.y = pk2(act_fn<ACT>(v0[2]), act_fn<ACT>(v0[3]));
                w.z = pk2(act_fn<ACT>(v1[0]), act_fn<ACT>(v1[1])); w.w = pk2(act_fn<ACT>(v1[2]), act_fn<ACT>(v1[3]));
                *(u32x4*)(rowp + bj * 128) = w; } }
}
struct EpiInProj {
    static constexpr bool PERM = true, KEEP = false;
    bf16_t* out9; bf16_t* g3;
    DI void operator()(const f32x4 (&acc)[2][2][4][2], const pg8::Unit& u, int wr, int wc, int fr, int fq) const {
        const int pn = u.pn, row0 = u.pm * 256 + wr * 64 + fr, cl = wc * 32 + 8 * fq;
        if (pn >= 20 && pn < 28) {
            bf16_t* base = g3; const int col0 = 128 * (pn - 20) + cl;
#pragma unroll
            for (int ai = 0; ai < 2; ++ai)
#pragma unroll
                for (int m = 0; m < 4; ++m) { bf16_t* rowp = base + (size_t)(row0 + ai * 128 + m * 16) * D + col0;
                    const f32x4 u0 = acc[ai][0][m][0], u1 = acc[ai][0][m][1], g0 = acc[ai][1][m][0], g1 = acc[ai][1][m][1];
                    u32x4 w; w.x = pk2(gelu_silu_(u0[0], g0[0]), gelu_silu_(u0[1], g0[1])); w.y = pk2(gelu_silu_(u0[2], g0[2]), gelu_silu_(u0[3], g0[3]));
                    w.z = pk2(gelu_silu_(u1[0], g1[0]), gelu_silu_(u1[1], g1[1])); w.w = pk2(gelu_silu_(u1[2], g1[2]), gelu_silu_(u1[3], g1[3]));
                    *(u32x4*)rowp = w; }
            return;
        }
        if (pn >= 32) {
            bf16_t* sa = g3 + 2 * ARR; bf16_t* rh = g3 + 4 * ARR; const int col0 = 128 * (pn - 32) + cl;
#pragma unroll
            for (int ai = 0; ai < 2; ++ai)
#pragma unroll
                for (int m = 0; m < 4; ++m) { const size_t off = (size_t)(row0 + ai * 128 + m * 16) * D + col0;
                    const f32x4 a0 = acc[ai][0][m][0], a1 = acc[ai][0][m][1], b0 = acc[ai][1][m][0], b1 = acc[ai][1][m][1];
                    const float av[8] = {a0[0], a0[1], a0[2], a0[3], a1[0], a1[1], a1[2], a1[3]}, bv[8] = {b0[0], b0[1], b0[2], b0[3], b1[0], b1[1], b1[2], b1[3]};
                    float sg[8], ro[8];
#pragma unroll
                    for (int j = 0; j < 8; ++j) { const float da = 1.0f + fexp2(-fmaxf(av[j], -40.f) * LOG2E), db = 1.0f + fexp2(-fmaxf(bv[j], -40.f) * LOG2E);
                        const float r = frcp(da * db); sg[j] = db * r; ro[j] = da * (da * r); }
                    *(u32x4*)(sa + off) = (u32x4){pk2(sg[0], sg[1]), pk2(sg[2], sg[3]), pk2(sg[4], sg[5]), pk2(sg[6], sg[7])};
                    *(u32x4*)(rh + off) = (u32x4){pk2(ro[0], ro[1]), pk2(ro[2], ro[3]), pk2(ro[4], ro[5]), pk2(ro[6], ro[7])}; }
            return;
        }
        int idx, ct;
        if (pn < 20) { idx = pn >> 2; ct = pn & 3; } else { idx = 6; ct = pn - 28; }
        bf16_t* base = (idx <= 4) ? out9 + (size_t)idx * ARR : out9 + 5 * ARR; const int col0 = 256 * ct + cl;
        if (idx == 0) store_act<1>(acc, base, row0, col0);
        else if (idx <= 3) store_act<0>(acc, base, row0, col0);
        else if (idx == 4) store_act<0>(acc, base, row0, col0);
        else store_act<3>(acc, base, row0, col0);
    }
};
struct EpiProjAB {
    static constexpr bool PERM = true, KEEP = true;
    const bf16_t* SMA; const bf16_t* RHO; bf16_t* MG;
    DI void mid(f32x4 (&acc)[2][2][4][2], const pg8::Unit& u, int wr, int wc, int fr, int fq) const {
        const int row0 = u.pm * 256 + wr * 64 + fr, col0 = u.pn * 256 + wc * 32 + 8 * fq;
#pragma unroll
        for (int ai = 0; ai < 2; ++ai)
#pragma unroll
            for (int m = 0; m < 4; ++m) { const size_t off = (size_t)(row0 + ai * 128 + m * 16) * D + col0;
#pragma unroll
                for (int bj = 0; bj < 2; ++bj) { const u32x4 gw = *(const u32x4*)(RHO + off + bj * 128);
                    acc[ai][bj][m][0] = acc[ai][bj][m][0] * (f32x4){bflo(gw.x), bfhi(gw.x), bflo(gw.y), bfhi(gw.y)};
                    acc[ai][bj][m][1] = acc[ai][bj][m][1] * (f32x4){bflo(gw.z), bfhi(gw.z), bflo(gw.w), bfhi(gw.w)}; }
                asm volatile("" ::: "memory"); }
    }
    DI void operator()(const f32x4 (&acc)[2][2][4][2], const pg8::Unit& u, int wr, int wc, int fr, int fq) const {
        const int row0 = u.pm * 256 + wr * 64 + fr, col0 = u.pn * 256 + wc * 32 + 8 * fq;
#pragma unroll
        for (int ai = 0; ai < 2; ++ai)
#pragma unroll
            for (int m = 0; m < 4; ++m) { const size_t off = (size_t)(row0 + ai * 128 + m * 16) * D + col0;
#pragma unroll
                for (int bj = 0; bj < 2; ++bj) { const f32x4 v0 = acc[ai][bj][m][0], v1 = acc[ai][bj][m][1];
                    const u32x4 gw = *(const u32x4*)(SMA + off + bj * 128);
                    u32x4 w; w.x = pk2(v0[0] * bflo(gw.x), v0[1] * bfhi(gw.x)); w.y = pk2(v0[2] * bflo(gw.y), v0[3] * bfhi(gw.y)); w.z = pk2(v1[0] * bflo(gw.z), v1[1] * bfhi(gw.z)); w.w = pk2(v1[2] * bflo(gw.w), v1[3] * bfhi(gw.w));
                    *(u32x4*)(MG + off + bj * 128) = w; }
                asm volatile("" ::: "memory"); }
    }
};
struct EpiResid {
    static constexpr bool PERM = true, KEEP = false;
    const float* xin; float* out;
    DI void operator()(const f32x4 (&acc)[2][2][4][2], const pg8::Unit& u, int wr, int wc, int fr, int fq) const {
        const int row0 = u.pm * 256 + wr * 64 + fr, col0 = u.pn * 256 + wc * 32 + 8 * fq;
#pragma unroll
        for (int ai = 0; ai < 2; ++ai)
#pragma unroll
            for (int m = 0; m < 4; ++m) { const size_t off = (size_t)(row0 + ai * 128 + m * 16) * D + col0;
#pragma unroll
                for (int bj = 0; bj < 2; ++bj) {
                    const f32x4 o0 = *(const f32x4*)(xin + off + bj * 128) + acc[ai][bj][m][0], o1 = *(const f32x4*)(xin + off + bj * 128 + 4) + acc[ai][bj][m][1];
                    *(f32x4*)(out + off + bj * 128) = o0; *(f32x4*)(out + off + bj * 128 + 4) = o1; }
                asm volatile("" ::: "memory"); }
    }
};

DI int src_col(int nv) {
    if (nv < 5120) return nv;
    if (nv < 7168) { const int t = (nv - 5120) >> 8, w = (nv - 5120) & 255; return w < 128 ? 5120 + 128 * t + w : 7168 + 128 * t + (w - 128); }
    if (nv < 8192) return 6144 + (nv - 7168);
    { const int t = (nv - 8192) >> 8, w = (nv - 8192) & 255; return w < 128 ? 8192 + 128 * t + w : 9216 + 128 * t + (w - 128); }
}
DI void transpose_item(const float* W, int N, bf16_t* WT, int k0, int nsrc0, int nvirt0, LAS float* scr, int lane) {
#pragma unroll 8
    for (int i = 0; i < 32; ++i) { const int kk = 2 * i + (lane >> 5); scr[kk * 33 + (lane & 31)] = W[(size_t)(k0 + kk) * N + nsrc0 + (lane & 31)]; }
    LDS_WAIT();
    const int c = lane & 7;
#pragma unroll
    for (int j = 0; j < 4; ++j) { const int n = (lane >> 3) + 8 * j; const LAS float* s = scr + (8 * c) * 33 + n;
        u32x4 o; o.x = pk2(s[0 * 33], s[1 * 33]); o.y = pk2(s[2 * 33], s[3 * 33]); o.z = pk2(s[4 * 33], s[5 * 33]); o.w = pk2(s[6 * 33], s[7 * 33]);
        *(u32x4*)(WT + (size_t)(nvirt0 + n) * D + k0 + 8 * c) = o; }
    LDS_WAIT();
}
DI void phase_prep(LAS unsigned char* lds, const float* w_in, const float* wa, const float* wb, const float* wo, unsigned char* ws, int G) {
    const int tid_ = opaque_tid(); const int lane = tid_ & 63, wave = __builtin_amdgcn_readfirstlane(tid_ >> 6);
    LAS float* scr = (LAS float*)(lds + wave * 16384);
    const int gw = blockIdx.x * 8 + wave, NGW = G * 8;
    constexpr int I_IN = 16 * 320, I_P = 16 * 32, PER_L = I_IN + 3 * I_P;
    for (int it = gw; it < PER_L; it += NGW) {
        int r = it;
        if (r < I_IN) { const int kb = r / 320, nb = r % 320; transpose_item(w_in, NIN, (bf16_t*)(ws + WS_WIN), 64 * kb, src_col(32 * nb), 32 * nb, scr, lane); continue; }
        r -= I_IN; const int which = r / I_P; r %= I_P; const int kb = r / 32, nb = r % 32;
        const float* W = (which == 0 ? wa : which == 1 ? wb : wo);
        bf16_t* WT = (bf16_t*)(ws + (which == 0 ? WS_WA : which == 1 ? WS_WB : WS_WO));
        transpose_item(W, D, WT, 64 * kb, 32 * nb, 32 * nb, scr, lane);
    }
}
DI void phase_rms_bf16(const float* x, const float* w, bf16_t* h, int nrows, int G) {
    const int tid_ = opaque_tid(); const int lane = tid_ & 63, wave = __builtin_amdgcn_readfirstlane(tid_ >> 6);
    const int gw = blockIdx.x * 8 + wave, NGW = G * 8;
    f32x4 wv[4];
#pragma unroll
    for (int j = 0; j < 4; ++j) wv[j] = ((const f32x4*)w)[lane + 64 * j];
    for (int m = gw; m < nrows; m += NGW) {
        const f32x4* xr = (const f32x4*)(x + (size_t)m * D) + lane; f32x4 v[4]; float s = 0.f;
#pragma unroll
        for (int j = 0; j < 4; ++j) { v[j] = xr[64 * j]; s += (v[j].x * v[j].x + v[j].y * v[j].y) + (v[j].z * v[j].z + v[j].w * v[j].w); }
        const float rstd = rsqrtf(wave_sum(s) * (1.0f / D) + 1e-6f);
        u32x2* o8 = (u32x2*)(h + (size_t)m * D) + lane;
#pragma unroll
        for (int j = 0; j < 4; ++j) { u32x2 o; o.x = pk2(v[j].x * rstd * wv[j].x, v[j].y * rstd * wv[j].y); o.y = pk2(v[j].z * rstd * wv[j].z, v[j].w * rstd * wv[j].w); o8[64 * j] = o; }
    }
}
DI void phase_final(float* x, const float* w, int nrows, int G) {
    const int tid_ = opaque_tid(); const int lane = tid_ & 63, wave = __builtin_amdgcn_readfirstlane(tid_ >> 6);
    const int gw = blockIdx.x * 8 + wave, NGW = G * 8;
    f32x4 wv[4];
#pragma unroll
    for (int j = 0; j < 4; ++j) wv[j] = ((const f32x4*)w)[lane + 64 * j];
    for (int m = gw; m < nrows; m += NGW) {
        f32x4* xr = (f32x4*)(x + (size_t)m * D) + lane; f32x4 v[4]; float s = 0.f;
#pragma unroll
        for (int j = 0; j < 4; ++j) { v[j] = xr[64 * j]; s += (v[j].x * v[j].x + v[j].y * v[j].y) + (v[j].z * v[j].z + v[j].w * v[j].w); }
        const float rstd = rsqrtf(wave_sum(s) * (1.0f / D) + 1e-6f);
#pragma unroll
        for (int j = 0; j < 4; ++j) xr[64 * j] = v[j] * rstd * wv[j];
    }
}
#define MFMA32(a, b, c) __builtin_amdgcn_mfma_f32_32x32x16_bf16((a), (b), (c), 0, 0, 0)
struct S1Regs { u32x4 q0, q1, z0, z1, v0, v1; };
DI size_t s1_rowoff(int it, int sub, int j) {
    const int sc = it & 31, dir = (it >> 5) & 1, h = (it >> 6) & 7, b = it >> 9, p = 64 * sub + j;
    return ((size_t)b * SEQ + sc * 128 + (dir ? 127 - p : p)) * D + h * 128;
}
DI void s1_load(S1Regs& R, const bf16_t* Q, const bf16_t* Z, const bf16_t* Iv, int it, int sub, int tid) {
    const size_t off = s1_rowoff(it, sub, tid >> 3) + 16 * (tid & 7);
    const bf16_t* zp = Z + (size_t)((it >> 5) & 1) * ARR;
    R.q0 = *(const u32x4*)(Q + off); R.q1 = *(const u32x4*)(Q + off + 8);
    R.z0 = *(const u32x4*)(zp + off); R.z1 = *(const u32x4*)(zp + off + 8);
    R.v0 = *(const u32x4*)(Iv + off); R.v1 = *(const u32x4*)(Iv + off + 8);
}
DI void phase_s1(LAS unsigned char* lds, const bf16_t* Q, bf16_t* Z, const bf16_t* Iv, bf16_t* O, bf16_t* X, float* AC, const float* LBT, int G) {
    const int tid = opaque_tid(), lane = tid & 63, wave = __builtin_amdgcn_readfirstlane(tid >> 6);
    const int r = lane & 31, hh = lane >> 5, j8 = tid >> 3, cg8 = tid & 7;
    LAS bf16_t* TQ = (LAS bf16_t*)(lds);
    LAS bf16_t* TV = (LAS bf16_t*)(lds + 17408);
    LAS bf16_t* TZ = (LAS bf16_t*)(lds + 34816);
    LAS bf16_t* QS = (LAS bf16_t*)(lds + 52224);
    LAS bf16_t* KSA = (LAS bf16_t*)(lds + 69632);
    LAS bf16_t* KSB = (LAS bf16_t*)(lds + 87040);
    LAS bf16_t* KHT = (LAS bf16_t*)(lds + 104448);
    LAS bf16_t* VT = (LAS bf16_t*)(lds + 122880);
    LAS float* TA = (LAS float*)(lds + 157696);
    LAS float* AA = TA + 128;
    LAS float* AB = TA + 256;
    LAS float* TT = TA + 384;
    LAS float* TR = TA + 512;
    LAS float* EC1 = TA + 640;
    LAS float* ER = TA + 768;
    LAS float* EF = TA + 896;
    LAS bf16_t* PS = TV;
    S1Regs R;
    int it = blockIdx.x;
    if (it < 2048) s1_load(R, Q, Z, Iv, it, 0, tid);
    __syncthreads();
    for (; it < 2048; it += G) {
        const int sc = it & 31, dir = (it >> 5) & 1, h = (it >> 6) & 7, b = it >> 9, seq = (b * 8 + h) * 2 + dir;
        f32x16 DA[2];
        float lbv[16], omv[16];
        { const float* lp = LBT + dir * 2048 + h * 128 + 16 * wave;
#pragma unroll
          for (int i = 0; i < 16; ++i) { lbv[i] = lp[i]; omv[i] = lp[1024 + i]; } }
#pragma unroll
        for (int sub = 0; sub < 2; ++sub) {
            *(LAS u32x4*)(TQ + j8 * 136 + 16 * cg8) = R.q0; *(LAS u32x4*)(TQ + j8 * 136 + 16 * cg8 + 8) = R.q1;
            *(LAS u32x4*)(TZ + j8 * 136 + 16 * cg8) = R.z0; *(LAS u32x4*)(TZ + j8 * 136 + 16 * cg8 + 8) = R.z1;
            *(LAS u32x4*)(TV + j8 * 136 + 16 * cg8) = R.v0; *(LAS u32x4*)(TV + j8 * 136 + 16 * cg8 + 8) = R.v1;
            __syncthreads();
            {
                const u32x4 z0 = *(const LAS u32x4*)(TZ + lane * 136 + 16 * wave), z1 = *(const LAS u32x4*)(TZ + lane * 136 + 16 * wave + 8);
                const u32x4 q0 = *(const LAS u32x4*)(TQ + lane * 136 + 16 * wave), q1 = *(const LAS u32x4*)(TQ + lane * 136 + 16 * wave + 8);
                const u32x4 v0 = *(const LAS u32x4*)(TV + lane * 136 + 16 * wave), v1 = *(const LAS u32x4*)(TV + lane * 136 + 16 * wave + 8);
                const unsigned zw[8] = {z0.x, z0.y, z0.z, z0.w, z1.x, z1.y, z1.z, z1.w};
                const unsigned qw[8] = {q0.x, q0.y, q0.z, q0.w, q1.x, q1.y, q1.z, q1.w};
                const unsigned vw[8] = {v0.x, v0.y, v0.z, v0.w, v1.x, v1.y, v1.z, v1.w};
                float kk[16], gg[16];
                if (sub == 0) s1_load(R, Q, Z, Iv, it, 1, tid); else if (it + G < 2048) s1_load(R, Q, Z, Iv, it + G, 0, tid);
#pragma unroll
                for (int i = 0; i < 16; ++i) { const unsigned w = zw[i >> 1]; float z = (i & 1) ? bfhi(w) : bflo(w); z = __builtin_amdgcn_fmed3f(z, -30.f, 30.f);
                    const float e = fexp2(-z * LOG2E), sg = frcp(1.0f + e); const float om = omv[i];
                    kk[i] = om * e * sg; gg[i] = __builtin_amdgcn_logf(lbv[i] + om * sg); }
#define S1_DPP16(MOD) asm volatile("s_nop 1\n\t" \
                    "v_add_f32_dpp %0, %0, %0 " MOD "\n\tv_add_f32_dpp %1, %1, %1 " MOD "\n\tv_add_f32_dpp %2, %2, %2 " MOD "\n\tv_add_f32_dpp %3, %3, %3 " MOD "\n\t" \
                    "v_add_f32_dpp %4, %4, %4 " MOD "\n\tv_add_f32_dpp %5, %5, %5 " MOD "\n\tv_add_f32_dpp %6, %6, %6 " MOD "\n\tv_add_f32_dpp %7, %7, %7 " MOD "\n\t" \
                    "v_add_f32_dpp %8, %8, %8 " MOD "\n\tv_add_f32_dpp %9, %9, %9 " MOD "\n\tv_add_f32_dpp %10, %10, %10 " MOD "\n\tv_add_f32_dpp %11, %11, %11 " MOD "\n\t" \
                    "v_add_f32_dpp %12, %12, %12 " MOD "\n\tv_add_f32_dpp %13, %13, %13 " MOD "\n\tv_add_f32_dpp %14, %14, %14 " MOD "\n\tv_add_f32_dpp %15, %15, %15 " MOD "\n\ts_nop 1" \
                    : "+v"(gg[0]), "+v"(gg[1]), "+v"(gg[2]), "+v"(gg[3]), "+v"(gg[4]), "+v"(gg[5]), "+v"(gg[6]), "+v"(gg[7]), \
                      "+v"(gg[8]), "+v"(gg[9]), "+v"(gg[10]), "+v"(gg[11]), "+v"(gg[12]), "+v"(gg[13]), "+v"(gg[14]), "+v"(gg[15]))
                S1_DPP16("row_shr:1 row_mask:0xf bank_mask:0xf bound_ctrl:1");
                S1_DPP16("row_shr:2 row_mask:0xf bank_mask:0xf bound_ctrl:1");
                S1_DPP16("row_shr:4 row_mask:0xf bank_mask:0xf bound_ctrl:1");
                S1_DPP16("row_shr:8 row_mask:0xf bank_mask:0xf bound_ctrl:1");
                S1_DPP16("row_bcast:15 row_mask:0xa bank_mask:0xf");
                S1_DPP16("row_bcast:31 row_mask:0xc bank_mask:0xf");
#undef S1_DPP16
                float Rv[16], aa[16], fv[16], erv[16];
#pragma unroll
                for (int i = 0; i < 16; ++i) Rv[i] = __int_as_float(__builtin_amdgcn_readlane(__float_as_int(gg[i]), 31));
                if (lane == 63) {
#pragma unroll
                    for (int q4 = 0; q4 < 4; ++q4) { const f32x4 t4 = (f32x4){gg[4 * q4] - Rv[4 * q4], gg[4 * q4 + 1] - Rv[4 * q4 + 1], gg[4 * q4 + 2] - Rv[4 * q4 + 2], gg[4 * q4 + 3] - Rv[4 * q4 + 3]};
                        *(LAS f32x4*)(TT + 16 * wave + 4 * q4) = t4; if (sub == 0) *(LAS f32x4*)(TA + 16 * wave + 4 * q4) = t4;
                        *(LAS f32x4*)(TR + 16 * wave + 4 * q4) = (f32x4){Rv[4 * q4], Rv[4 * q4 + 1], Rv[4 * q4 + 2], Rv[4 * q4 + 3]}; }
                }
                asm volatile("" ::: "memory");
                {
                    const int ci = 16 * wave + (lane & 15);
                    const float x1 = TT[ci], x2 = TR[ci];
                    const float e1 = fexp2(x1), e2 = fexp2(x2), ea = e1 * e2;
                    EC1[ci] = e1; ER[ci] = e2;
                    if (sub == 0) AA[ci] = ea;
                    else { const float aav = AA[ci]; AB[ci] = ea; EF[ci] = fexp2(x2 + TA[ci]);
                        if (lane < 16) AC[((size_t)seq * 32 + sc) * 128 + ci] = ea * aav; }
                }
                asm volatile("" ::: "memory");
#pragma unroll
                for (int q4 = 0; q4 < 4; ++q4) { const f32x4 e4 = *(const LAS f32x4*)(ER + 16 * wave + 4 * q4);
                    erv[4 * q4] = e4.x; erv[4 * q4 + 1] = e4.y; erv[4 * q4 + 2] = e4.z; erv[4 * q4 + 3] = e4.w;
                    if (sub == 1) { const f32x4 a4 = *(const LAS f32x4*)(AA + 16 * wave + 4 * q4), f4 = *(const LAS f32x4*)(EF + 16 * wave + 4 * q4);
                        aa[4 * q4] = a4.x; aa[4 * q4 + 1] = a4.y; aa[4 * q4 + 2] = a4.z; aa[4 * q4 + 3] = a4.w; fv[4 * q4] = f4.x; fv[4 * q4 + 1] = f4.y; fv[4 * q4 + 2] = f4.z; fv[4 * q4 + 3] = f4.w; } }
                unsigned qo[8], ko[8], qh[8];
#pragma unroll
                for (int w = 0; w < 8; ++w) {
                    float qt_[2], kt_[2], qh_[2];
#pragma unroll
                    for (int e2 = 0; e2 < 2; ++e2) { const int i = 2 * w + e2; const float qf = e2 ? bfhi(qw[w]) : bflo(qw[w]);
                        const float dq = gg[i] - Rv[i];
                        qt_[e2] = qf * fexp2(fminf(dq, 100.f)); kt_[e2] = kk[i] * fexp2(fminf(-dq, 100.f));
                        qh_[e2] = (sub == 0) ? qt_[e2] * erv[i] : qt_[e2] * erv[i] * aa[i]; }
                    qo[w] = pk2(qt_[0], qt_[1]); ko[w] = pk2(kt_[0], kt_[1]); qh[w] = pk2(qh_[0], qh_[1]);
                }
                LAS bf16_t* KSx = (sub == 0) ? KSA : KSB;
                *(LAS u32x4*)(QS + lane * 136 + 16 * wave) = (u32x4){qo[0], qo[1], qo[2], qo[3]}; *(LAS u32x4*)(QS + lane * 136 + 16 * wave + 8) = (u32x4){qo[4], qo[5], qo[6], qo[7]};
                *(LAS u32x4*)(KSx + lane * 136 + 16 * wave) = (u32x4){ko[0], ko[1], ko[2], ko[3]}; *(LAS u32x4*)(KSx + lane * 136 + 16 * wave + 8) = (u32x4){ko[4], ko[5], ko[6], ko[7]};
                *(LAS u32x4*)(TZ + lane * 136 + 16 * wave) = (u32x4){qh[0], qh[1], qh[2], qh[3]}; *(LAS u32x4*)(TZ + lane * 136 + 16 * wave + 8) = (u32x4){qh[4], qh[5], qh[6], qh[7]};
#pragma unroll
                for (int w = 0; w < 8; ++w) {
                    KHT[(16 * wave + 2 * w) * 72 + lane] = (bf16_t)(ko[w] & 0xffffu); KHT[(16 * wave + 2 * w + 1) * 72 + lane] = (bf16_t)(ko[w] >> 16);
                    VT[(16 * wave + 2 * w) * 136 + 64 * sub + lane] = (bf16_t)(vw[w] & 0xffffu); VT[(16 * wave + 2 * w + 1) * 136 + 64 * sub + lane] = (bf16_t)(vw[w] >> 16);
                }
                if (sub == 1) {
                    const u32x4 k0 = *(const LAS u32x4*)(KSA + lane * 136 + 16 * wave), k1 = *(const LAS u32x4*)(KSA + lane * 136 + 16 * wave + 8);
                    const unsigned kw[8] = {k0.x, k0.y, k0.z, k0.w, k1.x, k1.y, k1.z, k1.w}; unsigned kn[8];
#pragma unroll
                    for (int w = 0; w < 8; ++w) kn[w] = pk2(bflo(kw[w]) * fv[2 * w], bfhi(kw[w]) * fv[2 * w + 1]);
                    *(LAS u32x4*)(KSA + lane * 136 + 16 * wave) = (u32x4){kn[0], kn[1], kn[2], kn[3]}; *(LAS u32x4*)(KSA + lane * 136 + 16 * wave + 8) = (u32x4){kn[4], kn[5], kn[6], kn[7]};
                }
            }
            __syncthreads();
            {
                LAS bf16_t* KSx = (sub == 0) ? KSA : KSB;
                if (wave < 3) {
                    const int tm = (wave == 2) ? 1 : 0, tn = (wave == 0) ? 0 : 1;
                    f32x16 acc;
#pragma unroll
                    for (int i = 0; i < 16; ++i) acc[i] = 0.f;
#pragma unroll
                    for (int ks = 0; ks < 8; ++ks) { const bf16x8 a = *(const LAS bf16x8*)(KSx + (32 * tm + r) * 136 + 16 * ks + 8 * hh), bb = *(const LAS bf16x8*)(QS + (32 * tn + r) * 136 + 16 * ks + 8 * hh); acc = MFMA32(a, bb, acc); }
                    const int t = 32 * tn + r;
#pragma unroll
                    for (int g = 0; g < 4; ++g) { const int s0 = 32 * tm + 8 * g + 4 * hh;
                        const float p0 = (s0 + 0 <= t) ? acc[4 * g + 0] : 0.f, p1 = (s0 + 1 <= t) ? acc[4 * g + 1] : 0.f, p2 = (s0 + 2 <= t) ? acc[4 * g + 2] : 0.f, p3 = (s0 + 3 <= t) ? acc[4 * g + 3] : 0.f;
                        *(LAS u32x2*)(PS + t * 136 + 64 * sub + s0) = (u32x2){pk2(p0, p1), pk2(p2, p3)}; }
                } else if (sub == 1 && wave < 7) {
                    const int tm = (wave - 3) >> 1, tn = (wave - 3) & 1;
                    f32x16 acc;
#pragma unroll
                    for (int i = 0; i < 16; ++i) acc[i] = 0.f;
#pragma unroll
                    for (int ks = 0; ks < 8; ++ks) { const bf16x8 a = *(const LAS bf16x8*)(KSA + (32 * tm + r) * 136 + 16 * ks + 8 * hh), bb = *(const LAS bf16x8*)(QS + (32 * tn + r) * 136 + 16 * ks + 8 * hh); acc = MFMA32(a, bb, acc); }
                    const int t = 32 * tn + r;
#pragma unroll
                    for (int g = 0; g < 4; ++g) { const int s0 = 32 * tm + 8 * g + 4 * hh;
                        *(LAS u32x2*)(PS + t * 136 + s0) = (u32x2){pk2(acc[4 * g], acc[4 * g + 1]), pk2(acc[4 * g + 2], acc[4 * g + 3])}; }
                }
#pragma unroll
                for (int k = 0; k < 2; ++k) {
                    const int vt = wave >> 1, dt = 2 * (wave & 1) + k;
                    f32x16 acc;
#pragma unroll
                    for (int i = 0; i < 16; ++i) acc[i] = 0.f;
#pragma unroll
                    for (int ks = 0; ks < 4; ++ks) { const bf16x8 a = *(const LAS bf16x8*)(VT + (32 * vt + r) * 136 + 64 * sub + 16 * ks + 8 * hh), bb = *(const LAS bf16x8*)(KHT + (32 * dt + r) * 72 + 16 * ks + 8 * hh); acc = MFMA32(a, bb, acc); }
                    const float c1 = EC1[32 * dt + r];
                    if (sub == 0) {
#pragma unroll
                        for (int i = 0; i < 16; ++i) DA[k][i] = acc[i] * c1;
                    } else { const float ab = AB[32 * dt + r];
#pragma unroll
                        for (int i = 0; i < 16; ++i) acc[i] = DA[k][i] * ab + acc[i] * c1;
                        bf16_t* xp = X + ((size_t)seq * 32 + sc) * 16384 + (size_t)(32 * vt + 4 * hh) * 128 + 32 * dt + r;
#pragma unroll
                        for (int i = 0; i < 16; i += 2) { const unsigned p = pk2(acc[i], acc[i + 1]); const int v0 = (i & 3) + 8 * (i >> 2);
                            xp[(size_t)v0 * 128] = (bf16_t)(p & 0xffffu); xp[(size_t)(v0 + 1) * 128] = (bf16_t)(p >> 16); } }
                }
                {
                    bf16_t* zp = Z + (size_t)dir * ARR + s1_rowoff(it, sub, j8) + 16 * cg8;
                    __builtin_nontemporal_store(*(const LAS u32x4*)(TZ + j8 * 136 + 16 * cg8), (u32x4*)zp); __builtin_nontemporal_store(*(const LAS u32x4*)(TZ + j8 * 136 + 16 * cg8 + 8), (u32x4*)(zp + 8));
                }
            }
            __syncthreads();
            {
                const int vt = wave & 3, tn = wave >> 2;
                f32x16 acc;
#pragma unroll
                for (int i = 0; i < 16; ++i) acc[i] = 0.f;
                if (sub == 1) {
#pragma unroll
                    for (int ks = 0; ks < 4; ++ks) { const bf16x8 a = *(const LAS bf16x8*)(VT + (32 * vt + r) * 136 + 16 * ks + 8 * hh), bb = *(const LAS bf16x8*)(PS + (32 * tn + r) * 136 + 16 * ks + 8 * hh); acc = MFMA32(a, bb, acc); }
                }
#pragma unroll
                for (int ks = 0; ks < 4; ++ks) { if (ks < 2 * (tn + 1)) { const bf16x8 a = *(const LAS bf16x8*)(VT + (32 * vt + r) * 136 + 64 * sub + 16 * ks + 8 * hh), bb = *(const LAS bf16x8*)(PS + (32 * tn + r) * 136 + 64 * sub + 16 * ks + 8 * hh); acc = MFMA32(a, bb, acc); } }
                LAS bf16_t* op = QS + (32 * tn + r) * 136 + 32 * vt + 4 * hh;
#pragma unroll
                for (int g = 0; g < 4; ++g) *(LAS u32x2*)(op + 8 * g) = (u32x2){pk2(acc[4 * g], acc[4 * g + 1]), pk2(acc[4 * g + 2], acc[4 * g + 3])};
            }
            __syncthreads();
            {
                bf16_t* op = O + (size_t)dir * ARR + s1_rowoff(it, sub, j8) + 16 * cg8;
                __builtin_nontemporal_store(*(const LAS u32x4*)(QS + j8 * 136 + 16 * cg8), (u32x4*)op); __builtin_nontemporal_store(*(const LAS u32x4*)(QS + j8 * 136 + 16 * cg8 + 8), (u32x4*)(op + 8));
            }
        }
    }
}
DI void phase_lnstats(const bf16_t* GV, f32x2* STATS, int G) {
    const int tid_ = opaque_tid(); const int lane = tid_ & 63, wave = __builtin_amdgcn_readfirstlane(tid_ >> 6);
    const int gw = blockIdx.x * 8 + wave, NGW = G * 8;
    for (int m = gw; m < MH; m += NGW) {
        const bf16_t* p = GV + (size_t)m * D + 16 * lane;
        const u32x4 a0 = *(const u32x4*)p, a1 = *(const u32x4*)(p + 8);
        const unsigned aw[8] = {a0.x, a0.y, a0.z, a0.w, a1.x, a1.y, a1.z, a1.w};
        float s1 = 0.f, s2 = 0.f;
#pragma unroll
        for (int w = 0; w < 8; ++w) { const float x0 = bflo(aw[w]), x1 = bfhi(aw[w]); s1 += x0 + x1; s2 += x0 * x0 + x1 * x1; }
        s1 = wave_sum(s1); s2 = wave_sum(s2);
        const float mean = s1 * (1.0f / D), var = fmaxf(s2 * (1.0f / D) - mean * mean, 0.f);
        if (lane == 0) STATS[m] = (f32x2){mean, rsqrtf(var + 1e-5f)};
    }
}
DI void phase_s2(bf16_t* X, const float* AC, int G) {
    const int tid = opaque_tid();
    for (int gid = blockIdx.x * 512 + tid; gid < 64 * 2048; gid += G * 512) {
        const int seq = gid >> 11, e = gid & 2047, d0 = (e & 15) * 8, dir = seq & 1;
        bf16_t* xp = X + (size_t)seq * 32 * 16384 + (size_t)(e >> 4) * 128 + d0;
        const float* ap = AC + (size_t)seq * 32 * 128 + d0;
        float S[8];
#pragma unroll
        for (int i = 0; i < 8; ++i) S[i] = 0.f;
        for (int st = 0; st < 32; st += 8) {
            u32x4 dv[8]; f32x4 a0[8], a1[8];
#pragma unroll
            for (int u = 0; u < 8; ++u) { const int c = dir ? 31 - (st + u) : st + u; dv[u] = *(const u32x4*)(xp + (size_t)c * 16384); a0[u] = *(const f32x4*)(ap + c * 128); a1[u] = *(const f32x4*)(ap + c * 128 + 4); }
#pragma unroll
            for (int u = 0; u < 8; ++u) { const int c = dir ? 31 - (st + u) : st + u;
                *(u32x4*)(xp + (size_t)c * 16384) = (u32x4){pk2(S[0], S[1]), pk2(S[2], S[3]), pk2(S[4], S[5]), pk2(S[6], S[7])};
                S[0] = a0[u].x * S[0] + bflo(dv[u].x); S[1] = a0[u].y * S[1] + bfhi(dv[u].x); S[2] = a0[u].z * S[2] + bflo(dv[u].y); S[3] = a0[u].w * S[3] + bfhi(dv[u].y);
                S[4] = a1[u].x * S[4] + bflo(dv[u].z); S[5] = a1[u].y * S[5] + bfhi(dv[u].z); S[6] = a1[u].z * S[6] + bflo(dv[u].w); S[7] = a1[u].w * S[7] + bfhi(dv[u].w); }
        }
    }
}
struct S3Regs { u32x4 x[8], q[8]; };
DI void s3_decode(int it, int& c, int& h, int& b) { const int rest = (it & 7) | ((it >> 4) << 3); c = ((rest & 31) << 1) | ((it >> 3) & 1); h = (rest >> 5) & 7; b = rest >> 8; }
DI void s3_load(S3Regs& R, const bf16_t* QH, const bf16_t* X, int it, int dir, int ts, int vt, int lane) {
    int c, h, b; s3_decode(it, c, h, b);
    const bf16_t* xp = X + ((size_t)((b * 8 + h) * 2 + dir) * 32 + (c >> 1)) * 16384 + (size_t)(32 * vt) * 128 + 8 * lane;
    const bf16_t* qp = QH + (size_t)dir * ARR + ((size_t)b * SEQ + c * 64 + 32 * ts + (lane >> 4)) * D + h * 128 + 8 * (lane & 15);
#pragma unroll
    for (int k = 0; k < 8; ++k) { R.x[k] = *(const u32x4*)(xp + 512 * k); R.q[k] = *(const u32x4*)(qp + (size_t)(4 * k) * D); }
}
DI void phase_s3(LAS unsigned char* lds, const bf16_t* QH, const bf16_t* O, const bf16_t* X, const bf16_t* SGA, const float* gw_, bf16_t* YA, int G) {
    const int tid = opaque_tid(), lane = tid & 63, wave = __builtin_amdgcn_readfirstlane(tid >> 6);
    const int r = lane & 31, hh = lane >> 5, ts = wave >> 2, vt = wave & 3;
    LAS bf16_t* XW = (LAS bf16_t*)(lds + wave * 17408);
    LAS bf16_t* QW = XW + 32 * 136;
    LAS float* SS0 = (LAS float*)(lds + 8 * 17408);
    S3Regs R;
    int it = blockIdx.x;
    if (it < 2048) s3_load(R, QH, X, it, 0, ts, vt, lane);
    __syncthreads();
    for (int par = 0; it < 2048; it += G, par ^= 1) {
        int c, h, b; s3_decode(it, c, h, b);
        const size_t row = (size_t)b * SEQ + c * 64 + 32 * ts + r;
        LAS float* SS = SS0 + par * 256;
        const size_t eoff = ((size_t)b * SEQ + c * 64 + 32 * ts + (lane >> 2)) * D + h * 128 + 32 * vt + 8 * (lane & 3);
        u32x4 ef2[2], eb2[2], es2[2];
        f32x16 acc;
#pragma unroll
        for (int i = 0; i < 16; ++i) acc[i] = 0.f;
#pragma unroll
        for (int dir = 0; dir < 2; ++dir) {
#pragma unroll
            for (int k = 0; k < 8; ++k) { const int id = 64 * k + lane; *(LAS u32x4*)(XW + (id >> 4) * 136 + 8 * (id & 15)) = R.x[k]; *(LAS u32x4*)(QW + (id >> 4) * 136 + 8 * (id & 15)) = R.q[k]; }
            asm volatile("" ::: "memory");
            if (dir == 0) { s3_load(R, QH, X, it, 1, ts, vt, lane);
#pragma unroll
                for (int k = 0; k < 2; ++k) { ef2[k] = *(const u32x4*)(O + eoff + (size_t)(16 * k) * D); eb2[k] = *(const u32x4*)(O + ARR + eoff + (size_t)(16 * k) * D); es2[k] = *(const u32x4*)(SGA + eoff + (size_t)(16 * k) * D); } }
            else if (it + G < 2048) s3_load(R, QH, X, it + G, 0, ts, vt, lane);
#pragma unroll
            for (int ks = 0; ks < 8; ++ks) { const bf16x8 a = *(const LAS bf16x8*)(XW + r * 136 + 16 * ks + 8 * hh), bb = *(const LAS bf16x8*)(QW + r * 136 + 16 * ks + 8 * hh); acc = MFMA32(a, bb, acc); }
        }
        asm volatile("" ::: "memory");
        LAS bf16_t* T0 = XW; LAS bf16_t* T1 = XW + 1280; LAS bf16_t* T2 = XW + 2560; LAS bf16_t* TY = XW + 3840;
#pragma unroll
        for (int k = 0; k < 2; ++k) { const int eo = ((lane >> 2) + 16 * k) * 40 + 8 * (lane & 3);
            *(LAS u32x4*)(T0 + eo) = ef2[k]; *(LAS u32x4*)(T1 + eo) = eb2[k]; *(LAS u32x4*)(T2 + eo) = es2[k]; }
        asm volatile("" ::: "memory");
        u32x2 ef[4], eb[4], es[4];
#pragma unroll
        for (int g = 0; g < 4; ++g) { const int co = r * 40 + 8 * g + 4 * hh; ef[g] = *(const LAS u32x2*)(T0 + co); eb[g] = *(const LAS u32x2*)(T1 + co); es[g] = *(const LAS u32x2*)(T2 + co); }
        float o[16]; float ss = 0.f;
#pragma unroll
        for (int g = 0; g < 4; ++g) { const u32x2 f = ef[g], bk = eb[g];
            o[4 * g] = acc[4 * g] + bflo(f.x) + bflo(bk.x); o[4 * g + 1] = acc[4 * g + 1] + bfhi(f.x) + bfhi(bk.x); o[4 * g + 2] = acc[4 * g + 2] + bflo(f.y) + bflo(bk.y); o[4 * g + 3] = acc[4 * g + 3] + bfhi(f.y) + bfhi(bk.y); }
#pragma unroll
        for (int i = 0; i < 16; ++i) ss += o[i] * o[i];
        ss += __shfl_xor(ss, 32);
        if (hh == 0) SS[(32 * ts + r) * 4 + vt] = ss;
        __syncthreads();
        const f32x4 s4 = *(const LAS f32x4*)(SS + (32 * ts + r) * 4);
        const float rstd = rsqrtf((s4.x + s4.y + s4.z + s4.w) * (1.0f / 128.0f) + 1e-6f);
#pragma unroll
        for (int g = 0; g < 4; ++g) { const u32x2 sg = es[g]; const f32x4 gv = *(const f32x4*)(gw_ + 32 * vt + 8 * g + 4 * hh);
            *(LAS u32x2*)(TY + r * 40 + 8 * g + 4 * hh) = (u32x2){pk2(o[4 * g] * rstd * gv.x * siluf_(bflo(sg.x)), o[4 * g + 1] * rstd * gv.y * siluf_(bfhi(sg.x))), pk2(o[4 * g + 2] * rstd * gv.z * siluf_(bflo(sg.y)), o[4 * g + 3] * rstd * gv.w * siluf_(bfhi(sg.y)))}; }
        asm volatile("" ::: "memory");
#pragma unroll
        for (int k = 0; k < 2; ++k) *(u32x4*)(YA + eoff + (size_t)(16 * k) * D) = *(const LAS u32x4*)(TY + ((lane >> 2) + 16 * k) * 40 + 8 * (lane & 3));
        asm volatile("" ::: "memory");
    }
}

DI void phase_spatial(LAS unsigned char* lds, const bf16_t* GV, bf16_t* UG, const f32x2* STATS, const float* ln_w, const float* ln_b, const float* w_s, const float* b_s, int G) {
    const int tid = opaque_tid(), lane = tid & 63, wave = __builtin_amdgcn_readfirstlane(tid >> 6);
    const int r = lane & 31, hh = lane >> 5;
    LAS bf16_t* VL = (LAS bf16_t*)(lds);
    LAS bf16_t* WS = (LAS bf16_t*)(lds + 34816);
    int g_last = -1;
    for (int it = blockIdx.x; it < 1024; it += G) {
        const int g = it & 7, n = (it >> 3) & 31, b = it >> 8;
        const size_t rowbase = (size_t)b * SEQ + (size_t)n * 128;
        __syncthreads();
        {
            const int s = tid >> 2, cq = tid & 3; const f32x2 st = STATS[rowbase + s];
            const bf16_t* p = GV + (rowbase + s) * D + 128 * g + 32 * cq;
#pragma unroll
            for (int q = 0; q < 4; ++q) { const u32x4 a = *(const u32x4*)(p + 8 * q); const unsigned aw[4] = {a.x, a.y, a.z, a.w};
                const f32x4 w0 = *(const f32x4*)(ln_w + 128 * g + 32 * cq + 8 * q), w1 = *(const f32x4*)(ln_w + 128 * g + 32 * cq + 8 * q + 4);
                const f32x4 c0 = *(const f32x4*)(ln_b + 128 * g + 32 * cq + 8 * q), c1 = *(const f32x4*)(ln_b + 128 * g + 32 * cq + 8 * q + 4);
                const float wv[8] = {w0.x, w0.y, w0.z, w0.w, w1.x, w1.y, w1.z, w1.w}, bv[8] = {c0.x, c0.y, c0.z, c0.w, c1.x, c1.y, c1.z, c1.w};
#pragma unroll
                for (int w = 0; w < 4; ++w) { const float y0 = (bflo(aw[w]) - st.x) * st.y * wv[2 * w] + bv[2 * w], y1 = (bfhi(aw[w]) - st.x) * st.y * wv[2 * w + 1] + bv[2 * w + 1];
                    const unsigned pk = pk2(y0, y1); const int cc = 32 * cq + 8 * q + 2 * w;
                    VL[cc * 136 + s] = (bf16_t)(pk & 0xffffu); VL[(cc + 1) * 136 + s] = (bf16_t)(pk >> 16); } }
            if (g != g_last) {
                const int t = tid >> 2, sq = tid & 3; const float* wp = w_s + ((size_t)g * 128 + t) * 128 + 32 * sq;
#pragma unroll
                for (int q = 0; q < 4; ++q) { const f32x4 x0 = *(const f32x4*)(wp + 8 * q), x1 = *(const f32x4*)(wp + 8 * q + 4);
                    *(LAS u32x4*)(WS + t * 136 + 32 * sq + 8 * q) = (u32x4){pk2(x0.x, x0.y), pk2(x0.z, x0.w), pk2(x1.x, x1.y), pk2(x1.z, x1.w)}; }
                g_last = g; }
        }
        __syncthreads();
        {
            const int cm = wave & 3;
#pragma unroll
            for (int tt = 0; tt < 2; ++tt) {
                const int tn = 2 * (wave >> 2) + tt;
                f32x16 acc;
#pragma unroll
                for (int i = 0; i < 16; ++i) acc[i] = 0.f;
#pragma unroll
                for (int ks = 0; ks < 8; ++ks) { const bf16x8 a = *(const LAS bf16x8*)(VL + (32 * cm + r) * 136 + 16 * ks + 8 * hh), bb = *(const LAS bf16x8*)(WS + (32 * tn + r) * 136 + 16 * ks + 8 * hh); acc = MFMA32(a, bb, acc); }
                const int t = 32 * tn + r; const float bias = b_s[g * 128 + t];
                LAS bf16_t* TU = (LAS bf16_t*)(lds + 69632 + wave * 2560);
                bf16_t* ug = UG + (rowbase + 32 * tn + (lane >> 2)) * D + 128 * g + 32 * cm + 8 * (lane & 3);
                const int eo = (lane >> 2) * 40 + 8 * (lane & 3);
                const u32x4 u0 = *(const u32x4*)ug, u1 = *(const u32x4*)(ug + (size_t)16 * D);
                asm volatile("" ::: "memory");
                *(LAS u32x4*)(TU + eo) = u0; *(LAS u32x4*)(TU + eo + 16 * 40) = u1;
                asm volatile("" ::: "memory");
#pragma unroll
                for (int q = 0; q < 4; ++q) { const int co = r * 40 + 8 * q + 4 * hh; const u32x2 uw = *(const LAS u32x2*)(TU + co);
                    *(LAS u32x2*)(TU + co) = (u32x2){pk2(bflo(uw.x) * (acc[4 * q] + bias), bfhi(uw.x) * (acc[4 * q + 1] + bias)), pk2(bflo(uw.y) * (acc[4 * q + 2] + bias), bfhi(uw.y) * (acc[4 * q + 3] + bias))}; }
                asm volatile("" ::: "memory");
                *(u32x4*)ug = *(const LAS u32x4*)(TU + eo); *(u32x4*)(ug + (size_t)16 * D) = *(const LAS u32x4*)(TU + eo + 16 * 40);
                asm volatile("" ::: "memory");
            }
        }
    }
}

struct Args { const float* in[13]; float* out; unsigned char* ws; int ph_lo, ph_hi; };
constexpr int PPL = 11;
constexpr int NPH = 4 * PPL + 1;

__global__ void __launch_bounds__(512, 2) mega(Args a) {
    extern __shared__ __attribute__((aligned(16))) unsigned char shm[];
    LAS unsigned char* lds = (LAS unsigned char*)shm;
    cg::grid_group grid = cg::this_grid();
    const int G = gridDim.x, blk = blockIdx.x;
    unsigned char* ws = a.ws;
    const float* x0 = a.in[0];
    bf16_t* Hb = (bf16_t*)(ws + WS_H); bf16_t* out9 = (bf16_t*)(ws + WS_OUT9);
    bf16_t* Qb = out9, *ZFb = out9 + ARR, *Ib = out9 + 3 * ARR, *SGAb = out9 + 4 * ARR, *GVb = out9 + 5 * ARR;
    bf16_t* g3 = (bf16_t*)(ws + WS_G3); bf16_t* UGf = g3, *SMAf = g3 + 2 * ARR, *SMBf = g3 + 4 * ARR;
    bf16_t* OFb = (bf16_t*)(ws + WS_OF); bf16_t* Xb = (bf16_t*)(ws + WS_X); float* ACb = (float*)(ws + WS_AC); f32x2* STb = (f32x2*)(ws + WS_ST);
    volatile LAS unsigned* bst = (volatile LAS unsigned*)(lds + LDS_BYTES - 16);
    if (threadIdx.x < 4) bst[threadIdx.x] = 0u;
    if (blk == 0) for (int i = threadIdx.x; i < XCD_BAR_WORDS; i += 512) ((unsigned*)ws)[i] = 0u;
    __syncthreads();
    XcdBarrier xb; xb.bar = (unsigned*)ws; xb.x = 0; xb.st = bst;
    for (int ph = a.ph_lo; ph < a.ph_hi; ++ph) {
        if (ph == a.ph_lo + 1) { grid.sync(); xb = xcd_barrier_post((unsigned*)ws, bst); }
        else if (ph > a.ph_lo + 1) xcd_barrier(xb);
        if (ph == NPH - 1) { phase_final(a.out, a.in[12], M_ALL, G); continue; }
        const int l = ph / PPL, rr = ph % PPL;
        const float* xin = (l == 0) ? x0 : a.out;
        if (rr == 0) {
            phase_prep(lds, a.in[2] + (size_t)l * D * NIN, a.in[9] + (size_t)l * D * D, a.in[10] + (size_t)l * D * D, a.in[11] + (size_t)l * D * D, ws, G);
            phase_rms_bf16(xin, a.in[1] + l * D, Hb, M_ALL, G);
            if (blk == 0) {
                float* LBT = (float*)(ws + WS_LBT);
                for (int i = threadIdx.x; i < 2048; i += 512) { const float* lp = a.in[3] + i;
                    const float v0 = lp[0], v1 = lp[2048], v2 = lp[4096], v3 = lp[6144], mx = fmaxf(fmaxf(v0, v1), fmaxf(v2, v3));
                    const float e0 = __expf(v0 - mx), e1 = __expf(v1 - mx), e2 = __expf(v2 - mx), e3 = __expf(v3 - mx);
                    float lb = 0.f; if (l >= 1) lb += e1; if (l >= 2) lb += e2; if (l >= 3) lb += e3;
                    lb = lb / (e0 + e1 + e2 + e3);
                    LBT[(i >> 10) * 2048 + (i & 1023)] = fmaxf(lb, 1e-20f); LBT[(i >> 10) * 2048 + 1024 + (i & 1023)] = 1.0f - lb; }
            }
            continue;
        }
        const int hf = (rr <= 8) ? (rr - 1) / 4 : 0, k = (rr <= 8) ? (rr - 1) % 4 : rr - 5;
        bf16_t* Hh = Hb + (size_t)hf * ARR;
        bf16_t* UGb = UGf + (size_t)hf * ARR;
        if (k == 0) {
            pg8::Gemm g{Hh, Hh, (const bf16_t*)(ws + WS_WIN), (const bf16_t*)(ws + WS_WIN), D};
            pg8::Order S; S.init(MH, NIN, G, blk, 0, 1);
            EpiInProj E{out9, g3 + (size_t)hf * ARR};
            pg8::gemm_phase<EpiInProj>(lds, g, S, E);
        } else if (k == 1) {
            phase_lnstats(GVb, STb, G);
            phase_s1(lds, Qb, ZFb, Ib, OFb, Xb, ACb, (const float*)(ws + WS_LBT), G);
        } else if (k == 2) {
            phase_s2(Xb, ACb, G);
        } else if (k == 3) {
            if (blk & 1) phase_s3(lds, ZFb, OFb, Xb, SGAb, a.in[4] + l * 128, Hh, G);
            __syncthreads();
            phase_spatial(lds, GVb, UGb, STb, a.in[5] + l * D, a.in[6] + l * D, a.in[7] + (size_t)l * 8 * 128 * 128, a.in[8] + l * 8 * 128, G);
            __syncthreads();
            if (!(blk & 1)) phase_s3(lds, ZFb, OFb, Xb, SGAb, a.in[4] + l * 128, Hh, G);
        } else if (k == 4) {
            pg8::Gemm g{UGf, Hb, (const bf16_t*)(ws + WS_WB), (const bf16_t*)(ws + WS_WA), D};
            pg8::Order S; S.init(M_ALL, D, G, blk, 1);
            EpiProjAB E{SMAf, SMBf, out9};
            pg8::gemm_phase<EpiProjAB>(lds, g, S, E);
        } else {
            pg8::Gemm g{out9, out9, (const bf16_t*)(ws + WS_WO), (const bf16_t*)(ws + WS_WO), D};
            pg8::Order S; S.init(M_ALL, D, G, blk, 0);
            EpiResid E{xin, a.out};
            pg8::gemm_phase<EpiResid>(lds, g, S, E);
        }
    }
}


extern "C" void kernel_launch(void* const* d_in, const int* in_sizes, int n_in, void* d_out, int out_size, void* d_ws, size_t ws_size, hipStream_t stream) {
    static int grid = 0;
    if (grid == 0) {
        if (n_in != 13 || ws_size < WS_END) { fprintf(stderr, "kernel_launch: unexpected inputs (n_in %d, ws %zu, need %zu)\n", n_in, ws_size, (size_t)WS_END); grid = -1; return; }
        int dev = 0, cus = 0, per_cu = 0;
        hipGetDevice(&dev); hipDeviceGetAttribute(&cus, hipDeviceAttributeMultiprocessorCount, dev);
        if (hipFuncSetAttribute((const void*)mega, hipFuncAttributeMaxDynamicSharedMemorySize, LDS_BYTES) != hipSuccess) { fprintf(stderr, "kernel_launch: hipFuncSetAttribute failed\n"); grid = -1; return; }
        if (hipOccupancyMaxActiveBlocksPerMultiprocessor(&per_cu, (const void*)mega, 512, LDS_BYTES) != hipSuccess || per_cu < 1) { fprintf(stderr, "kernel_launch: occupancy query gave %d\n", per_cu); per_cu = 1; }
        (void)hipGetLastError();
        grid = cus * 1;
        fprintf(stderr, "kernel_launch: cus %d per_cu %d grid %d\n", cus, per_cu, grid);
    }
    if (grid < 0) return;
    Args a{};
    for (int i = 0; i < 13; ++i) a.in[i] = (const float*)d_in[i];
    a.out = (float*)d_out; a.ws = (unsigned char*)d_ws; a.ph_lo = 0; a.ph_hi = NPH;
    void* args[] = {&a};
    hipError_t e = hipLaunchCooperativeKernel((const void*)mega, dim3(grid), dim3(512), args, LDS_BYTES, stream);
    if (e != hipSuccess) fprintf(stderr, "kernel_launch: cooperative launch failed: %s (grid %d)\n", hipGetErrorString(e), grid);
}
```
